# Optimizing an MI355X kernel written in HIP

```python
import math
import jax
import jax.numpy as jnp
from jax import lax
import numpy as np

D_MODEL = 1024
BATCH = 8
SEQ = 4096
DEPTH = 4

D_MIX = D_MODEL
EPS = 1e-6
CONV_WIDTH = 4
CHUNK = 64
S5_WIDTH = D_MIX // 4
S5_CH = 16
S5_GROUPS = S5_WIDTH // S5_CH
S5_STATE = 64
GDN_WIDTH = (3 * D_MIX) // 8
GDN_HEAD_DIM = 64
GDN_HEADS = GDN_WIDTH // GDN_HEAD_DIM
GDN_CONV_DIM = 3 * GDN_WIDTH
SSD_WIDTH = D_MIX - S5_WIDTH - GDN_WIDTH
SSD_HEAD_DIM = 64
SSD_HEADS = SSD_WIDTH // SSD_HEAD_DIM
SSD_GROUPS = 2
SSD_STATE = 128
SSD_CONV_DIM = SSD_WIDTH + 2 * SSD_GROUPS * SSD_STATE
PROJ_SIZES = (S5_WIDTH, GDN_CONV_DIM, GDN_WIDTH, GDN_HEADS, GDN_HEADS,
              SSD_WIDTH, SSD_CONV_DIM, SSD_HEADS)
D_IN_PROJ = sum(PROJ_SIZES)
MOE_GROUPS = 4
EXPERTS_PER_GROUP = 8
N_EXPERTS = MOE_GROUPS * EXPERTS_PER_GROUP
TOP_K = 2
D_EXPERT = 256
MOE_BLOCK = 128

kernel_name = "hymba_s5_gdn_ssd_hiermoe_adaln"


def rms_norm(x, w):
    xf = x.astype(jnp.float32)
    xf = xf * lax.rsqrt(jnp.mean(xf * xf, axis=-1, keepdims=True) + EPS)
    return (xf * w.astype(jnp.float32)).astype(x.dtype)


def l2norm(x):
    return x * lax.rsqrt(jnp.sum(x * x, axis=-1, keepdims=True) + EPS)


def causal_conv(x, w, b=None):
    K, S = w.shape[0], x.shape[1]
    xp = jnp.pad(x, ((0, 0), (K - 1, 0), (0, 0)))
    y = sum(xp[:, j:j + S] * w[j] for j in range(K))
    if b is not None:
        y = y + b
    return jax.nn.silu(y)


def _linear_recurrence(e1, e2):
    a1, b1 = e1
    a2, b2 = e2
    return a1 * a2, a2 * b1 + b2


def s5_mixer(u, a_re, a_im, b_re, b_im, c_re, c_im, d_skip, log_dt, w_glu, norm_w):
    Bsz, S, _ = u.shape
    f32 = jnp.float32
    uf = u.astype(f32).reshape(Bsz, S, S5_GROUPS, S5_CH)
    lam = lax.complex(a_re.astype(f32), a_im.astype(f32))
    step = jnp.exp(log_dt.astype(f32))[:, None]
    lam_bar = jnp.exp(lam * step)
    b_bar = ((lam_bar - 1.0) / lam)[..., None] * lax.complex(b_re.astype(f32), b_im.astype(f32))
    bu = jnp.einsum('gpc,bsgc->bsgp', b_bar, uf.astype(jnp.complex64))
    lam_seq = jnp.broadcast_to(lam_bar, bu.shape)
    _, states = lax.associative_scan(_linear_recurrence, (lam_seq, bu), axis=1)
    c_mat = lax.complex(c_re.astype(f32), c_im.astype(f32))
    y = jnp.einsum('gcp,bsgp->bsgc', c_mat, states).real + d_skip.astype(f32).reshape(S5_GROUPS, S5_CH) * uf
    y = jax.nn.gelu(y.reshape(Bsz, S, S5_WIDTH))
    y = y * jax.nn.sigmoid(y @ w_glu.astype(f32))
    return rms_norm(y, norm_w).astype(u.dtype)


def gdn_mixer(qkv, z, a, b, conv_w, a_log, dt_bias, norm_w):
    Bsz, S, _ = qkv.shape
    H, Dh, C = GDN_HEADS, GDN_HEAD_DIM, CHUNK
    NC = S // C
    f32 = jnp.float32
    qkv_c = causal_conv(qkv, conv_w).astype(f32)

    def chunks(t):
        return t.reshape(Bsz, NC, C, H, Dh).transpose(0, 3, 1, 2, 4)

    q, k, v = (chunks(t) for t in jnp.split(qkv_c, 3, axis=-1))
    q = l2norm(q) * Dh ** -0.5
    k = l2norm(k)
    beta = jax.nn.sigmoid(b.astype(f32)).reshape(Bsz, NC, C, H).transpose(0, 3, 1, 2)
    g = -jnp.exp(a_log.astype(f32)) * jax.nn.softplus(a.astype(f32) + dt_bias.astype(f32))
    gc = jnp.cumsum(g.reshape(Bsz, NC, C, H).transpose(0, 3, 1, 2), axis=-1)
    causal = jnp.tril(jnp.ones((C, C), bool))
    strict = jnp.tril(jnp.ones((C, C), bool), -1)
    decay = jnp.exp(jnp.where(causal, gc[..., :, None] - gc[..., None, :], -jnp.inf))
    k_beta = k * beta[..., None]
    lower = jnp.where(strict, jnp.einsum('bhncd,bhnmd->bhncm', k_beta, k) * decay, 0.0)
    rhs = jnp.concatenate([v * beta[..., None], k_beta * jnp.exp(gc)[..., None]], axis=-1)
    sol = lax.linalg.triangular_solve(lower, rhs, left_side=True, lower=True, unit_diagonal=True)
    u_val, w_dec = sol[..., :Dh], sol[..., Dh:]
    attn = jnp.einsum('bhncd,bhnmd->bhncm', q, k) * decay
    q_dec = q * jnp.exp(gc)[..., None]
    k_dec = k * jnp.exp(gc[..., -1:] - gc)[..., None]
    g_tot = jnp.exp(gc[..., -1])

    def step(state, inp):
        attn_c, q_c, w_c, u_c, k_c, gt_c = inp
        v_new = u_c - jnp.einsum('bhcd,bhde->bhce', w_c, state)
        o = jnp.einsum('bhcd,bhde->bhce', q_c, state) + jnp.einsum('bhcm,bhme->bhce', attn_c, v_new)
        state = state * gt_c[..., None, None] + jnp.einsum('bhcd,bhce->bhde', k_c, v_new)
        return state, o

    xs = tuple(jnp.moveaxis(t, 2, 0) for t in (attn, q_dec, w_dec, u_val, k_dec, g_tot))
    _, o = lax.scan(step, jnp.zeros((Bsz, H, Dh, Dh), f32), xs)
    o = o.transpose(1, 0, 3, 2, 4).reshape(Bsz, S, H, Dh)
    o = rms_norm(o, norm_w) * jax.nn.silu(z.astype(f32).reshape(Bsz, S, H, Dh))
    return o.reshape(Bsz, S, GDN_WIDTH).astype(qkv.dtype)


def ssd_mixer(z, xbc, dt_raw, conv_w, conv_b, a_log, dt_bias, d_skip, norm_w):
    Bsz, S, _ = z.shape
    H, P, G, N, C = SSD_HEADS, SSD_HEAD_DIM, SSD_GROUPS, SSD_STATE, CHUNK
    R, NC = H // G, S // C
    f32 = jnp.float32
    xbc_c = causal_conv(xbc, conv_w, conv_b).astype(f32)
    xs, bm, cm = jnp.split(xbc_c, [SSD_WIDTH, SSD_WIDTH + G * N], axis=-1)
    xs = xs.reshape(Bsz, NC, C, G, R, P)
    bm = bm.reshape(Bsz, NC, C, G, N)
    cm = cm.reshape(Bsz, NC, C, G, N)
    dt = jax.nn.softplus(dt_raw.astype(f32) + dt_bias.astype(f32)).reshape(Bsz, NC, C, G, R)
    a = -jnp.exp(a_log.astype(f32)).reshape(G, R)
    x_dt = xs * dt[..., None]
    acs = jnp.cumsum((dt * a).transpose(0, 3, 4, 1, 2), axis=-1)
    causal = jnp.tril(jnp.ones((C, C), bool))
    seg = jnp.exp(jnp.where(causal, acs[..., :, None] - acs[..., None, :], -jnp.inf))
    cb = jnp.einsum('bnlgd,bnmgd->bgnlm', cm, bm)
    y_diag = jnp.einsum('bgnlm,bgrnlm,bnmgrp->bnlgrp', cb, seg, x_dt)
    decay_in = jnp.exp(acs[..., -1:] - acs)
    chunk_states = jnp.einsum('bnmgd,bgrnm,bnmgrp->bngrpd', bm, decay_in, x_dt)
    chunk_decay = jnp.exp(acs[..., -1])
    decay_out = jnp.exp(acs)

    def step(state, inp):
        c_n, dout_n, cs_n, cd_n = inp
        y_off = jnp.einsum('blgd,bgrpd,bgrl->blgrp', c_n, state, dout_n)
        state = state * cd_n[..., None, None] + cs_n
        return state, y_off

    scan_in = (jnp.moveaxis(cm, 1, 0), jnp.moveaxis(decay_out, 3, 0),
               jnp.moveaxis(chunk_states, 1, 0), jnp.moveaxis(chunk_decay, 3, 0))
    _, y_off = lax.scan(step, jnp.zeros((Bsz, G, R, P, N), f32), scan_in)
    y = y_diag + jnp.moveaxis(y_off, 0, 1) + d_skip.astype(f32).reshape(G, R, 1) * xs
    y = y.reshape(Bsz, S, SSD_WIDTH) * jax.nn.silu(z.astype(f32))
    y = rms_norm(y.reshape(Bsz, S, G, SSD_WIDTH // G), norm_w.reshape(G, SSD_WIDTH // G))
    return y.reshape(Bsz, S, SSD_WIDTH).astype(z.dtype)


def hier_moe(h, w_grp, b_grp, w_rt, b_rt, w_gate, w_up, w_down):
    Bsz, S, D = h.shape
    N = Bsz * S
    NK = N * TOP_K
    f32 = jnp.float32
    xt = h.reshape(N, D)
    lg = (xt @ w_grp).astype(f32) + b_grp.astype(f32)
    g_idx = jnp.argmax(lg, axis=-1)
    g_w = jnp.take_along_axis(jax.nn.softmax(lg, axis=-1), g_idx[:, None], axis=1)[:, 0]
    le = ((xt @ w_rt).astype(f32) + b_rt.astype(f32)).reshape(N, MOE_GROUPS, EXPERTS_PER_GROUP)
    le_sel = jnp.take_along_axis(le, g_idx[:, None, None], axis=1)[:, 0]
    top_v, top_i = lax.top_k(le_sel, TOP_K)
    w_e = jax.nn.softmax(top_v, axis=-1)
    eid = (g_idx[:, None] * EXPERTS_PER_GROUP + top_i).reshape(NK).astype(jnp.int32)
    wt = (g_w[:, None] * w_e).reshape(NK)
    tok = jnp.repeat(jnp.arange(N, dtype=jnp.int32), TOP_K)
    order = jnp.argsort(eid)
    eid_s, tok_s, wt_s = eid[order], tok[order], wt[order]
    counts = jnp.bincount(eid, length=N_EXPERTS)
    padded = ((counts + MOE_BLOCK - 1) // MOE_BLOCK) * MOE_BLOCK
    start = jnp.cumsum(counts) - counts
    pend = jnp.cumsum(padded)
    pstart = pend - padded
    dest = pstart[eid_s] + jnp.arange(NK, dtype=jnp.int32) - start[eid_s]
    L_pad = NK + N_EXPERTS * MOE_BLOCK
    n_blk = L_pad // MOE_BLOCK
    buf_tok = jnp.full((L_pad,), N, jnp.int32).at[dest].set(tok_s)
    buf_wt = jnp.zeros((L_pad,), f32).at[dest].set(wt_s)
    blk_e = jnp.minimum(jnp.searchsorted(pend, jnp.arange(n_blk) * MOE_BLOCK, side='right'), N_EXPERTS - 1)
    x_pad = jnp.concatenate([xt, jnp.zeros((1, D), xt.dtype)], axis=0)
    xb = x_pad[buf_tok].reshape(n_blk, MOE_BLOCK, D)

    def expert_block(args):
        xblk, e = args
        hid = jax.nn.silu(xblk @ w_gate[e]) * (xblk @ w_up[e])
        return hid @ w_down[e]

    yb = lax.map(expert_block, (xb, blk_e)).reshape(L_pad, D)
    y = yb * buf_wt[:, None].astype(yb.dtype)
    out = jax.ops.segment_sum(y, buf_tok, num_segments=N + 1)[:N]
    return out.reshape(Bsz, S, D)


def setup_inputs(seed: int = 0) -> dict:
    key = jax.random.key(seed)
    k = jax.random.split(key, 36)
    f32 = jnp.float32
    L, D = DEPTH, D_MODEL

    def nrm(i, shape, scale):
        return scale * jax.random.normal(k[i], shape, f32)

    def unif(i, shape, lo, hi):
        return jax.random.uniform(k[i], shape, f32, lo, hi)

    def dt_bias(i, shape):
        dt = jnp.exp(unif(i, shape, math.log(1e-3), math.log(1e-1)))
        return dt + jnp.log(-jnp.expm1(-dt))

    s5_n = jnp.arange(S5_STATE, dtype=f32)
    return {
        "x": nrm(0, (BATCH, SEQ, D), 1.0),
        "c": nrm(1, (BATCH, D), 1.0),
        "w_ada": nrm(2, (L, D, 6 * D), 0.5 * D ** -0.5),
        "b_ada": nrm(3, (L, 6 * D), 0.02),
        "norm_mix": 1.0 + nrm(4, (L, D), 0.02),
        "norm_ffn": 1.0 + nrm(5, (L, D), 0.02),
        "w_in": nrm(6, (L, D, D_IN_PROJ), D ** -0.5),
        "w_out": nrm(7, (L, D_MIX, D), D_MIX ** -0.5),
        "s5_a_re": -0.5 + nrm(8, (L, S5_GROUPS, S5_STATE), 0.01),
        "s5_a_im": math.pi * s5_n + nrm(9, (L, S5_GROUPS, S5_STATE), 0.01),
        "s5_b_re": nrm(10, (L, S5_GROUPS, S5_STATE, S5_CH), (2 * S5_CH) ** -0.5),
        "s5_b_im": nrm(11, (L, S5_GROUPS, S5_STATE, S5_CH), (2 * S5_CH) ** -0.5),
        "s5_c_re": nrm(12, (L, S5_GROUPS, S5_CH, S5_STATE), (2 * S5_STATE) ** -0.5),
        "s5_c_im": nrm(13, (L, S5_GROUPS, S5_CH, S5_STATE), (2 * S5_STATE) ** -0.5),
        "s5_d": nrm(14, (L, S5_WIDTH), 1.0),
        "s5_log_dt": unif(15, (L, S5_GROUPS), math.log(1e-3), math.log(1e-1)),
        "s5_w_glu": nrm(16, (L, S5_WIDTH, S5_WIDTH), S5_WIDTH ** -0.5),
        "s5_norm": 1.0 + nrm(17, (L, S5_WIDTH), 0.02),
        "gdn_conv_w": nrm(18, (L, CONV_WIDTH, GDN_CONV_DIM), CONV_WIDTH ** -0.5),
        "gdn_a_log": jnp.log(unif(19, (L, GDN_HEADS), 1.0, 16.0)),
        "gdn_dt_bias": dt_bias(20, (L, GDN_HEADS)),
        "gdn_norm": 1.0 + nrm(21, (L, GDN_HEAD_DIM), 0.02),
        "ssd_conv_w": nrm(22, (L, CONV_WIDTH, SSD_CONV_DIM), CONV_WIDTH ** -0.5),
        "ssd_conv_b": nrm(23, (L, SSD_CONV_DIM), 0.02),
        "ssd_a_log": jnp.log(unif(24, (L, SSD_HEADS), 1.0, 16.0)),
        "ssd_dt_bias": dt_bias(25, (L, SSD_HEADS)),
        "ssd_d": 1.0 + nrm(26, (L, SSD_HEADS), 0.02),
        "ssd_norm": 1.0 + nrm(27, (L, SSD_WIDTH), 0.02),
        "moe_w_grp": nrm(28, (L, D, MOE_GROUPS), D ** -0.5),
        "moe_b_grp": nrm(29, (L, MOE_GROUPS), 0.01),
        "moe_w_rt": nrm(30, (L, D, N_EXPERTS), D ** -0.5),
        "moe_b_rt": nrm(31, (L, N_EXPERTS), 0.01),
        "moe_w_gate": nrm(32, (L, N_EXPERTS, D, D_EXPERT), D ** -0.5),
        "moe_w_up": nrm(33, (L, N_EXPERTS, D, D_EXPERT), D ** -0.5),
        "moe_w_down": nrm(34, (L, N_EXPERTS, D_EXPERT, D), D_EXPERT ** -0.5),
        "norm_final": 1.0 + nrm(35, (D,), 0.02),
    }


def reference(x, c, w_ada, b_ada, norm_mix, norm_ffn, w_in, w_out,
              s5_a_re, s5_a_im, s5_b_re, s5_b_im, s5_c_re, s5_c_im, s5_d, s5_log_dt, s5_w_glu, s5_norm,
              gdn_conv_w, gdn_a_log, gdn_dt_bias, gdn_norm,
              ssd_conv_w, ssd_conv_b, ssd_a_log, ssd_dt_bias, ssd_d, ssd_norm,
              moe_w_grp, moe_b_grp, moe_w_rt, moe_b_rt, moe_w_gate, moe_w_up, moe_w_down,
              norm_final):
    Bsz = x.shape[0]
    splits = np.cumsum(PROJ_SIZES)[:-1].tolist()
    cond = jax.nn.silu(c)
    for l in range(DEPTH):
        mod = (cond @ w_ada[l] + b_ada[l]).reshape(Bsz, 6, 1, D_MODEL)
        h = rms_norm(x, norm_mix[l]) * (1.0 + mod[:, 1]) + mod[:, 0]
        proj = h @ w_in[l]
        s5_u, g_qkv, g_z, g_a, g_b, s_z, s_xbc, s_dt = jnp.split(proj, splits, axis=-1)
        y_s5 = s5_mixer(s5_u, s5_a_re[l], s5_a_im[l], s5_b_re[l], s5_b_im[l], s5_c_re[l], s5_c_im[l],
                        s5_d[l], s5_log_dt[l], s5_w_glu[l], s5_norm[l])
        y_gdn = gdn_mixer(g_qkv, g_z, g_a, g_b, gdn_conv_w[l], gdn_a_log[l], gdn_dt_bias[l], gdn_norm[l])
        y_ssd = ssd_mixer(s_z, s_xbc, s_dt, ssd_conv_w[l], ssd_conv_b[l], ssd_a_log[l], ssd_dt_bias[l],
                          ssd_d[l], ssd_norm[l])
        y = jnp.concatenate([y_s5, y_gdn, y_ssd], axis=-1) @ w_out[l]
        x = x + mod[:, 2] * y
        h = rms_norm(x, norm_ffn[l]) * (1.0 + mod[:, 4]) + mod[:, 3]
        x = x + mod[:, 5] * hier_moe(h, moe_w_grp[l], moe_b_grp[l], moe_w_rt[l], moe_b_rt[l],
                                     moe_w_gate[l], moe_w_up[l], moe_w_down[l])
    return rms_norm(x, norm_final)
```

```cpp
#include <hip/hip_runtime.h>
#include <cstdio>
#include <cstdint>
namespace pg8 {
#define PG8_LAS __attribute__((address_space(3)))
typedef unsigned short bf16_t;
typedef short bf16x8 __attribute__((ext_vector_type(8)));
typedef float f32x4 __attribute__((ext_vector_type(4)));
typedef unsigned u32x4 __attribute__((ext_vector_type(4)));
constexpr int BM = 256, BK = 64, HALF = 128, HTB = HALF * BK * 2  , STAGE_BYTES = 8 * HTB, NXCD = 8, WGM = 8;

__host__ __device__ __forceinline__ int lds_byte(int r, int c) { const int st = (r >> 4) * 2 + (c >> 5), rr = r & 15, cc = c & 31, ob = rr * 64 + cc * 2; return st * 1024 + (ob ^ (((ob >> 9) & 1) << 5)); }
__host__ __device__ __forceinline__ void stage_rc(int b, int& R, int& C) { const int st = b / 1024, sb = b % 1024, swz = sb ^ (((sb >> 9) & 1) << 5); R = (st >> 1) * 16 + swz / 64; C = (st & 1) * 32 + (swz % 64) / 2; }
__host__ __device__ __forceinline__ int perm32(int rho) { const int n = rho >> 4, i = rho & 15; return 8 * (i >> 2) + 4 * n + (i & 3); }

struct Unit { int pm, pn, e; };
struct Gemm { const bf16_t* A; const bf16_t* Bt; int M, N, K; size_t estride; };

struct StaticOrder {
    int nM, nN, nwg, G, c;
    __host__ __device__ void init(int M, int N, int G_, int c_) { nM = M / BM; nN = N / BM; nwg = nM * nN; G = G_; c = c_; }
    __host__ __device__ bool next(int i, Unit& u) const {
        const long L = (long)i * G + c; if (L >= nwg) return false;
        int wgid = (int)L; { const int q = nwg / NXCD, r = nwg % NXCD, xcd = wgid % NXCD, off = wgid / NXCD; wgid = (xcd < r ? xcd * (q + 1) : r * (q + 1) + (xcd - r) * q) + off; }
        const int nig = WGM * nN, gid = wgid / nig, fm = gid * WGM, gsz = (nM - fm) < WGM ? (nM - fm) : WGM;
        u.pm = fm + ((wgid % nig) % gsz); u.pn = (wgid % nig) / gsz; u.e = 0; return true;
    }
    __device__ __forceinline__ void a_ready(const Unit&) const {}
    __device__ __forceinline__ void done(const Unit&) const {}
};

__device__ __forceinline__ unsigned cvt_pk_bf16(float lo, float hi) { unsigned r; asm volatile("v_cvt_pk_bf16_f32 %0, %1, %2" : "=v"(r) : "v"(lo), "v"(hi)); return r; }
typedef float f32x2 __attribute__((ext_vector_type(2)));
__device__ __forceinline__ f32x2 gelu_pk(f32x2 v) {
    const f32x2 av = __builtin_elementwise_abs(v), d = av * 0.2316418882f + 1.0f;
    f32x2 t; t.x = __builtin_amdgcn_rcpf(d.x); t.y = __builtin_amdgcn_rcpf(d.y);
    f32x2 q = t * 0.5307027145f + (-0.7265760135f); q = q * t + 0.7107068705f; q = q * t + (-0.142248368f); q = q * t + 0.127414796f; q = q * t;
    const f32x2 s = (v * v) * (-0.72134752044f);
    f32x2 e; e.x = __builtin_amdgcn_exp2f(s.x); e.y = __builtin_amdgcn_exp2f(s.y);
    const f32x2 m = v * (q * e), r = v - m;
    f32x2 o; o.x = v.x < 0.f ? m.x : r.x; o.y = v.y < 0.f ? m.y : r.y; return o;
}

template <int ACT  > struct EpiBf16 {
    static constexpr bool PERM = true, AFTER_DRAIN = false; static_assert(ACT == 0 || ACT == 1, "EpiBf16: ACT is 0 (none) or 1 (gelu_pk)");
    bf16_t* O; int ldc; const float* bias; int split_cols; size_t split_stride; float scale0;
    __device__ __forceinline__ void operator()(const f32x4 (&acc)[2][2][4][2], const Unit& u, int wr, int wc, int fr, int fq) const {
        const int row0 = u.pm * BM + wr * 64 + fr; int colt = u.pn * BM; bf16_t* base = O;
        float sc = 1.f; if (split_cols) { const int t = colt / split_cols; base += (size_t)t * split_stride; colt -= t * split_cols; if (t == 0) sc = scale0; }
        const int col0 = colt + wc * 32 + 8 * fq, bcol0 = u.pn * BM + wc * 32 + 8 * fq;
        f32x4 bv[2][2];
#pragma unroll
        for (int bj = 0; bj < 2; ++bj)
#pragma unroll
            for (int n = 0; n < 2; ++n) bv[bj][n] = bias ? *(const f32x4*)(bias + bcol0 + bj * HALF + 4 * n) : (f32x4){0.f, 0.f, 0.f, 0.f};
#pragma unroll
        for (int ai = 0; ai < 2; ++ai)
#pragma unroll
            for (int m = 0; m < 4; ++m) { bf16_t* rowp = base + (size_t)(row0 + ai * HALF + m * 16) * ldc + col0;
#pragma unroll
                for (int bj = 0; bj < 2; ++bj) { f32x4 v0 = acc[ai][bj][m][0] + bv[bj][0], v1 = acc[ai][bj][m][1] + bv[bj][1];
                    if (ACT == 1) { f32x2 a = gelu_pk((f32x2){v0[0], v0[1]}), b = gelu_pk((f32x2){v0[2], v0[3]}), c = gelu_pk((f32x2){v1[0], v1[1]}), d = gelu_pk((f32x2){v1[2], v1[3]});
                        v0 = (f32x4){a.x, a.y, b.x, b.y}; v1 = (f32x4){c.x, c.y, d.x, d.y}; }
                    v0 = v0 * sc; v1 = v1 * sc; u32x4 w; w.x = cvt_pk_bf16(v0[0], v0[1]); w.y = cvt_pk_bf16(v0[2], v0[3]); w.z = cvt_pk_bf16(v1[0], v1[1]); w.w = cvt_pk_bf16(v1[2], v1[3]);
                    *(u32x4*)(rowp + bj * HALF) = w; } }
    }
};
template <class Epi, class Sched, bool ALIGN_EPI = false, bool SP2 = false>
__device__ __forceinline__ void gemm_phase(PG8_LAS unsigned char* lds, const Gemm g, const Sched& S, const Epi& E) {
    int tid_ = threadIdx.x; asm volatile("" : "+v"(tid_));
    const int tid = tid_, wid = __builtin_amdgcn_readfirstlane(tid >> 6), lane = tid & 63, wr = wid >> 2, wc = wid & 3, fr = lane & 15, fq = lane >> 4;
    const int K = g.K, nt = K / BK;
    unsigned voffA[2], voffB[2];
#pragma unroll
    for (int i = 0; i < 2; ++i) { int R, C; stage_rc(tid * 16 + i * 8192, R, C); const int Rb = Epi::PERM ? ((R & ~31) + perm32(R & 31)) : R;
        voffA[i] = (unsigned)(R * K + C) * 2u; voffB[i] = (unsigned)(Rb * K + C) * 2u; }
    const size_t kstep = (size_t)(BK * 2);
    const size_t hstep = (size_t)HALF * K * 2;
    const size_t tstep = 2 * hstep;
    const unsigned ldsw = (unsigned)wid * 1024u;
    const int aoff = lds_byte(wr * 64 + fr, fq * 8), boff = lds_byte(wc * 32 + fr, fq * 8);
#define PG8_SA(b, h) (((b) * 2 + (h)) * HTB)
#define PG8_SB(b, h) ((4 + (b) * 2 + (h)) * HTB)
#define PG8_STAGE(bufoff, gbase, voff) do { _Pragma("unroll") for (int _i = 0; _i < 2; ++_i) \
        __builtin_amdgcn_global_load_lds((const unsigned*)((const char*)(gbase) + (voff)[_i]), (PG8_LAS unsigned*)(lds + (bufoff) + ldsw + _i * 8192), 16, 0, 0); } while (0)
#define PG8_LDA(dst, b, h) do { _Pragma("unroll") for (int m = 0; m < 4; ++m) _Pragma("unroll") for (int k = 0; k < 2; ++k) dst[m][k] = *(const PG8_LAS bf16x8*)(lds + PG8_SA(b, h) + aoff + m * 2048 + k * 1024); } while (0)
#define PG8_LDB(dst, b, h) do { _Pragma("unroll") for (int n = 0; n < 2; ++n) _Pragma("unroll") for (int k = 0; k < 2; ++k) dst[n][k] = *(const PG8_LAS bf16x8*)(lds + PG8_SB(b, h) + boff + n * 2048 + k * 1024); } while (0)
#define PG8_MMA(ai, bj, At, Bt) do { __builtin_amdgcn_s_setprio(1); _Pragma("unroll") for (int m = 0; m < 4; ++m) _Pragma("unroll") for (int n = 0; n < 2; ++n) _Pragma("unroll") for (int k = 0; k < 2; ++k) \
        acc[ai][bj][m][n] = __builtin_amdgcn_mfma_f32_16x16x32_bf16(Bt[n][k], At[m][k], acc[ai][bj][m][n], 0, 0, 0); __builtin_amdgcn_s_setprio(0); } while (0)
#define PG8_WAIT_V(n) asm volatile("s_waitcnt vmcnt(" #n ")" ::: "memory")
#define PG8_WAIT_L(n) asm volatile("s_waitcnt lgkmcnt(" #n ")" ::: "memory")
#define PG8_BAR __builtin_amdgcn_s_barrier()
#define PG8_SCHED __builtin_amdgcn_sched_barrier(0)
    Unit cur, nxt; int ui = 0;
    if (!S.next(0, cur)) return;
    f32x4 acc[2][2][4][2];
#pragma unroll
    for (int a = 0; a < 2; ++a)
#pragma unroll
        for (int b = 0; b < 2; ++b)
#pragma unroll
            for (int m = 0; m < 4; ++m)
#pragma unroll
                for (int n = 0; n < 2; ++n) acc[a][b][m][n] = (f32x4){0.f, 0.f, 0.f, 0.f};
    bf16x8 At[4][2], B0[2][2], B1[2][2];
    const char* cA = (const char*)g.A + (size_t)cur.pm * tstep; const char* cB = (const char*)g.Bt + (size_t)cur.e * g.estride + (size_t)cur.pn * tstep;
    S.a_ready(cur);
    if constexpr (SP2) {
        PG8_STAGE(PG8_SB(0, 0), cB, voffB); PG8_STAGE(PG8_SB(0, 1), cB + hstep, voffB); PG8_STAGE(PG8_SA(0, 0), cA, voffA); PG8_STAGE(PG8_SA(0, 1), cA + hstep, voffA);
        if (wr == 1) PG8_BAR;
        PG8_WAIT_V(2); PG8_BAR;
        PG8_STAGE(PG8_SB(1, 0), cB + kstep, voffB); PG8_STAGE(PG8_SA(1, 0), cA + kstep, voffA); PG8_STAGE(PG8_SB(1, 1), cB + hstep + kstep, voffB);
        PG8_WAIT_V(6); PG8_BAR;
    } else {
        PG8_STAGE(PG8_SB(0, 0), cB, voffB); PG8_STAGE(PG8_SA(0, 0), cA, voffA); PG8_STAGE(PG8_SB(0, 1), cB + hstep, voffB); PG8_STAGE(PG8_SA(0, 1), cA + hstep, voffA);
        if (wr == 1) PG8_BAR;
        PG8_WAIT_V(4); PG8_BAR;
        PG8_STAGE(PG8_SB(1, 0), cB + kstep, voffB); PG8_STAGE(PG8_SA(1, 0), cA + kstep, voffA); PG8_STAGE(PG8_SB(1, 1), cB + hstep + kstep, voffB);
        PG8_WAIT_V(6); PG8_BAR;
    }
    for (;;) {
        const bool has_next = S.next(ui + 1, nxt);
        const char* nA = has_next ? (const char*)g.A + (size_t)nxt.pm * tstep : cA; const char* nB = has_next ? (const char*)g.Bt + (size_t)nxt.e * g.estride + (size_t)nxt.pn * tstep : cB;
        for (int t = 0; t < nt; t += 2) {
            const bool last = (t == nt - 2);
            const char* a1 = cA + (size_t)(t + 1) * kstep;
            const char* a2 = last ? nA : cA + (size_t)(t + 2) * kstep; const char* b2 = last ? nB : cB + (size_t)(t + 2) * kstep;
            const char* a3 = a2 + kstep; const char* b3 = b2 + kstep;
            if (last && has_next) S.a_ready(nxt);
            if constexpr (SP2) {
            PG8_LDB(B0, 0, 0); PG8_LDB(B1, 0, 1); PG8_SCHED; PG8_LDA(At, 0, 0); PG8_STAGE(PG8_SA(1, 1), a1 + hstep, voffA);
            PG8_WAIT_V(8); PG8_WAIT_L(0); PG8_BAR; PG8_MMA(0, 0, At, B0); PG8_MMA(0, 1, At, B1); PG8_BAR; PG8_SCHED;
            PG8_LDA(At, 0, 1); PG8_STAGE(PG8_SB(0, 0), b2, voffB); PG8_STAGE(PG8_SB(0, 1), b2 + hstep, voffB); PG8_STAGE(PG8_SA(0, 0), a2, voffA);
            PG8_WAIT_V(8); PG8_WAIT_L(0); PG8_BAR; PG8_MMA(1, 0, At, B0); PG8_MMA(1, 1, At, B1); PG8_BAR; PG8_SCHED;
            PG8_LDB(B0, 1, 0); PG8_LDB(B1, 1, 1); PG8_SCHED; PG8_LDA(At, 1, 0); PG8_STAGE(PG8_SA(0, 1), a2 + hstep, voffA);
            PG8_WAIT_V(8); PG8_WAIT_L(0); PG8_BAR; PG8_MMA(0, 0, At, B0); PG8_MMA(0, 1, At, B1); PG8_BAR; PG8_SCHED;
            PG8_LDA(At, 1, 1); PG8_STAGE(PG8_SB(1, 0), b3, voffB); PG8_STAGE(PG8_SB(1, 1), b3 + hstep, voffB); PG8_STAGE(PG8_SA(1, 0), a3, voffA);
            PG8_WAIT_V(8); PG8_WAIT_L(0); PG8_BAR; PG8_MMA(1, 0, At, B0); PG8_MMA(1, 1, At, B1); PG8_BAR; PG8_SCHED;
            } else {
            PG8_LDB(B0, 0, 0); PG8_SCHED; PG8_LDA(At, 0, 0); PG8_STAGE(PG8_SA(1, 1), a1 + hstep, voffA);
            PG8_WAIT_L(8); PG8_BAR; PG8_WAIT_L(0); PG8_MMA(0, 0, At, B0); PG8_BAR; PG8_SCHED;
            PG8_LDB(B1, 0, 1); PG8_STAGE(PG8_SB(0, 0), b2, voffB);
            PG8_BAR; PG8_WAIT_L(0); PG8_MMA(0, 1, At, B1); PG8_BAR;
            PG8_LDA(At, 0, 1); PG8_STAGE(PG8_SA(0, 0), a2, voffA);
            PG8_BAR; PG8_WAIT_L(0); PG8_MMA(1, 0, At, B0); PG8_BAR; PG8_SCHED;
            PG8_STAGE(PG8_SB(0, 1), b2 + hstep, voffB);
            PG8_WAIT_V(6); PG8_BAR; PG8_MMA(1, 1, At, B1); PG8_BAR;
            PG8_LDB(B0, 1, 0); PG8_SCHED; PG8_LDA(At, 1, 0); PG8_STAGE(PG8_SA(0, 1), a2 + hstep, voffA);
            PG8_WAIT_L(8); PG8_BAR; PG8_WAIT_L(0); PG8_MMA(0, 0, At, B0); PG8_BAR; PG8_SCHED;
            PG8_LDB(B1, 1, 1); PG8_STAGE(PG8_SB(1, 0), b3, voffB);
            PG8_BAR; PG8_WAIT_L(0); PG8_MMA(0, 1, At, B1); PG8_BAR;
            PG8_LDA(At, 1, 1); PG8_STAGE(PG8_SA(1, 0), a3, voffA);
            PG8_BAR; PG8_WAIT_L(0); PG8_MMA(1, 0, At, B0); PG8_BAR; PG8_SCHED;
            PG8_STAGE(PG8_SB(1, 1), b3 + hstep, voffB);
            PG8_WAIT_V(6); PG8_BAR; PG8_MMA(1, 1, At, B1); PG8_BAR;
            }
        }
        if constexpr (ALIGN_EPI) { if (wr == 0) PG8_BAR; }
        if constexpr (!Epi::AFTER_DRAIN) { E(acc, cur, wr, wc, fr, fq); S.done(cur); }
        if (!has_next) break;
#pragma unroll
        for (int a = 0; a < 2; ++a)
#pragma unroll
            for (int b = 0; b < 2; ++b)
#pragma unroll
                for (int m = 0; m < 4; ++m)
#pragma unroll
                    for (int n = 0; n < 2; ++n) acc[a][b][m][n] = (f32x4){0.f, 0.f, 0.f, 0.f};
        cur = nxt; cA = nA; cB = nB; ++ui;
        if constexpr (ALIGN_EPI) { if (wr == 1) PG8_BAR; }
    }
    PG8_WAIT_V(0);
    if constexpr (!ALIGN_EPI) { if (wr == 0) PG8_BAR; }
    PG8_BAR;
    if constexpr (Epi::AFTER_DRAIN) { E.fused(acc, cur, wr, wc, fr, fq, lds, wid, lane); S.done(cur); }
#undef PG8_SA
#undef PG8_SB
#undef PG8_STAGE
#undef PG8_LDA
#undef PG8_LDB
#undef PG8_MMA
#undef PG8_WAIT_V
#undef PG8_WAIT_L
#undef PG8_BAR
#undef PG8_SCHED
}
}

#ifndef ONE_LAUNCH
#define ONE_LAUNCH 0
#endif

#define GAS __attribute__((address_space(1)))
#define LAS __attribute__((address_space(3)))
typedef unsigned short bf16;
typedef float v4f __attribute__((ext_vector_type(4)));
typedef unsigned v4u __attribute__((ext_vector_type(4)));
typedef unsigned v2u __attribute__((ext_vector_type(2)));

constexpr int NB = 8, SEQ = 4096, NTOK = NB * SEQ, DM = 1024, NL = 4;
constexpr int DIN = 3090, NP = 3072;
constexpr int PC_S5 = 0, PC_GQKV = 256, PC_GZ = 1408, PC_SZ = 1792, PC_SX = 2176;
constexpr int NE = 32, DE = 256;
constexpr int MAXROWS = 2 * NTOK + NE * 256;
constexpr int MAXTILES = MAXROWS / 256;
constexpr float EPS = 1e-6f;

constexpr size_t MiB = 1u << 20;
constexpr size_t WS_CTL = 0, CTL_BYTES = 1 * MiB;
constexpr size_t WS_MOD = 1 * MiB;
constexpr size_t WS_SMW = 2 * MiB;
constexpr size_t WS_RW = 3 * MiB;
constexpr size_t WS_TI = 4 * MiB;
constexpr size_t WS_LIST = 5 * MiB;
constexpr size_t WS_SM = 9 * MiB;
constexpr size_t WS_WB = 16 * MiB;
constexpr size_t WB_IN = 0, WB_OUT = 6 * MiB, WB_GU = 8 * MiB, WB_DN = 40 * MiB;
constexpr size_t WS_P = 72 * MiB;
constexpr size_t WS_HID = WS_P + 144 * MiB;
constexpr size_t WS_H = 264 * MiB;
constexpr size_t WS_Y = 328 * MiB;
constexpr size_t WS_YRAW = 392 * MiB;
constexpr size_t WS_END = 520 * MiB;
static_assert((size_t)MAXROWS * DM * 2 <= 144 * MiB && (size_t)MAXROWS * DE * 2 <= 48 * MiB, "moe overlay");
constexpr int CW_BAR = 4096;
constexpr int CW_CNT = 16384;

constexpr int LDS_MISC = 147456;
constexpr int LDS_BYTES = LDS_MISC + 2048;

struct Args {
    const float* in[36]; float* out; unsigned char* ws; int ph_lo, ph_hi;
};
enum { I_X = 0, I_C, I_WADA, I_BADA, I_NMIX, I_NFFN, I_WIN, I_WOUT, I_S5ARE, I_S5AIM, I_S5BRE, I_S5BIM, I_S5CRE, I_S5CIM, I_S5D, I_S5LDT, I_S5GLU, I_S5NORM,
       I_GCW, I_GALOG, I_GDTB, I_GNORM, I_SCW, I_SCB, I_SALOG, I_SDTB, I_SD, I_SNORM, I_MWG, I_MBG, I_MWR, I_MBR, I_MGATE, I_MUP, I_MDOWN, I_NFIN };

struct Ctx { LAS unsigned char* lds; volatile LAS int* misc; unsigned char* ws; float* out; int tid, lane, wave, G, bid; };
constexpr int MISC_PTR = 448;
__device__ __forceinline__ const float* inptr(const Ctx& F, int i) { unsigned lo = (unsigned)F.misc[MISC_PTR + 2 * i], hi = (unsigned)F.misc[MISC_PTR + 2 * i + 1];
    lo = __builtin_amdgcn_readfirstlane(lo); hi = __builtin_amdgcn_readfirstlane(hi); return (const float*)(((unsigned long long)hi << 32) | lo); }

__device__ __forceinline__ Ctx launder(const Ctx& F) { Ctx G = F; int t = F.tid; asm volatile("" : "+v"(t)); G.tid = t; G.lane = t & 63; G.wave = __builtin_amdgcn_readfirstlane(t >> 6);
    unsigned long long w = (unsigned long long)F.ws, o = (unsigned long long)F.out; unsigned l0 = (unsigned)(unsigned long long)F.lds; int gg = F.G, bb = F.bid; asm volatile("" : "+s"(w), "+s"(o), "+s"(l0), "+s"(gg), "+s"(bb)); G.G = gg; G.bid = bb;
    G.ws = (unsigned char*)w; G.out = (float*)o; G.lds = (LAS unsigned char*)(unsigned long long)l0; G.misc = (volatile LAS int*)(G.lds + LDS_MISC); return G; }
#define LDS_WAIT() asm volatile("s_waitcnt lgkmcnt(0)" ::: "memory")
#define VM_WAIT() asm volatile("s_waitcnt vmcnt(0)" ::: "memory")

__device__ __forceinline__ float bf2f(unsigned v) { return __uint_as_float(v << 16); }
__device__ __forceinline__ unsigned f2bf(float f) { unsigned u = __float_as_uint(f); return (u + 0x7fffu + ((u >> 16) & 1u)) >> 16; }
__device__ __forceinline__ unsigned pk2(float lo, float hi) { return f2bf(lo) | (f2bf(hi) << 16); }
__device__ __forceinline__ float wave_sum(float v) {
#pragma unroll
    for (int o = 1; o < 64; o <<= 1) v += __shfl_xor(v, o);
    return v;
}
__device__ __forceinline__ float sigm(float x) { return 1.f / (1.f + __expf(-x)); }
__device__ __forceinline__ float silu_f(float x) { return x / (1.f + __expf(-x)); }
__device__ __forceinline__ float log1p_small(float e) { return e < 0.03125f ? e * (1.f + e * (-0.5f + e * (0.33333334f - 0.25f * e))) : __logf(1.f + e); }
__device__ __forceinline__ float softplus_f(float x) { return fmaxf(x, 0.f) + log1p_small(__expf(-fabsf(x))); }
__device__ __forceinline__ float gelu_tanh(float x) { const float u = 0.7978845608028654f * (x + 0.044715f * x * x * x); return x / (1.f + __expf(-2.f * u)); }
__device__ __forceinline__ float dot4(v4f a, v4f b) { return (a.x * b.x + a.y * b.y) + (a.z * b.z + a.w * b.w); }

#define XB_TMO      128
#define XB_XCNT(j)  (256  + 64 * (j))
#define XB_XSUB(j)  (1280 + 64 * (j))
#define XB_XGEN(j)  (2304 + 64 * (j))
#define XB_TOP      3328
#define XB_TOPGEN   3392
#define XCD_BAR_WORDS 3456
#define XB_SPIN_CAP (1u << 20)
__device__ __forceinline__ unsigned xb_ld(unsigned* p)              { return __hip_atomic_load(p, __ATOMIC_RELAXED, __HIP_MEMORY_SCOPE_AGENT); }
__device__ __forceinline__ unsigned xb_add(unsigned* p, unsigned v) { return __hip_atomic_fetch_add(p, v, __ATOMIC_RELAXED, __HIP_MEMORY_SCOPE_AGENT); }
__device__ __forceinline__ unsigned xb_xcc_id() { return (unsigned)__builtin_amdgcn_s_getreg((3 << 11) | 20) & 0xFu; }
#define XB_SPIN(cond, bar) do { unsigned _sp = 0; while (cond) { __builtin_amdgcn_s_sleep(1); \
    if ((++_sp & 255u) == 0u) { if (xb_ld(&(bar)[XB_TMO])) break; if (_sp > XB_SPIN_CAP) { atomicAdd(&(bar)[XB_TMO], 1u); break; } } } } while (0)
struct XcdBarrier { unsigned* bar; unsigned x; volatile LAS unsigned* st; };
__device__ __forceinline__ XcdBarrier xcd_barrier_post(unsigned* bar, volatile LAS unsigned* st) {
    XcdBarrier b; b.bar = bar; b.x = xb_xcc_id(); b.st = st;
    if (threadIdx.x == 0) (void)xb_add(&bar[XB_XCNT(b.x)], 1u);
    return b;
}
__device__ __forceinline__ void xcd_barrier_complete(unsigned* bar, unsigned x, unsigned& nloc, unsigned& nx) {
    const unsigned G = gridDim.x * gridDim.y * gridDim.z;
    unsigned sum, cnt, mine, sp = 0u;
    for (;;) {
        sum = 0u; cnt = 0u; mine = 0u;
#pragma unroll
        for (unsigned j = 0; j < 16; ++j) { const unsigned c = xb_ld(&bar[XB_XCNT(j)]); sum += c; cnt += (c > 0u) ? 1u : 0u; mine = (j == x) ? c : mine; }
        if (sum == G) break;
        __builtin_amdgcn_s_sleep(1);
        if ((++sp & 255u) == 0u) { if (xb_ld(&bar[XB_TMO])) break; if (sp > XB_SPIN_CAP) { atomicAdd(&bar[XB_TMO], 1u); break; } }
    }
    nloc = mine > 0u ? mine : 1u; nx = cnt > 0u ? cnt : 1u;
}
__device__ __forceinline__ void xcd_barrier(const XcdBarrier& b) {
    asm volatile("s_waitcnt vmcnt(0)" ::: "memory");
    __syncthreads();
    if (threadIdx.x == 0) {
        unsigned* bar = b.bar;
        __builtin_amdgcn_s_waitcnt(0);
        unsigned nloc = b.st[0], nx = b.st[1];
        if (nloc == 0u) { xcd_barrier_complete(bar, b.x, nloc, nx); b.st[0] = nloc; b.st[1] = nx; }
        const unsigned old = xb_add(&bar[XB_XSUB(b.x)], 1u);
        const unsigned gen = old / nloc;
        if (old + 1u == (gen + 1u) * nloc) {
            __builtin_amdgcn_fence(__ATOMIC_RELEASE, "agent");
            asm volatile("s_waitcnt vmcnt(0)" ::: "memory");
            const unsigned og = xb_add(&bar[XB_TOP], 1u);
            const unsigned tg = og / nx;
            if (og + 1u == (tg + 1u) * nx) xb_add(&bar[XB_TOPGEN], 1u);
            else XB_SPIN(xb_ld(&bar[XB_TOPGEN]) == tg, bar);
            __builtin_amdgcn_fence(__ATOMIC_ACQUIRE, "agent");
            xb_add(&bar[XB_XGEN(b.x)], 1u);
            asm volatile("s_waitcnt vmcnt(0)" ::: "memory");
        } else {
            XB_SPIN(xb_ld(&bar[XB_XGEN(b.x)]) == gen, bar);
            __builtin_amdgcn_fence(__ATOMIC_ACQUIRE, "agent");
            asm volatile("s_waitcnt vmcnt(0)" ::: "memory");
        }
    }
    __syncthreads();
}

__device__ __forceinline__ void ph_prologue(const Ctx& F0) {
    Ctx F = launder(F0);
    float* SMW = (float*)(F.ws + WS_SMW); float* RW = (float*)(F.ws + WS_RW); float* MOD = (float*)(F.ws + WS_MOD);
    const int gt = F.bid * 512 + F.tid, NT = F.G * 512;
    const float* p_win = inptr(F, I_WIN); const float* p_mwg = inptr(F, I_MWG); const float* p_mwr = inptr(F, I_MWR); const float* p_c = inptr(F, I_C); const float* p_bada = inptr(F, I_BADA);
    for (int i = gt; i < NL * 54 * DM; i += NT) {
        const int l = i / (54 * DM), r = i % (54 * DM), j = r / DM, k = r % DM;
        if (j < 18) { const int col = j < 12 ? 1792 + j : 3084 + (j - 12); SMW[(l * 18 + j) * DM + k] = p_win[((size_t)l * DM + k) * DIN + col]; }
        else { const int jj = j - 18; RW[(l * 36 + jj) * DM + k] = jj < 4 ? p_mwg[((size_t)l * DM + k) * 4 + jj] : p_mwr[((size_t)l * DM + k) * 32 + (jj - 4)]; }
    }
    LAS float* cond = (LAS float*)F.lds; LAS float* red = (LAS float*)(F.lds + 32768);
    for (int item = F.bid; item < NL * 24; item += F.G) {
        for (int i = F.tid; i < NB * DM; i += 512) cond[i] = silu_f(p_c[i]);
        __syncthreads();
        const int l = item / 24, cg = item % 24;
        v4f acc[NB];
#pragma unroll
        for (int b = 0; b < NB; ++b) acc[b] = (v4f){0.f, 0.f, 0.f, 0.f};
        const float* wp = inptr(F, I_WADA) + ((size_t)l * DM + F.wave * 128) * (6 * DM) + cg * 256 + 4 * F.lane;
#pragma unroll 8
        for (int kk = 0; kk < 128; ++kk) {
            const v4f w = *(const v4f*)(wp + (size_t)kk * (6 * DM)); const int k = F.wave * 128 + kk;
#pragma unroll
            for (int b = 0; b < NB; ++b) acc[b] += cond[b * DM + k] * w;
        }
#pragma unroll
        for (int b = 0; b < NB; ++b) *(LAS v4f*)(red + (F.wave * NB + b) * 256 + 4 * F.lane) = acc[b];
        __syncthreads();
        for (int o = F.tid; o < NB * 256; o += 512) { const int b = o / 256, col = o % 256; float s = 0.f;
#pragma unroll
            for (int w = 0; w < 8; ++w) s += red[(w * NB + b) * 256 + col];
            MOD[((size_t)l * NB + b) * (6 * DM) + cg * 256 + col] = s + p_bada[l * 6 * DM + cg * 256 + col]; }
        __syncthreads();
    }
}

__device__ __forceinline__ void transpose_item(const float* W, int ldw, int K, bf16* WT, int k0, int nsrc0, int ndst0, LAS float* scr, int lane) {
#pragma unroll 8
    for (int i = 0; i < 32; ++i) { const int kk = 2 * i + (lane >> 5); scr[kk * 33 + (lane & 31)] = W[(size_t)(k0 + kk) * ldw + nsrc0 + (lane & 31)]; }
    LDS_WAIT();
    const int c = lane & 7;
#pragma unroll
    for (int j = 0; j < 4; ++j) { const int n = (lane >> 3) + 8 * j; const LAS float* s = scr + (8 * c) * 33 + n;
        v4u o; o.x = pk2(s[0 * 33], s[1 * 33]); o.y = pk2(s[2 * 33], s[3 * 33]); o.z = pk2(s[4 * 33], s[5 * 33]); o.w = pk2(s[6 * 33], s[7 * 33]);
        *(v4u*)(WT + (size_t)(ndst0 + n) * K + k0 + 8 * c) = o; }
    LDS_WAIT();
}
constexpr int CV_IN = 16 * 96, CV_OUT = 16 * 32, CV_G = NE * 16 * 8, CV_D = NE * 4 * 32, CV_ITEMS = CV_IN + CV_OUT + 2 * CV_G + CV_D;
__device__ __forceinline__ void convert_item(Ctx& F, int l, int it, LAS float* scr, int lane) {
    unsigned char* wb = F.ws + WS_WB;
    if (it < CV_IN) { const int kb = it / 96, nb = it % 96, nd = 32 * nb, ns = nd + (nd >= 1792 ? 12 : 0);
        transpose_item(inptr(F, I_WIN) + (size_t)l * DM * DIN, DIN, DM, (bf16*)(wb + WB_IN), 64 * kb, ns, nd, scr, lane); return; }
    it -= CV_IN;
    if (it < CV_OUT) { const int kb = it / 32, nb = it % 32;
        transpose_item(inptr(F, I_WOUT) + (size_t)l * DM * DM, DM, DM, (bf16*)(wb + WB_OUT), 64 * kb, 32 * nb, 32 * nb, scr, lane); return; }
    it -= CV_OUT;
    if (it < 2 * CV_G) { const int up = it >= CV_G; if (up) it -= CV_G; const int e = it / 128, r = it % 128, kb = r / 8, nb = r % 8, j0 = 32 * nb;
        const int nd = 256 * (j0 / 128) + (j0 % 128) + (up ? 128 : 0);
        transpose_item(inptr(F, up ? I_MUP : I_MGATE) + ((size_t)l * NE + e) * DM * DE, DE, DM, (bf16*)(wb + WB_GU) + (size_t)e * 512 * DM, 64 * kb, j0, nd, scr, lane); return; }
    it -= 2 * CV_G;
    { const int e = it / 128, r = it % 128, kb = r / 32, nb = r % 32;
        transpose_item(inptr(F, I_MDOWN) + ((size_t)l * NE + e) * DE * DM, DM, DE, (bf16*)(wb + WB_DN) + (size_t)e * DM * DE, 64 * kb, 32 * nb, 32 * nb, scr, lane); }
}

__device__ __forceinline__ void build_tiles(const Ctx& F, int lc) {
    if (F.tid == 0) {
        const unsigned* cnt = (const unsigned*)(F.ws + WS_CTL) + CW_CNT + lc * NE; int acc = 0;
        for (int e = 0; e < NE; ++e) { const int c = (int)__hip_atomic_load(cnt + e, __ATOMIC_RELAXED, __HIP_MEMORY_SCOPE_AGENT); F.misc[16 + e] = acc; F.misc[64 + e] = c;
            const int nt = (c + 255) / 256; for (int t = 0; t < nt; ++t) F.misc[128 + acc + t] = e; acc += nt; }
        F.misc[16 + NE] = acc;
    }
}

__device__ __forceinline__ void ph_n1(const Ctx& F0, int l, int mode) {
    Ctx F = launder(F0);
    const float* MOD = (const float*)(F.ws + WS_MOD);
    const int lp = mode ? NL - 1 : l - 1;
    LAS float* sw = (LAS float*)F.lds;
    if (mode == 0) {
        const float* SMW = (const float*)(F.ws + WS_SMW) + (size_t)l * 18 * DM;
        for (int i = F.tid; i < 18 * DM / 4; i += 512) ((LAS v4f*)sw)[i] = ((const v4f*)SMW)[i];
    }
    if (lp >= 0) build_tiles(F, lp);
    __syncthreads();
    if (mode == 0) {
        LAS float* scr = (LAS float*)(F.lds + 73728 + F.wave * 8448);
        for (int it = F.wave * F.G + F.bid; it < CV_ITEMS; it += 8 * F.G) convert_item(F, l, it, scr, F.lane);
    }
    const int NGW = F.G * 8, gw = F.bid * 8 + F.wave, rows_per = (NTOK + NGW - 1) / NGW;
    const int r0 = gw * rows_per, r1 = (r0 + rows_per) < NTOK ? (r0 + rows_per) : NTOK;
    const float* xin = (mode == 0 && l == 0) ? inptr(F, I_X) : F.out;
    const bf16* MO = (const bf16*)(F.ws + WS_P); const int* TI = (const int*)(F.ws + WS_TI);
    bf16* H = (bf16*)(F.ws + WS_H); float* SM = (float*)(F.ws + WS_SM);
    int curb = -1; v4f An[4], Bn[4], Gp[4];
    float tc_a = 0.f, tc_b = 0.f;
    if (mode == 0) { if (F.lane < 6) { tc_a = -expf(inptr(F, I_GALOG)[l * 6 + F.lane]); tc_b = inptr(F, I_GDTB)[l * 6 + F.lane]; } else if (F.lane >= 12 && F.lane < 18) tc_b = inptr(F, I_SDTB)[l * 6 + F.lane - 12]; }
    const float* p_nrm = inptr(F, mode == 0 ? I_NMIX : I_NFIN);
#pragma unroll
    for (int j = 0; j < 4; ++j) { An[j] = (v4f){0, 0, 0, 0}; Bn[j] = An[j]; Gp[j] = An[j]; }
    for (int row = r0; row < r1; ++row) {
        const int b = row >> 12;
        if (b != curb) { curb = b;
#pragma unroll
            for (int j = 0; j < 4; ++j) { const int c = 4 * F.lane + 256 * j;
                if (mode == 0) { const v4f nm = *(const v4f*)(p_nrm + l * DM + c), sc = *(const v4f*)(MOD + ((size_t)l * NB + b) * 6 * DM + 1 * DM + c), sh = *(const v4f*)(MOD + ((size_t)l * NB + b) * 6 * DM + c);
                    An[j] = nm * (1.f + sc); Bn[j] = sh; }
                else { An[j] = *(const v4f*)(p_nrm + c); Bn[j] = (v4f){0, 0, 0, 0}; }
                if (lp >= 0) Gp[j] = *(const v4f*)(MOD + ((size_t)lp * NB + b) * 6 * DM + 5 * DM + c); }
        }
        v4f v[4];
#pragma unroll
        for (int j = 0; j < 4; ++j) v[j] = *(const v4f*)(xin + (size_t)row * DM + 4 * F.lane + 256 * j);
        if (lp >= 0) {
            const int e0 = TI[row * 8 + 0], s0 = TI[row * 8 + 1], e1 = TI[row * 8 + 3], s1 = TI[row * 8 + 4];
            const float w0 = __int_as_float(TI[row * 8 + 2]), w1 = __int_as_float(TI[row * 8 + 5]);
            const size_t ra = (size_t)(F.misc[16 + e0] * 256 + s0), rb = (size_t)(F.misc[16 + e1] * 256 + s1);
#pragma unroll
            for (int j = 0; j < 4; ++j) { const v2u a = *(const v2u*)(MO + ra * DM + 4 * F.lane + 256 * j), c = *(const v2u*)(MO + rb * DM + 4 * F.lane + 256 * j);
                const v4f ya = (v4f){bf2f(a.x & 0xffffu), bf2f(a.x >> 16), bf2f(a.y & 0xffffu), bf2f(a.y >> 16)}, yb = (v4f){bf2f(c.x & 0xffffu), bf2f(c.x >> 16), bf2f(c.y & 0xffffu), bf2f(c.y >> 16)};
                v[j] += Gp[j] * (w0 * ya + w1 * yb); }
            if (mode == 0) {
#pragma unroll
                for (int j = 0; j < 4; ++j) *(v4f*)(F.out + (size_t)row * DM + 4 * F.lane + 256 * j) = v[j];
            }
        }
        float ss = 0.f;
#pragma unroll
        for (int j = 0; j < 4; ++j) ss += dot4(v[j], v[j]);
        const float rs = rsqrtf(wave_sum(ss) * (1.f / DM) + EPS);
        v4f h[4];
#pragma unroll
        for (int j = 0; j < 4; ++j) h[j] = v[j] * rs * An[j] + Bn[j];
        if (mode == 1) {
#pragma unroll
            for (int j = 0; j < 4; ++j) *(v4f*)(F.out + (size_t)row * DM + 4 * F.lane + 256 * j) = h[j];
            continue;
        }
#pragma unroll
        for (int j = 0; j < 4; ++j) { v2u o; o.x = pk2(h[j].x, h[j].y); o.y = pk2(h[j].z, h[j].w); *(v2u*)(H + (size_t)row * DM + 4 * F.lane + 256 * j) = o; }
        float mine = 0.f;
#pragma unroll 2
        for (int c = 0; c < 18; ++c) { float s = 0.f;
#pragma unroll
            for (int j = 0; j < 4; ++j) s += dot4(h[j], ((const LAS v4f*)sw)[c * 256 + 64 * j + F.lane]);
            s = wave_sum(s); mine = (F.lane == c) ? s : mine; }
        if (F.lane < 18) { float r;
            if (F.lane < 6) r = tc_a * softplus_f(mine + tc_b);
            else if (F.lane < 12) r = sigm(mine);
            else r = softplus_f(mine + tc_b);
            SM[(size_t)row * 18 + F.lane] = r; }
    }
}

constexpr int TB = 8;
__device__ __forceinline__ void gdn_naive(Ctx& F, int l, int b, int hh, int cq, LAS float* wl, int lane) {
    const bf16* P = (const bf16*)(F.ws + WS_P); const float* SM = (const float*)(F.ws + WS_SM); float* YR = (float*)(F.ws + WS_YRAW);
    const int el = lane & 15, dq = lane >> 4;
    float S[16];
#pragma unroll
    for (int i = 0; i < 16; ++i) S[i] = 0.f;
    const float* cw = inptr(F, I_GCW) + (size_t)l * 4 * 1152; const int chq = hh * 64 + lane, chk = 384 + chq, chv = 768 + chq;
    float wq[4], wk[4], wv[4];
#pragma unroll
    for (int j = 0; j < 4; ++j) { wq[j] = cw[j * 1152 + chq]; wk[j] = cw[j * 1152 + chk]; wv[j] = cw[j * 1152 + chv]; }
    float q1 = 0, q2 = 0, q3 = 0, k1 = 0, k2 = 0, k3 = 0, v1 = 0, v2 = 0, v3 = 0;
    for (int t0 = 0; t0 < SEQ; t0 += TB) {
        float xq[TB], xk[TB], xv[TB], gg[TB], bb[TB];
#pragma unroll
        for (int i = 0; i < TB; ++i) { const size_t row = (size_t)b * SEQ + t0 + i; const bf16* pr = P + row * NP + PC_GQKV;
            xq[i] = bf2f(pr[chq]); xk[i] = bf2f(pr[chk]); xv[i] = bf2f(pr[chv]); gg[i] = SM[row * 18 + hh]; bb[i] = SM[row * 18 + 6 + hh]; }
#pragma unroll
        for (int i = 0; i < TB; ++i) {
            const size_t row = (size_t)b * SEQ + t0 + i;
            float cq_ = wq[0] * q3 + wq[1] * q2 + wq[2] * q1 + wq[3] * xq[i]; q3 = q2; q2 = q1; q1 = xq[i];
            float ck_ = wk[0] * k3 + wk[1] * k2 + wk[2] * k1 + wk[3] * xk[i]; k3 = k2; k2 = k1; k1 = xk[i];
            float cv_ = wv[0] * v3 + wv[1] * v2 + wv[2] * v1 + wv[3] * xv[i]; v3 = v2; v2 = v1; v1 = xv[i];
            cq_ = silu_f(cq_); ck_ = silu_f(ck_); cv_ = silu_f(cv_);
            const float qn = cq_ * rsqrtf(wave_sum(cq_ * cq_) + EPS) * 0.125f, kn = ck_ * rsqrtf(wave_sum(ck_ * ck_) + EPS);
            wl[lane] = qn; wl[64 + lane] = kn; wl[128 + lane] = cv_;
            LDS_WAIT();
            float kd[16], qd[16];
#pragma unroll
            for (int j = 0; j < 4; ++j) { const v4f a = *(const LAS v4f*)(wl + 64 + 16 * dq + 4 * j), c = *(const LAS v4f*)(wl + 16 * dq + 4 * j);
                kd[4 * j] = a.x; kd[4 * j + 1] = a.y; kd[4 * j + 2] = a.z; kd[4 * j + 3] = a.w; qd[4 * j] = c.x; qd[4 * j + 1] = c.y; qd[4 * j + 2] = c.z; qd[4 * j + 3] = c.w; }
            const float ve = wl[128 + 16 * cq + el];
            LDS_WAIT();
            const float a = __expf(gg[i]);
            float ks = 0.f;
#pragma unroll
            for (int j = 0; j < 16; ++j) ks += kd[j] * S[j];
            ks += __shfl_xor(ks, 16); ks += __shfl_xor(ks, 32);
            const float vn = bb[i] * (ve - a * ks);
            float o = 0.f;
#pragma unroll
            for (int j = 0; j < 16; ++j) { S[j] = a * S[j] + kd[j] * vn; o += qd[j] * S[j]; }
            o += __shfl_xor(o, 16); o += __shfl_xor(o, 32);
            if (dq == 0) YR[row * DM + 256 + hh * 64 + 16 * cq + el] = o;
        }
    }
}
__device__ __forceinline__ void ssd_naive(Ctx& F, int l, int b, int hh, int pq, LAS float* wl, int lane) {
    const bf16* P = (const bf16*)(F.ws + WS_P); const float* SM = (const float*)(F.ws + WS_SM); float* YR = (float*)(F.ws + WS_YRAW);
    const int pl = lane & 15, nq = lane >> 4, gi = hh / 3, p = 16 * pq + pl;
    float hs[32];
#pragma unroll
    for (int i = 0; i < 32; ++i) hs[i] = 0.f;
    const float* cw = inptr(F, I_SCW) + (size_t)l * 4 * 896; const float* cb = inptr(F, I_SCB) + (size_t)l * 896;
    const int cB0 = 384 + gi * 128 + lane, cB1 = cB0 + 64, cC0 = 640 + gi * 128 + lane, cC1 = cC0 + 64, cX = hh * 64 + p;
    float wB0[4], wB1[4], wC0[4], wC1[4], wX[4];
#pragma unroll
    for (int j = 0; j < 4; ++j) { wB0[j] = cw[j * 896 + cB0]; wB1[j] = cw[j * 896 + cB1]; wC0[j] = cw[j * 896 + cC0]; wC1[j] = cw[j * 896 + cC1]; wX[j] = cw[j * 896 + cX]; }
    const float bB0 = cb[cB0], bB1 = cb[cB1], bC0 = cb[cC0], bC1 = cb[cC1], bX = cb[cX];
    const float Aneg = -expf(inptr(F, I_SALOG)[l * 6 + hh]), Dsk = inptr(F, I_SD)[l * 6 + hh];
    float hB0[3] = {0, 0, 0}, hB1[3] = {0, 0, 0}, hC0[3] = {0, 0, 0}, hC1[3] = {0, 0, 0}, hX[3] = {0, 0, 0};
    for (int t0 = 0; t0 < SEQ; t0 += TB) {
        float xB0[TB], xB1[TB], xC0[TB], xC1[TB], xX[TB], xZ[TB], dts[TB];
#pragma unroll
        for (int i = 0; i < TB; ++i) { const size_t row = (size_t)b * SEQ + t0 + i; const bf16* pr = P + row * NP;
            xB0[i] = bf2f(pr[PC_SX + cB0]); xB1[i] = bf2f(pr[PC_SX + cB1]); xC0[i] = bf2f(pr[PC_SX + cC0]); xC1[i] = bf2f(pr[PC_SX + cC1]); xX[i] = bf2f(pr[PC_SX + cX]);
            xZ[i] = bf2f(pr[PC_SZ + hh * 64 + p]); dts[i] = SM[row * 18 + 12 + hh]; }
#pragma unroll
        for (int i = 0; i < TB; ++i) {
            const size_t row = (size_t)b * SEQ + t0 + i;
#define CONV1(w, hst, x, bias) ({ float _y = w[0] * hst[2] + w[1] * hst[1] + w[2] * hst[0] + w[3] * (x) + (bias); hst[2] = hst[1]; hst[1] = hst[0]; hst[0] = (x); silu_f(_y); })
            const float vB0 = CONV1(wB0, hB0, xB0[i], bB0), vB1 = CONV1(wB1, hB1, xB1[i], bB1), vC0 = CONV1(wC0, hC0, xC0[i], bC0), vC1 = CONV1(wC1, hC1, xC1[i], bC1), vX = CONV1(wX, hX, xX[i], bX);
#undef CONV1
            wl[lane] = vB0; wl[64 + lane] = vB1; wl[128 + lane] = vC0; wl[192 + lane] = vC1;
            LDS_WAIT();
            float Bv[32], Cv[32];
#pragma unroll
            for (int j = 0; j < 8; ++j) { const v4f a = *(const LAS v4f*)(wl + 32 * nq + 4 * j), c = *(const LAS v4f*)(wl + 128 + 32 * nq + 4 * j);
                Bv[4 * j] = a.x; Bv[4 * j + 1] = a.y; Bv[4 * j + 2] = a.z; Bv[4 * j + 3] = a.w; Cv[4 * j] = c.x; Cv[4 * j + 1] = c.y; Cv[4 * j + 2] = c.z; Cv[4 * j + 3] = c.w; }
            LDS_WAIT();
            const float dt = dts[i], dA = __expf(dt * Aneg), xdt = vX * dt;
            float y = 0.f;
#pragma unroll
            for (int j = 0; j < 32; ++j) { hs[j] = dA * hs[j] + xdt * Bv[j]; y += Cv[j] * hs[j]; }
            y += __shfl_xor(y, 16); y += __shfl_xor(y, 32);
            y = (y + Dsk * vX) * silu_f(xZ[i]);
            if (nq == 0) YR[row * DM + 640 + hh * 64 + p] = y;
        }
    }
}
__device__ __forceinline__ void s5_naive(Ctx& F, int l, int b, int g, int lane) {
    const bf16* P = (const bf16*)(F.ws + WS_P); float* YR = (float*)(F.ws + WS_YRAW);
    const int gp = (l * 16 + g) * 64 + lane;
    const float are = inptr(F, I_S5ARE)[gp], aim = inptr(F, I_S5AIM)[gp], step = expf(inptr(F, I_S5LDT)[l * 16 + g]);
    const float mag = expf(are * step); float sn, cs; sincosf(aim * step, &sn, &cs);
    const float lbr = mag * cs, lbi = mag * sn;
    const float nr = lbr - 1.f, ni = lbi, den = are * are + aim * aim;
    const float fr = (nr * are + ni * aim) / den, fi = (ni * are - nr * aim) / den;
    float Br[16], Bi[16], Cr[16], Ci[16], Dk[16];
#pragma unroll
    for (int c = 0; c < 16; ++c) { const float br = inptr(F, I_S5BRE)[(size_t)gp * 16 + c], bi = inptr(F, I_S5BIM)[(size_t)gp * 16 + c];
        Br[c] = fr * br - fi * bi; Bi[c] = fr * bi + fi * br;
        Cr[c] = inptr(F, I_S5CRE)[((size_t)(l * 16 + g) * 16 + c) * 64 + lane]; Ci[c] = inptr(F, I_S5CIM)[((size_t)(l * 16 + g) * 16 + c) * 64 + lane];
        Dk[c] = inptr(F, I_S5D)[l * 256 + g * 16 + c]; }
    float sr = 0.f, si = 0.f;
    for (int t0 = 0; t0 < SEQ; t0 += TB) {
        v4u ua[TB], ub[TB];
#pragma unroll
        for (int i = 0; i < TB; ++i) { const size_t row = (size_t)b * SEQ + t0 + i; const v4u* pr = (const v4u*)(P + row * NP + PC_S5 + g * 16); ua[i] = pr[0]; ub[i] = pr[1]; }
#pragma unroll
        for (int i = 0; i < TB; ++i) {
            const size_t row = (size_t)b * SEQ + t0 + i;
            float u[16];
            u[0] = bf2f(ua[i].x & 0xffffu); u[1] = bf2f(ua[i].x >> 16); u[2] = bf2f(ua[i].y & 0xffffu); u[3] = bf2f(ua[i].y >> 16);
            u[4] = bf2f(ua[i].z & 0xffffu); u[5] = bf2f(ua[i].z >> 16); u[6] = bf2f(ua[i].w & 0xffffu); u[7] = bf2f(ua[i].w >> 16);
            u[8] = bf2f(ub[i].x & 0xffffu); u[9] = bf2f(ub[i].x >> 16); u[10] = bf2f(ub[i].y & 0xffffu); u[11] = bf2f(ub[i].y >> 16);
            u[12] = bf2f(ub[i].z & 0xffffu); u[13] = bf2f(ub[i].z >> 16); u[14] = bf2f(ub[i].w & 0xffffu); u[15] = bf2f(ub[i].w >> 16);
            float bur = 0.f, bui = 0.f;
#pragma unroll
            for (int c = 0; c < 16; ++c) { bur += Br[c] * u[c]; bui += Bi[c] * u[c]; }
            const float nsr = lbr * sr - lbi * si + bur, nsi = lbr * si + lbi * sr + bui; sr = nsr; si = nsi;
            float mine = 0.f;
#pragma unroll
            for (int c = 0; c < 16; ++c) { float y = wave_sum(Cr[c] * sr - Ci[c] * si) + Dk[c] * u[c]; mine = (lane == c) ? y : mine; }
            if (lane < 16) YR[row * DM + g * 16 + lane] = gelu_tanh(mine);
        }
    }
}
__device__ __forceinline__ void ph_m2(const Ctx& F0, int l) {
    Ctx F = launder(F0);
    const int u = F.wave * F.G + F.bid;
    LAS float* wl = (LAS float*)(F.lds + F.wave * 4096);
    if (u < 192) gdn_naive(F, l, u / 24, (u % 24) / 4, u % 4, wl, F.lane);
    else if (u < 384) { const int v = u - 192; ssd_naive(F, l, v / 24, (v % 24) / 4, v % 4, wl, F.lane); }
    else if (u < 512) { const int v = u - 384; s5_naive(F, l, v / 16, v % 16, F.lane); }
}

__device__ __forceinline__ void ph_m3(const Ctx& F0, int l) {
    Ctx F = launder(F0);
    const bf16* P = (const bf16*)(F.ws + WS_P); const float* YR = (const float*)(F.ws + WS_YRAW); bf16* Y = (bf16*)(F.ws + WS_Y);
    const int NGW = F.G * 8, gw = F.bid * 8 + F.wave;
    LAS float* ys = (LAS float*)(F.lds + F.wave * 8192);
    const float* wg = inptr(F, I_S5GLU) + (size_t)l * 65536;
    const v4f s5n = *(const v4f*)(inptr(F, I_S5NORM) + l * 256 + 4 * F.lane);
    for (int tg = gw; tg < NTOK / 8; tg += NGW) {
        const int tok0 = tg * 8; v4f yv[8];
#pragma unroll
        for (int t = 0; t < 8; ++t) yv[t] = *(const v4f*)(YR + (size_t)(tok0 + t) * DM + 4 * F.lane);
#pragma unroll
        for (int i = 0; i < 4; ++i) { *(LAS v4f*)(ys + (4 * F.lane + i) * 8) = (v4f){yv[0][i], yv[1][i], yv[2][i], yv[3][i]}; *(LAS v4f*)(ys + (4 * F.lane + i) * 8 + 4) = (v4f){yv[4][i], yv[5][i], yv[6][i], yv[7][i]}; }
        LDS_WAIT();
        v4f acc[8];
#pragma unroll
        for (int t = 0; t < 8; ++t) acc[t] = (v4f){0, 0, 0, 0};
#pragma unroll 4
        for (int k = 0; k < 256; ++k) { const v4f w = *(const v4f*)(wg + k * 256 + 4 * F.lane); const v4f a0 = *(const LAS v4f*)(ys + k * 8), a1 = *(const LAS v4f*)(ys + k * 8 + 4);
            acc[0] += a0.x * w; acc[1] += a0.y * w; acc[2] += a0.z * w; acc[3] += a0.w * w; acc[4] += a1.x * w; acc[5] += a1.y * w; acc[6] += a1.z * w; acc[7] += a1.w * w; }
        LDS_WAIT();
#pragma unroll
        for (int t = 0; t < 8; ++t) { v4f v = yv[t]; v.x *= sigm(acc[t].x); v.y *= sigm(acc[t].y); v.z *= sigm(acc[t].z); v.w *= sigm(acc[t].w);
            const float rs = rsqrtf(wave_sum(dot4(v, v)) * (1.f / 256.f) + EPS); v = v * rs * s5n;
            v2u o; o.x = pk2(v.x, v.y); o.y = pk2(v.z, v.w); *(v2u*)(Y + (size_t)(tok0 + t) * DM + 4 * F.lane) = o; }
    }
    const float gn = inptr(F, I_GNORM)[l * 64 + F.lane];
    float sn[6];
#pragma unroll
    for (int j = 0; j < 6; ++j) sn[j] = inptr(F, I_SNORM)[l * 384 + j * 64 + F.lane];
    for (int tok = gw; tok < NTOK; tok += NGW) {
#pragma unroll
        for (int hh = 0; hh < 6; ++hh) { const float o = YR[(size_t)tok * DM + 256 + hh * 64 + F.lane]; const float rs = rsqrtf(wave_sum(o * o) * (1.f / 64.f) + EPS);
            const float z = bf2f(P[(size_t)tok * NP + PC_GZ + hh * 64 + F.lane]);
            Y[(size_t)tok * DM + 256 + hh * 64 + F.lane] = (bf16)f2bf(o * rs * gn * silu_f(z)); }
#pragma unroll
        for (int g = 0; g < 2; ++g) { float v[3], ss = 0.f;
#pragma unroll
            for (int j = 0; j < 3; ++j) { v[j] = YR[(size_t)tok * DM + 640 + g * 192 + j * 64 + F.lane]; ss += v[j] * v[j]; }
            const float rs = rsqrtf(wave_sum(ss) * (1.f / 192.f) + EPS);
#pragma unroll
            for (int j = 0; j < 3; ++j) Y[(size_t)tok * DM + 640 + g * 192 + j * 64 + F.lane] = (bf16)f2bf(v[j] * rs * sn[g * 3 + j]); }
    }
}

__device__ __forceinline__ void ph_n2(const Ctx& F0, int l) {
    Ctx F = launder(F0);
    const float* MOD = (const float*)(F.ws + WS_MOD);
    LAS float* rw = (LAS float*)F.lds;
    { const float* RW = (const float*)(F.ws + WS_RW) + (size_t)l * 36 * DM;
      for (int i = F.tid; i < 36 * DM / 4; i += 512) ((LAS v4f*)rw)[i] = ((const v4f*)RW)[i]; }
    __syncthreads();
    const int NGW = F.G * 8, gw = F.bid * 8 + F.wave, rows_per = (NTOK + NGW - 1) / NGW;
    const int r0 = gw * rows_per, r1 = (r0 + rows_per) < NTOK ? (r0 + rows_per) : NTOK;
    bf16* H = (bf16*)(F.ws + WS_H); int* TI = (int*)(F.ws + WS_TI); int* LIST = (int*)(F.ws + WS_LIST);
    unsigned* cnt = (unsigned*)(F.ws + WS_CTL) + CW_CNT + l * NE;
    int curb = -1; v4f An[4], Bn[4];
    const float* p_nffn = inptr(F, I_NFFN); const float* p_mbg = inptr(F, I_MBG) + l * 4; const float* p_mbr = inptr(F, I_MBR) + l * 32;
#pragma unroll
    for (int j = 0; j < 4; ++j) { An[j] = (v4f){0, 0, 0, 0}; Bn[j] = An[j]; }
    for (int c0 = r0; c0 < r1; c0 += 64) {
        const int c1 = (c0 + 64) < r1 ? (c0 + 64) : r1;
        int me0 = 0, me1 = 0; float mw0 = 0.f, mw1 = 0.f;
        for (int row = c0; row < c1; ++row) {
            const int b = row >> 12;
            if (b != curb) { curb = b;
#pragma unroll
                for (int j = 0; j < 4; ++j) { const int c = 4 * F.lane + 256 * j;
                    const v4f nm = *(const v4f*)(p_nffn + l * DM + c), sc = *(const v4f*)(MOD + ((size_t)l * NB + b) * 6 * DM + 4 * DM + c), sh = *(const v4f*)(MOD + ((size_t)l * NB + b) * 6 * DM + 3 * DM + c);
                    An[j] = nm * (1.f + sc); Bn[j] = sh; }
            }
            v4f v[4]; float ss = 0.f;
#pragma unroll
            for (int j = 0; j < 4; ++j) { v[j] = *(const v4f*)(F.out + (size_t)row * DM + 4 * F.lane + 256 * j); ss += dot4(v[j], v[j]); }
            const float rs = rsqrtf(wave_sum(ss) * (1.f / DM) + EPS);
            v4f h[4];
#pragma unroll
            for (int j = 0; j < 4; ++j) { h[j] = v[j] * rs * An[j] + Bn[j]; v2u o; o.x = pk2(h[j].x, h[j].y); o.y = pk2(h[j].z, h[j].w); *(v2u*)(H + (size_t)row * DM + 4 * F.lane + 256 * j) = o; }
            float lg[4];
#pragma unroll
            for (int c = 0; c < 4; ++c) { float s = 0.f;
#pragma unroll
                for (int j = 0; j < 4; ++j) s += dot4(h[j], ((const LAS v4f*)rw)[c * 256 + 64 * j + F.lane]);
                lg[c] = wave_sum(s) + p_mbg[c]; }
            int gi = 0; float gm = lg[0];
#pragma unroll
            for (int c = 1; c < 4; ++c) if (lg[c] > gm) { gm = lg[c]; gi = c; }
            float den = 0.f;
#pragma unroll
            for (int c = 0; c < 4; ++c) den += __expf(lg[c] - gm);
            const float gwt = 1.f / den;
            float le[8];
#pragma unroll
            for (int c = 0; c < 8; ++c) { float s = 0.f; const LAS v4f* wr_ = (const LAS v4f*)rw + (4 + gi * 8 + c) * 256;
#pragma unroll
                for (int j = 0; j < 4; ++j) s += dot4(h[j], wr_[64 * j + F.lane]);
                le[c] = wave_sum(s) + p_mbr[gi * 8 + c]; }
            int i1 = 0; float v1 = le[0];
#pragma unroll
            for (int c = 1; c < 8; ++c) if (le[c] > v1) { v1 = le[c]; i1 = c; }
            int i2 = -1; float v2 = -3.0e38f;
#pragma unroll
            for (int c = 0; c < 8; ++c) if (c != i1 && le[c] > v2) { v2 = le[c]; i2 = c; }
            const float ex = __expf(v2 - v1), we1 = 1.f / (1.f + ex), we2 = ex / (1.f + ex);
            if (F.lane == row - c0) { me0 = gi * 8 + i1; me1 = gi * 8 + i2; mw0 = gwt * we1; mw1 = gwt * we2; }
        }
        if (c0 + F.lane < c1) {
            const int row = c0 + F.lane;
            const int s0 = (int)__hip_atomic_fetch_add(cnt + me0, 1u, __ATOMIC_RELAXED, __HIP_MEMORY_SCOPE_AGENT);
            const int s1 = (int)__hip_atomic_fetch_add(cnt + me1, 1u, __ATOMIC_RELAXED, __HIP_MEMORY_SCOPE_AGENT);
            int* ti = TI + (size_t)row * 8; ti[0] = me0; ti[1] = s0; ti[2] = __float_as_int(mw0); ti[3] = me1; ti[4] = s1; ti[5] = __float_as_int(mw1);
            LIST[(size_t)me0 * NTOK + s0] = row; LIST[(size_t)me1 * NTOK + s1] = row;
        }
    }
}

__device__ __forceinline__ void ph_e0(const Ctx& F0, int l) {
    Ctx F = launder(F0);
    build_tiles(F, l); __syncthreads();
    const int ntiles = F.misc[16 + NE];
    const bf16* H = (const bf16*)(F.ws + WS_H); bf16* XG = (bf16*)(F.ws + WS_P); const int* LIST = (const int*)(F.ws + WS_LIST);
    for (int tile = F.bid; tile < ntiles; tile += F.G) {
        const int e = F.misc[128 + tile], ts = F.misc[16 + e], ce = F.misc[64 + e];
        for (int r = F.wave; r < 256; r += 8) { const int slot = (tile - ts) * 256 + r;
            if (slot < ce) { const int tok = LIST[(size_t)e * NTOK + slot]; const v4u* s = (const v4u*)(H + (size_t)tok * DM); v4u* d = (v4u*)(XG + ((size_t)tile * 256 + r) * DM);
                d[F.lane] = s[F.lane]; d[64 + F.lane] = s[64 + F.lane]; } }
    }
}

struct EpiResid {
    static constexpr bool PERM = false, AFTER_DRAIN = false;
    const float* xin; float* xout; const float* gate;
    __device__ __forceinline__ void operator()(const pg8::f32x4 (&acc)[2][2][4][2], const pg8::Unit& u, int wr, int wc, int fr, int fq) const {
        const int row0 = u.pm * 256 + wr * 64 + fr, col0 = u.pn * 256 + wc * 32 + 4 * fq, b = u.pm >> 4;
        pg8::f32x4 gv[2][2];
#pragma unroll
        for (int bj = 0; bj < 2; ++bj)
#pragma unroll
            for (int n = 0; n < 2; ++n) gv[bj][n] = *(const pg8::f32x4*)(gate + (size_t)b * 6 * DM + col0 + bj * 128 + n * 16);
#pragma unroll
        for (int ai = 0; ai < 2; ++ai)
#pragma unroll
            for (int m = 0; m < 4; ++m) { const size_t off = (size_t)(row0 + ai * 128 + m * 16) * DM + col0;
#pragma unroll
                for (int bj = 0; bj < 2; ++bj)
#pragma unroll
                    for (int n = 0; n < 2; ++n) { const pg8::f32x4 xv = *(const pg8::f32x4*)(xin + off + bj * 128 + n * 16); *(pg8::f32x4*)(xout + off + bj * 128 + n * 16) = xv + gv[bj][n] * acc[ai][bj][m][n]; } }
    }
};
struct EpiGLU {
    static constexpr bool PERM = true, AFTER_DRAIN = false;
    bf16* O;
    __device__ __forceinline__ void operator()(const pg8::f32x4 (&acc)[2][2][4][2], const pg8::Unit& u, int wr, int wc, int fr, int fq) const {
        const int row0 = u.pm * 256 + wr * 64 + fr, col0 = u.pn * 128 + wc * 32 + 8 * fq;
#pragma unroll
        for (int ai = 0; ai < 2; ++ai)
#pragma unroll
            for (int m = 0; m < 4; ++m) { bf16* rowp = O + (size_t)(row0 + ai * 128 + m * 16) * DE + col0; float hv[8];
#pragma unroll
                for (int n = 0; n < 2; ++n)
#pragma unroll
                    for (int i = 0; i < 4; ++i) { const float g = acc[ai][0][m][n][i], uu = acc[ai][1][m][n][i]; hv[4 * n + i] = g / (1.f + __expf(-g)) * uu; }
                v4u w; w.x = pg8::cvt_pk_bf16(hv[0], hv[1]); w.y = pg8::cvt_pk_bf16(hv[2], hv[3]); w.z = pg8::cvt_pk_bf16(hv[4], hv[5]); w.w = pg8::cvt_pk_bf16(hv[6], hv[7]);
                *(v4u*)rowp = w; }
    }
};
struct MoeOrder {
    int nunits, NT, G, c; volatile LAS int* misc;
    __device__ __forceinline__ bool next(int i, pg8::Unit& u) const { const int L = i * G + c; if (L >= nunits) return false; const int tile = L / NT; u.pm = tile; u.pn = L % NT; u.e = misc[128 + tile]; return true; }
    __device__ __forceinline__ void a_ready(const pg8::Unit&) const {}
    __device__ __forceinline__ void done(const pg8::Unit&) const {}
};

constexpr int PH_PER_LAYER = 9, N_PHASES = 2 + NL * PH_PER_LAYER;

__global__ void __launch_bounds__(512, 2) fwd(Args A) {
    extern __shared__ __attribute__((aligned(16))) unsigned char lds_raw[];
    Ctx F; F.lds = (LAS unsigned char*)lds_raw; F.misc = (volatile LAS int*)(F.lds + LDS_MISC);
    F.tid = threadIdx.x; F.lane = F.tid & 63; F.wave = __builtin_amdgcn_readfirstlane(F.tid >> 6); F.G = gridDim.x; F.bid = blockIdx.x; F.ws = A.ws; F.out = A.out;
    for (int i = F.tid; i < (LDS_BYTES - LDS_MISC) / 4; i += 512) F.misc[i] = 0;
    __syncthreads();
    if (F.tid < 36) { const unsigned long long p = (unsigned long long)A.in[F.tid]; F.misc[MISC_PTR + 2 * F.tid] = (int)(unsigned)p; F.misc[MISC_PTR + 2 * F.tid + 1] = (int)(unsigned)(p >> 32); }
    __syncthreads();
#if ONE_LAUNCH
    XcdBarrier bar = xcd_barrier_post((unsigned*)(F.ws + WS_CTL) + CW_BAR, (volatile LAS unsigned*)F.misc);
#define GRID_BAR() xcd_barrier(bar)
#else
#define GRID_BAR() do {} while (0)
#endif
    const int lo = A.ph_lo, hi = A.ph_hi;
#ifndef DISMASK
#define DISMASK 0
#endif
#define IN(k) (lo <= (k) && (k) < hi)
#define EN(j) (!((DISMASK >> (j)) & 1))
#define SEAM(k) do { if (IN((k) + 1)) GRID_BAR(); } while (0)
    if (EN(9) && IN(0)) { ph_prologue(F); SEAM(0); }
    for (int l = 0; l < NL; ++l) {
        const int p0 = 1 + l * PH_PER_LAYER;
        if (EN(0) && IN(p0 + 0)) { ph_n1(F, l, 0); SEAM(p0 + 0); }
        if (EN(1) && IN(p0 + 1)) { const Ctx P = launder(F);
            pg8::Gemm g{(const bf16*)(P.ws + WS_H), (const bf16*)((P.ws + WS_WB) + WB_IN), NTOK, NP, DM, 0}; pg8::StaticOrder S; S.init(NTOK, NP, P.G, P.bid);
            pg8::EpiBf16<0> E{(bf16*)(P.ws + WS_P), NP, nullptr, 0, 0, 1.f};
            pg8::gemm_phase<pg8::EpiBf16<0>, pg8::StaticOrder, true, true>(P.lds, g, S, E);
            SEAM(p0 + 1); }
        if (EN(2) && IN(p0 + 2)) { ph_m2(F, l); SEAM(p0 + 2); }
        if (EN(3) && IN(p0 + 3)) { ph_m3(F, l); SEAM(p0 + 3); }
        if (EN(4) && IN(p0 + 4)) { const Ctx P = launder(F);
            pg8::Gemm g{(const bf16*)(P.ws + WS_Y), (const bf16*)((P.ws + WS_WB) + WB_OUT), NTOK, DM, DM, 0}; pg8::StaticOrder S; S.init(NTOK, DM, P.G, P.bid);
            EpiResid E{l == 0 ? inptr(F, I_X) : P.out, P.out, (const float*)(P.ws + WS_MOD) + (size_t)l * NB * 6 * DM + 2 * DM};
            pg8::gemm_phase<EpiResid, pg8::StaticOrder, true, true>(P.lds, g, S, E);
            SEAM(p0 + 4); }
        if (EN(5) && IN(p0 + 5)) { ph_n2(F, l); SEAM(p0 + 5); }
        if (EN(6) && IN(p0 + 6)) { ph_e0(F, l); SEAM(p0 + 6); }
        if (EN(7) && IN(p0 + 7)) { const Ctx P = launder(F);
            __syncthreads(); build_tiles(P, l); __syncthreads();
            const int ntiles = P.misc[16 + NE];
            pg8::Gemm g{(const bf16*)(P.ws + WS_P), (const bf16*)((P.ws + WS_WB) + WB_GU), MAXROWS, 512, DM, (size_t)512 * DM * 2};
            MoeOrder S{ntiles * 2, 2, P.G, P.bid, P.misc};
            EpiGLU E{(bf16*)(P.ws + WS_HID)};
            pg8::gemm_phase<EpiGLU, MoeOrder, true, true>(P.lds, g, S, E);
            SEAM(p0 + 7); }
        if (EN(8) && IN(p0 + 8)) { const Ctx P = launder(F);
            __syncthreads(); build_tiles(P, l); __syncthreads();
            const int ntiles = P.misc[16 + NE];
            pg8::Gemm g{(const bf16*)(P.ws + WS_HID), (const bf16*)((P.ws + WS_WB) + WB_DN), MAXROWS, DM, DE, (size_t)DM * DE * 2};
            MoeOrder S{ntiles * 4, 4, P.G, P.bid, P.misc};
            pg8::EpiBf16<0> E{(bf16*)(P.ws + WS_P), DM, nullptr, 0, 0, 1.f};
            pg8::gemm_phase<pg8::EpiBf16<0>, MoeOrder, true, true>(P.lds, g, S, E);
            SEAM(p0 + 8); }
    }
    if (EN(10) && IN(N_PHASES - 1)) ph_n1(F, 0, 1);
}

extern "C" void kernel_launch(void* const* d_in, const int* in_sizes, int n_in, void* d_out, int out_size, void* d_ws, size_t ws_size, hipStream_t stream) {
    static int grid = 0;
    if (grid == 0) {
        if (n_in != 36 || out_size != NTOK * DM || ws_size < WS_END) { fprintf(stderr, "kernel_launch: unexpected shapes: n_in %d out %d ws %zu (need %zu)\n", n_in, out_size, ws_size, (size_t)WS_END); grid = -1; return; }
        int dev = 0, cus = 0, per_cu = 0;
        if (hipGetDevice(&dev) != hipSuccess || hipDeviceGetAttribute(&cus, hipDeviceAttributeMultiprocessorCount, dev) != hipSuccess) { grid = -1; return; }
        if (hipFuncSetAttribute((const void*)fwd, hipFuncAttributeMaxDynamicSharedMemorySize, LDS_BYTES) != hipSuccess) { fprintf(stderr, "kernel_launch: hipFuncSetAttribute failed\n"); grid = -1; return; }
        if (hipOccupancyMaxActiveBlocksPerMultiprocessor(&per_cu, (const void*)fwd, 512, LDS_BYTES) != hipSuccess || per_cu < 1) fprintf(stderr, "kernel_launch: occupancy query says %d\n", per_cu);
        (void)hipGetLastError();
        grid = cus;
    }
    if (grid < 0) return;
    (void)hipMemsetAsync((char*)d_ws + WS_CTL, 0, CTL_BYTES, stream);
    Args a{};
    for (int i = 0; i < 36; ++i) a.in[i] = (const float*)d_in[i];
    a.out = (float*)d_out; a.ws = (unsigned char*)d_ws;
#if ONE_LAUNCH
    a.ph_lo = 0; a.ph_hi = N_PHASES;
    hipLaunchKernelGGL(fwd, dim3(grid), dim3(512), LDS_BYTES, stream, a);
#else
    for (int ph = 0; ph < N_PHASES; ++ph) { a.ph_lo = ph; a.ph_hi = ph + 1; hipLaunchKernelGGL(fwd, dim3(grid), dim3(512), LDS_BYTES, stream, a); }
#endif
}
```

```cpp
#include <hip/hip_runtime.h>
#include <cstdio>
#include <cstdint>
namespace pg8 {
#define PG8_LAS __attribute__((address_space(3)))
typedef unsigned short bf16_t;
typedef short bf16x8 __attribute__((ext_vector_type(8)));
typedef float f32x4 __attribute__((ext_vector_type(4)));
typedef unsigned u32x4 __attribute__((ext_vector_type(4)));
constexpr int BM = 256, BK = 64, HALF = 128, HTB = HALF * BK * 2  , STAGE_BYTES = 8 * HTB, NXCD = 8, WGM = 8;

__host__ __device__ __forceinline__ int lds_byte(int r, int c) { const int st = (r >> 4) * 2 + (c >> 5), rr = r & 15, cc = c & 31, ob = rr * 64 + cc * 2; return st * 1024 + (ob ^ (((ob >> 9) & 1) << 5)); }
__host__ __device__ __forceinline__ void stage_rc(int b, int& R, int& C) { const int st = b / 1024, sb = b % 1024, swz = sb ^ (((sb >> 9) & 1) << 5); R = (st >> 1) * 16 + swz / 64; C = (st & 1) * 32 + (swz % 64) / 2; }
__host__ __device__ __forceinline__ int perm32(int rho) { const int n = rho >> 4, i = rho & 15; return 8 * (i >> 2) + 4 * n + (i & 3); }

struct Unit { int pm, pn, e; };
struct Gemm { const bf16_t* A; const bf16_t* Bt; int M, N, K; size_t estride; };

struct StaticOrder {
    int nM, nN, nwg, G, c;
    __host__ __device__ void init(int M, int N, int G_, int c_) { nM = M / BM; nN = N / BM; nwg = nM * nN; G = G_; c = c_; }
    __host__ __device__ bool next(int i, Unit& u) const {
        const long L = (long)i * G + c; if (L >= nwg) return false;
        int wgid = (int)L; { const int q = nwg / NXCD, r = nwg % NXCD, xcd = wgid % NXCD, off = wgid / NXCD; wgid = (xcd < r ? xcd * (q + 1) : r * (q + 1) + (xcd - r) * q) + off; }
        const int nig = WGM * nN, gid = wgid / nig, fm = gid * WGM, gsz = (nM - fm) < WGM ? (nM - fm) : WGM;
        u.pm = fm + ((wgid % nig) % gsz); u.pn = (wgid % nig) / gsz; u.e = 0; return true;
    }
    __device__ __forceinline__ void a_ready(const Unit&) const {}
    __device__ __forceinline__ void done(const Unit&) const {}
};

__device__ __forceinline__ unsigned cvt_pk_bf16(float lo, float hi) { unsigned r; asm volatile("v_cvt_pk_bf16_f32 %0, %1, %2" : "=v"(r) : "v"(lo), "v"(hi)); return r; }
typedef float f32x2 __attribute__((ext_vector_type(2)));
__device__ __forceinline__ f32x2 gelu_pk(f32x2 v) {
    const f32x2 av = __builtin_elementwise_abs(v), d = av * 0.2316418882f + 1.0f;
    f32x2 t; t.x = __builtin_amdgcn_rcpf(d.x); t.y = __builtin_amdgcn_rcpf(d.y);
    f32x2 q = t * 0.5307027145f + (-0.7265760135f); q = q * t + 0.7107068705f; q = q * t + (-0.142248368f); q = q * t + 0.127414796f; q = q * t;
    const f32x2 s = (v * v) * (-0.72134752044f);
    f32x2 e; e.x = __builtin_amdgcn_exp2f(s.x); e.y = __builtin_amdgcn_exp2f(s.y);
    const f32x2 m = v * (q * e), r = v - m;
    f32x2 o; o.x = v.x < 0.f ? m.x : r.x; o.y = v.y < 0.f ? m.y : r.y; return o;
}

template <int ACT  > struct EpiBf16 {
    static constexpr bool PERM = true, AFTER_DRAIN = false; static_assert(ACT == 0 || ACT == 1, "EpiBf16: ACT is 0 (none) or 1 (gelu_pk)");
    bf16_t* O; int ldc; const float* bias; int split_cols; size_t split_stride; float scale0;
    __device__ __forceinline__ void operator()(const f32x4 (&acc)[2][2][4][2], const Unit& u, int wr, int wc, int fr, int fq) const {
        const int row0 = u.pm * BM + wr * 64 + fr; int colt = u.pn * BM; bf16_t* base = O;
        float sc = 1.f; if (split_cols) { const int t = colt / split_cols; base += (size_t)t * split_stride; colt -= t * split_cols; if (t == 0) sc = scale0; }
        const int col0 = colt + wc * 32 + 8 * fq, bcol0 = u.pn * BM + wc * 32 + 8 * fq;
        f32x4 bv[2][2];
#pragma unroll
        for (int bj = 0; bj < 2; ++bj)
#pragma unroll
            for (int n = 0; n < 2; ++n) bv[bj][n] = bias ? *(const f32x4*)(bias + bcol0 + bj * HALF + 4 * n) : (f32x4){0.f, 0.f, 0.f, 0.f};
#pragma unroll
        for (int ai = 0; ai < 2; ++ai)
#pragma unroll
            for (int m = 0; m < 4; ++m) { bf16_t* rowp = base + (size_t)(row0 + ai * HALF + m * 16) * ldc + col0;
#pragma unroll
                for (int bj = 0; bj < 2; ++bj) { f32x4 v0 = acc[ai][bj][m][0] + bv[bj][0], v1 = acc[ai][bj][m][1] + bv[bj][1];
                    if (ACT == 1) { f32x2 a = gelu_pk((f32x2){v0[0], v0[1]}), b = gelu_pk((f32x2){v0[2], v0[3]}), c = gelu_pk((f32x2){v1[0], v1[1]}), d = gelu_pk((f32x2){v1[2], v1[3]});
                        v0 = (f32x4){a.x, a.y, b.x, b.y}; v1 = (f32x4){c.x, c.y, d.x, d.y}; }
                    v0 = v0 * sc; v1 = v1 * sc; u32x4 w; w.x = cvt_pk_bf16(v0[0], v0[1]); w.y = cvt_pk_bf16(v0[2], v0[3]); w.z = cvt_pk_bf16(v1[0], v1[1]); w.w = cvt_pk_bf16(v1[2], v1[3]);
                    *(u32x4*)(rowp + bj * HALF) = w; } }
    }
};
template <class Epi, class Sched, bool ALIGN_EPI = false, bool SP2 = false>
__device__ __forceinline__ void gemm_phase(PG8_LAS unsigned char* lds, const Gemm g, const Sched& S, const Epi& E) {
    int tid_ = threadIdx.x; asm volatile("" : "+v"(tid_));
    const int tid = tid_, wid = __builtin_amdgcn_readfirstlane(tid >> 6), lane = tid & 63, wr = wid >> 2, wc = wid & 3, fr = lane & 15, fq = lane >> 4;
    const int K = g.K, nt = K / BK;
    unsigned voffA[2], voffB[2];
#pragma unroll
    for (int i = 0; i < 2; ++i) { int R, C; stage_rc(tid * 16 + i * 8192, R, C); const int Rb = Epi::PERM ? ((R & ~31) + perm32(R & 31)) : R;
        voffA[i] = (unsigned)(R * K + C) * 2u; voffB[i] = (unsigned)(Rb * K + C) * 2u; }
    const size_t kstep = (size_t)(BK * 2);
    const size_t hstep = (size_t)HALF * K * 2;
    const size_t tstep = 2 * hstep;
    const unsigned ldsw = (unsigned)wid * 1024u;
    const int aoff = lds_byte(wr * 64 + fr, fq * 8), boff = lds_byte(wc * 32 + fr, fq * 8);
#define PG8_SA(b, h) (((b) * 2 + (h)) * HTB)
#define PG8_SB(b, h) ((4 + (b) * 2 + (h)) * HTB)
#define PG8_STAGE(bufoff, gbase, voff) do { _Pragma("unroll") for (int _i = 0; _i < 2; ++_i) \
        __builtin_amdgcn_global_load_lds((const unsigned*)((const char*)(gbase) + (voff)[_i]), (PG8_LAS unsigned*)(lds + (bufoff) + ldsw + _i * 8192), 16, 0, 0); } while (0)
#define PG8_LDA(dst, b, h) do { _Pragma("unroll") for (int m = 0; m < 4; ++m) _Pragma("unroll") for (int k = 0; k < 2; ++k) dst[m][k] = *(const PG8_LAS bf16x8*)(lds + PG8_SA(b, h) + aoff + m * 2048 + k * 1024); } while (0)
#define PG8_LDB(dst, b, h) do { _Pragma("unroll") for (int n = 0; n < 2; ++n) _Pragma("unroll") for (int k = 0; k < 2; ++k) dst[n][k] = *(const PG8_LAS bf16x8*)(lds + PG8_SB(b, h) + boff + n * 2048 + k * 1024); } while (0)
#define PG8_MMA(ai, bj, At, Bt) do { __builtin_amdgcn_s_setprio(1); _Pragma("unroll") for (int m = 0; m < 4; ++m) _Pragma("unroll") for (int n = 0; n < 2; ++n) _Pragma("unroll") for (int k = 0; k < 2; ++k) \
        acc[ai][bj][m][n] = __builtin_amdgcn_mfma_f32_16x16x32_bf16(Bt[n][k], At[m][k], acc[ai][bj][m][n], 0, 0, 0); __builtin_amdgcn_s_setprio(0); } while (0)
#define PG8_WAIT_V(n) asm volatile("s_waitcnt vmcnt(" #n ")" ::: "memory")
#define PG8_WAIT_L(n) asm volatile("s_waitcnt lgkmcnt(" #n ")" ::: "memory")
#define PG8_BAR __builtin_amdgcn_s_barrier()
#define PG8_SCHED __builtin_amdgcn_sched_barrier(0)
    Unit cur, nxt; int ui = 0;
    if (!S.next(0, cur)) return;
    f32x4 acc[2][2][4][2];
#pragma unroll
    for (int a = 0; a < 2; ++a)
#pragma unroll
        for (int b = 0; b < 2; ++b)
#pragma unroll
            for (int m = 0; m < 4; ++m)
#pragma unroll
                for (int n = 0; n < 2; ++n) acc[a][b][m][n] = (f32x4){0.f, 0.f, 0.f, 0.f};
    bf16x8 At[4][2], B0[2][2], B1[2][2];
    const char* cA = (const char*)g.A + (size_t)cur.pm * tstep; const char* cB = (const char*)g.Bt + (size_t)cur.e * g.estride + (size_t)cur.pn * tstep;
    S.a_ready(cur);
    if constexpr (SP2) {
        PG8_STAGE(PG8_SB(0, 0), cB, voffB); PG8_STAGE(PG8_SB(0, 1), cB + hstep, voffB); PG8_STAGE(PG8_SA(0, 0), cA, voffA); PG8_STAGE(PG8_SA(0, 1), cA + hstep, voffA);
        if (wr == 1) PG8_BAR;
        PG8_WAIT_V(2); PG8_BAR;
        PG8_STAGE(PG8_SB(1, 0), cB + kstep, voffB); PG8_STAGE(PG8_SA(1, 0), cA + kstep, voffA); PG8_STAGE(PG8_SB(1, 1), cB + hstep + kstep, voffB);
        PG8_WAIT_V(6); PG8_BAR;
    } else {
        PG8_STAGE(PG8_SB(0, 0), cB, voffB); PG8_STAGE(PG8_SA(0, 0), cA, voffA); PG8_STAGE(PG8_SB(0, 1), cB + hstep, voffB); PG8_STAGE(PG8_SA(0, 1), cA + hstep, voffA);
        if (wr == 1) PG8_BAR;
        PG8_WAIT_V(4); PG8_BAR;
        PG8_STAGE(PG8_SB(1, 0), cB + kstep, voffB); PG8_STAGE(PG8_SA(1, 0), cA + kstep, voffA); PG8_STAGE(PG8_SB(1, 1), cB + hstep + kstep, voffB);
        PG8_WAIT_V(6); PG8_BAR;
    }
    for (;;) {
        const bool has_next = S.next(ui + 1, nxt);
        const char* nA = has_next ? (const char*)g.A + (size_t)nxt.pm * tstep : cA; const char* nB = has_next ? (const char*)g.Bt + (size_t)nxt.e * g.estride + (size_t)nxt.pn * tstep : cB;
        for (int t = 0; t < nt; t += 2) {
            const bool last = (t == nt - 2);
            const char* a1 = cA + (size_t)(t + 1) * kstep;
            const char* a2 = last ? nA : cA + (size_t)(t + 2) * kstep; const char* b2 = last ? nB : cB + (size_t)(t + 2) * kstep;
            const char* a3 = a2 + kstep; const char* b3 = b2 + kstep;
            if (last && has_next) S.a_ready(nxt);
            if constexpr (SP2) {
            PG8_LDB(B0, 0, 0); PG8_LDB(B1, 0, 1); PG8_SCHED; PG8_LDA(At, 0, 0); PG8_STAGE(PG8_SA(1, 1), a1 + hstep, voffA);
            PG8_WAIT_V(8); PG8_WAIT_L(0); PG8_BAR; PG8_MMA(0, 0, At, B0); PG8_MMA(0, 1, At, B1); PG8_BAR; PG8_SCHED;
            PG8_LDA(At, 0, 1); PG8_STAGE(PG8_SB(0, 0), b2, voffB); PG8_STAGE(PG8_SB(0, 1), b2 + hstep, voffB); PG8_STAGE(PG8_SA(0, 0), a2, voffA);
            PG8_WAIT_V(8); PG8_WAIT_L(0); PG8_BAR; PG8_MMA(1, 0, At, B0); PG8_MMA(1, 1, At, B1); PG8_BAR; PG8_SCHED;
            PG8_LDB(B0, 1, 0); PG8_LDB(B1, 1, 1); PG8_SCHED; PG8_LDA(At, 1, 0); PG8_STAGE(PG8_SA(0, 1), a2 + hstep, voffA);
            PG8_WAIT_V(8); PG8_WAIT_L(0); PG8_BAR; PG8_MMA(0, 0, At, B0); PG8_MMA(0, 1, At, B1); PG8_BAR; PG8_SCHED;
            PG8_LDA(At, 1, 1); PG8_STAGE(PG8_SB(1, 0), b3, voffB); PG8_STAGE(PG8_SB(1, 1), b3 + hstep, voffB); PG8_STAGE(PG8_SA(1, 0), a3, voffA);
            PG8_WAIT_V(8); PG8_WAIT_L(0); PG8_BAR; PG8_MMA(1, 0, At, B0); PG8_MMA(1, 1, At, B1); PG8_BAR; PG8_SCHED;
            } else {
            PG8_LDB(B0, 0, 0); PG8_SCHED; PG8_LDA(At, 0, 0); PG8_STAGE(PG8_SA(1, 1), a1 + hstep, voffA);
            PG8_WAIT_L(8); PG8_BAR; PG8_WAIT_L(0); PG8_MMA(0, 0, At, B0); PG8_BAR; PG8_SCHED;
            PG8_LDB(B1, 0, 1); PG8_STAGE(PG8_SB(0, 0), b2, voffB);
            PG8_BAR; PG8_WAIT_L(0); PG8_MMA(0, 1, At, B1); PG8_BAR;
            PG8_LDA(At, 0, 1); PG8_STAGE(PG8_SA(0, 0), a2, voffA);
            PG8_BAR; PG8_WAIT_L(0); PG8_MMA(1, 0, At, B0); PG8_BAR; PG8_SCHED;
            PG8_STAGE(PG8_SB(0, 1), b2 + hstep, voffB);
            PG8_WAIT_V(6); PG8_BAR; PG8_MMA(1, 1, At, B1); PG8_BAR;
            PG8_LDB(B0, 1, 0); PG8_SCHED; PG8_LDA(At, 1, 0); PG8_STAGE(PG8_SA(0, 1), a2 + hstep, voffA);
            PG8_WAIT_L(8); PG8_BAR; PG8_WAIT_L(0); PG8_MMA(0, 0, At, B0); PG8_BAR; PG8_SCHED;
            PG8_LDB(B1, 1, 1); PG8_STAGE(PG8_SB(1, 0), b3, voffB);
            PG8_BAR; PG8_WAIT_L(0); PG8_MMA(0, 1, At, B1); PG8_BAR;
            PG8_LDA(At, 1, 1); PG8_STAGE(PG8_SA(1, 0), a3, voffA);
            PG8_BAR; PG8_WAIT_L(0); PG8_MMA(1, 0, At, B0); PG8_BAR; PG8_SCHED;
            PG8_STAGE(PG8_SB(1, 1), b3 + hstep, voffB);
            PG8_WAIT_V(6); PG8_BAR; PG8_MMA(1, 1, At, B1); PG8_BAR;
            }
        }
        if constexpr (ALIGN_EPI) { if (wr == 0) PG8_BAR; }
        if constexpr (!Epi::AFTER_DRAIN) { E(acc, cur, wr, wc, fr, fq); S.done(cur); }
        if (!has_next) break;
#pragma unroll
        for (int a = 0; a < 2; ++a)
#pragma unroll
            for (int b = 0; b < 2; ++b)
#pragma unroll
                for (int m = 0; m < 4; ++m)
#pragma unroll
                    for (int n = 0; n < 2; ++n) acc[a][b][m][n] = (f32x4){0.f, 0.f, 0.f, 0.f};
        cur = nxt; cA = nA; cB = nB; ++ui;
        if constexpr (ALIGN_EPI) { if (wr == 1) PG8_BAR; }
    }
    PG8_WAIT_V(0);
    if constexpr (!ALIGN_EPI) { if (wr == 0) PG8_BAR; }
    PG8_BAR;
    if constexpr (Epi::AFTER_DRAIN) { E.fused(acc, cur, wr, wc, fr, fq, lds, wid, lane); S.done(cur); }
#undef PG8_SA
#undef PG8_SB
#undef PG8_STAGE
#undef PG8_LDA
#undef PG8_LDB
#undef PG8_MMA
#undef PG8_WAIT_V
#undef PG8_WAIT_L
#undef PG8_BAR
#undef PG8_SCHED
}
}

#ifndef ONE_LAUNCH
#define ONE_LAUNCH 1
#endif

#define GAS __attribute__((address_space(1)))
#define LAS __attribute__((address_space(3)))
typedef unsigned short bf16;
typedef float v4f __attribute__((ext_vector_type(4)));
typedef unsigned v4u __attribute__((ext_vector_type(4)));
typedef unsigned v2u __attribute__((ext_vector_type(2)));

constexpr int NB = 8, SEQ = 4096, NTOK = NB * SEQ, DM = 1024, NL = 4;
constexpr int DIN = 3090, NP = 3072;
constexpr int PC_S5 = 0, PC_GQKV = 256, PC_GZ = 1408, PC_SZ = 1792, PC_SX = 2176;
constexpr int NE = 32, DE = 256;
constexpr int MAXROWS = 2 * NTOK + NE * 256;
constexpr int MAXTILES = MAXROWS / 256;
constexpr float EPS = 1e-6f;

constexpr size_t MiB = 1u << 20;
constexpr size_t WS_CTL = 0, CTL_BYTES = 1 * MiB;
constexpr size_t WS_MOD = 1 * MiB;
constexpr size_t WS_SMW = 2 * MiB;
constexpr size_t WS_RW = 3 * MiB;
constexpr size_t WS_TI = 4 * MiB;
constexpr size_t WS_LIST = 5 * MiB;
constexpr size_t WS_SM = 9 * MiB;
constexpr size_t WS_WB = 16 * MiB;
constexpr size_t WB_IN = 0, WB_OUT = 6 * MiB, WB_GU = 8 * MiB, WB_DN = 40 * MiB;
constexpr size_t WS_P = 72 * MiB;
constexpr size_t WS_HID = WS_P + 144 * MiB;
constexpr size_t WS_H = 264 * MiB;
constexpr size_t WS_Y = 328 * MiB;
constexpr size_t WS_YRAW = 392 * MiB;
constexpr size_t WS_END = 520 * MiB;
static_assert((size_t)MAXROWS * DM * 2 <= 144 * MiB && (size_t)MAXROWS * DE * 2 <= 48 * MiB, "moe overlay");
constexpr int CW_BAR = 4096;
constexpr int CW_CNT = 16384;

constexpr int LDS_MISC = 147456;
constexpr int LDS_BYTES = LDS_MISC + 2048;

struct Args {
    const float* in[36]; float* out; unsigned char* ws; int ph_lo, ph_hi;
};
enum { I_X = 0, I_C, I_WADA, I_BADA, I_NMIX, I_NFFN, I_WIN, I_WOUT, I_S5ARE, I_S5AIM, I_S5BRE, I_S5BIM, I_S5CRE, I_S5CIM, I_S5D, I_S5LDT, I_S5GLU, I_S5NORM,
       I_GCW, I_GALOG, I_GDTB, I_GNORM, I_SCW, I_SCB, I_SALOG, I_SDTB, I_SD, I_SNORM, I_MWG, I_MBG, I_MWR, I_MBR, I_MGATE, I_MUP, I_MDOWN, I_NFIN };

struct Ctx { LAS unsigned char* lds; volatile LAS int* misc; unsigned char* ws; float* out; int tid, lane, wave, G, bid; };
constexpr int MISC_PTR = 448;
__device__ __forceinline__ const float* inptr(const Ctx& F, int i) { unsigned lo = (unsigned)F.misc[MISC_PTR + 2 * i], hi = (unsigned)F.misc[MISC_PTR + 2 * i + 1];
    lo = __builtin_amdgcn_readfirstlane(lo); hi = __builtin_amdgcn_readfirstlane(hi); return (const float*)(((unsigned long long)hi << 32) | lo); }

__device__ __forceinline__ Ctx launder(const Ctx& F) { Ctx G = F; int t = F.tid; asm volatile("" : "+v"(t)); G.tid = t; G.lane = t & 63; G.wave = __builtin_amdgcn_readfirstlane(t >> 6);
    unsigned long long w = (unsigned long long)F.ws, o = (unsigned long long)F.out; unsigned l0 = (unsigned)(unsigned long long)F.lds; int gg = F.G, bb = F.bid; asm volatile("" : "+s"(w), "+s"(o), "+s"(l0), "+s"(gg), "+s"(bb)); G.G = gg; G.bid = bb;
    G.ws = (unsigned char*)w; G.out = (float*)o; G.lds = (LAS unsigned char*)(unsigned long long)l0; G.misc = (volatile LAS int*)(G.lds + LDS_MISC); return G; }
#define LDS_WAIT() asm volatile("s_waitcnt lgkmcnt(0)" ::: "memory")
#define VM_WAIT() asm volatile("s_waitcnt vmcnt(0)" ::: "memory")

__device__ __forceinline__ float bf2f(unsigned v) { return __uint_as_float(v << 16); }
__device__ __forceinline__ unsigned f2bf(float f) { unsigned u = __float_as_uint(f); return (u + 0x7fffu + ((u >> 16) & 1u)) >> 16; }
__device__ __forceinline__ unsigned pk2(float lo, float hi) { return f2bf(lo) | (f2bf(hi) << 16); }
__device__ __forceinline__ float wave_sum(float v) {
#pragma unroll
    for (int o = 1; o < 64; o <<= 1) v += __shfl_xor(v, o);
    return v;
}
__device__ __forceinline__ float sigm(float x) { return 1.f / (1.f + __expf(-x)); }
__device__ __forceinline__ float silu_f(float x) { return x / (1.f + __expf(-x)); }
__device__ __forceinline__ float log1p_small(float e) { return e < 0.03125f ? e * (1.f + e * (-0.5f + e * (0.33333334f - 0.25f * e))) : __logf(1.f + e); }
__device__ __forceinline__ float softplus_f(float x) { return fmaxf(x, 0.f) + log1p_small(__expf(-fabsf(x))); }
__device__ __forceinline__ float gelu_tanh(float x) { const float u = 0.7978845608028654f * (x + 0.044715f * x * x * x); return x / (1.f + __expf(-2.f * u)); }
__device__ __forceinline__ float dot4(v4f a, v4f b) { return (a.x * b.x + a.y * b.y) + (a.z * b.z + a.w * b.w); }

#define XB_TMO      128
#define XB_XCNT(j)  (256  + 64 * (j))
#define XB_XSUB(j)  (1280 + 64 * (j))
#define XB_XGEN(j)  (2304 + 64 * (j))
#define XB_TOP      3328
#define XB_TOPGEN   3392
#define XCD_BAR_WORDS 3456
#define XB_SPIN_CAP (1u << 20)
__device__ __forceinline__ unsigned xb_ld(unsigned* p)              { return __hip_atomic_load(p, __ATOMIC_RELAXED, __HIP_MEMORY_SCOPE_AGENT); }
__device__ __forceinline__ unsigned xb_add(unsigned* p, unsigned v) { return __hip_atomic_fetch_add(p, v, __ATOMIC_RELAXED, __HIP_MEMORY_SCOPE_AGENT); }
__device__ __forceinline__ unsigned xb_xcc_id() { return (unsigned)__builtin_amdgcn_s_getreg((3 << 11) | 20) & 0xFu; }
#define XB_SPIN(cond, bar) do { unsigned _sp = 0; while (cond) { __builtin_amdgcn_s_sleep(1); \
    if ((++_sp & 255u) == 0u) { if (xb_ld(&(bar)[XB_TMO])) break; if (_sp > XB_SPIN_CAP) { atomicAdd(&(bar)[XB_TMO], 1u); break; } } } } while (0)
struct XcdBarrier { unsigned* bar; unsigned x; volatile LAS unsigned* st; };
__device__ __forceinline__ XcdBarrier xcd_barrier_post(unsigned* bar, volatile LAS unsigned* st) {
    XcdBarrier b; b.bar = bar; b.x = xb_xcc_id(); b.st = st;
    if (threadIdx.x == 0) (void)xb_add(&bar[XB_XCNT(b.x)], 1u);
    return b;
}
__device__ __forceinline__ void xcd_barrier_complete(unsigned* bar, unsigned x, unsigned& nloc, unsigned& nx) {
    const unsigned G = gridDim.x * gridDim.y * gridDim.z;
    unsigned sum, cnt, mine, sp = 0u;
    for (;;) {
        sum = 0u; cnt = 0u; mine = 0u;
#pragma unroll
        for (unsigned j = 0; j < 16; ++j) { const unsigned c = xb_ld(&bar[XB_XCNT(j)]); sum += c; cnt += (c > 0u) ? 1u : 0u; mine = (j == x) ? c : mine; }
        if (sum == G) break;
        __builtin_amdgcn_s_sleep(1);
        if ((++sp & 255u) == 0u) { if (xb_ld(&bar[XB_TMO])) break; if (sp > XB_SPIN_CAP) { atomicAdd(&bar[XB_TMO], 1u); break; } }
    }
    nloc = mine > 0u ? mine : 1u; nx = cnt > 0u ? cnt : 1u;
}
__device__ __forceinline__ void xcd_barrier(const XcdBarrier& b) {
    asm volatile("s_waitcnt vmcnt(0)" ::: "memory");
    __syncthreads();
    if (threadIdx.x == 0) {
        unsigned* bar = b.bar;
        __builtin_amdgcn_s_waitcnt(0);
        unsigned nloc = b.st[0], nx = b.st[1];
        if (nloc == 0u) { xcd_barrier_complete(bar, b.x, nloc, nx); b.st[0] = nloc; b.st[1] = nx; }
        const unsigned old = xb_add(&bar[XB_XSUB(b.x)], 1u);
        const unsigned gen = old / nloc;
        if (old + 1u == (gen + 1u) * nloc) {
            __builtin_amdgcn_fence(__ATOMIC_RELEASE, "agent");
            asm volatile("s_waitcnt vmcnt(0)" ::: "memory");
            const unsigned og = xb_add(&bar[XB_TOP], 1u);
            const unsigned tg = og / nx;
            if (og + 1u == (tg + 1u) * nx) xb_add(&bar[XB_TOPGEN], 1u);
            else XB_SPIN(xb_ld(&bar[XB_TOPGEN]) == tg, bar);
            __builtin_amdgcn_fence(__ATOMIC_ACQUIRE, "agent");
            xb_add(&bar[XB_XGEN(b.x)], 1u);
            asm volatile("s_waitcnt vmcnt(0)" ::: "memory");
        } else {
            XB_SPIN(xb_ld(&bar[XB_XGEN(b.x)]) == gen, bar);
            __builtin_amdgcn_fence(__ATOMIC_ACQUIRE, "agent");
            asm volatile("s_waitcnt vmcnt(0)" ::: "memory");
        }
    }
    __syncthreads();
}

__device__ __forceinline__ void ph_prologue(const Ctx& F0) {
    Ctx F = launder(F0);
    float* SMW = (float*)(F.ws + WS_SMW); float* RW = (float*)(F.ws + WS_RW); float* MOD = (float*)(F.ws + WS_MOD);
    const int gt = F.bid * 512 + F.tid, NT = F.G * 512;
    const float* p_win = inptr(F, I_WIN); const float* p_mwg = inptr(F, I_MWG); const float* p_mwr = inptr(F, I_MWR); const float* p_c = inptr(F, I_C); const float* p_bada = inptr(F, I_BADA);
    for (int i = gt; i < NL * 54 * DM; i += NT) {
        const int l = i / (54 * DM), r = i % (54 * DM), j = r / DM, k = r % DM;
        if (j < 18) { const int col = j < 12 ? 1792 + j : 3084 + (j - 12); SMW[(l * 18 + j) * DM + k] = p_win[((size_t)l * DM + k) * DIN + col]; }
        else { const int jj = j - 18; RW[(l * 36 + jj) * DM + k] = jj < 4 ? p_mwg[((size_t)l * DM + k) * 4 + jj] : p_mwr[((size_t)l * DM + k) * 32 + (jj - 4)]; }
    }
    LAS float* cond = (LAS float*)F.lds; LAS float* red = (LAS float*)(F.lds + 32768);
    for (int item = F.bid; item < NL * 24; item += F.G) {
        for (int i = F.tid; i < NB * DM; i += 512) cond[i] = silu_f(p_c[i]);
        __syncthreads();
        const int l = item / 24, cg = item % 24;
        v4f acc[NB];
#pragma unroll
        for (int b = 0; b < NB; ++b) acc[b] = (v4f){0.f, 0.f, 0.f, 0.f};
        const float* wp = inptr(F, I_WADA) + ((size_t)l * DM + F.wave * 128) * (6 * DM) + cg * 256 + 4 * F.lane;
#pragma unroll 8
        for (int kk = 0; kk < 128; ++kk) {
            const v4f w = *(const v4f*)(wp + (size_t)kk * (6 * DM)); const int k = F.wave * 128 + kk;
#pragma unroll
            for (int b = 0; b < NB; ++b) acc[b] += cond[b * DM + k] * w;
        }
#pragma unroll
        for (int b = 0; b < NB; ++b) *(LAS v4f*)(red + (F.wave * NB + b) * 256 + 4 * F.lane) = acc[b];
        __syncthreads();
        for (int o = F.tid; o < NB * 256; o += 512) { const int b = o / 256, col = o % 256; float s = 0.f;
#pragma unroll
            for (int w = 0; w < 8; ++w) s += red[(w * NB + b) * 256 + col];
            MOD[((size_t)l * NB + b) * (6 * DM) + cg * 256 + col] = s + p_bada[l * 6 * DM + cg * 256 + col]; }
        __syncthreads();
    }
}

__device__ __forceinline__ void transpose_item(const float* W, int ldw, int K, bf16* WT, int k0, int nsrc0, int ndst0, LAS float* scr, int lane) {
#pragma unroll 8
    for (int i = 0; i < 32; ++i) { const int kk = 2 * i + (lane >> 5); scr[kk * 33 + (lane & 31)] = W[(size_t)(k0 + kk) * ldw + nsrc0 + (lane & 31)]; }
    LDS_WAIT();
    const int c = lane & 7;
#pragma unroll
    for (int j = 0; j < 4; ++j) { const int n = (lane >> 3) + 8 * j; const LAS float* s = scr + (8 * c) * 33 + n;
        v4u o; o.x = pk2(s[0 * 33], s[1 * 33]); o.y = pk2(s[2 * 33], s[3 * 33]); o.z = pk2(s[4 * 33], s[5 * 33]); o.w = pk2(s[6 * 33], s[7 * 33]);
        *(v4u*)(WT + (size_t)(ndst0 + n) * K + k0 + 8 * c) = o; }
    LDS_WAIT();
}
constexpr int CV_IN = 16 * 96, CV_OUT = 16 * 32, CV_G = NE * 16 * 8, CV_D = NE * 4 * 32, CV_ITEMS = CV_IN + CV_OUT + 2 * CV_G + CV_D;
__device__ __forceinline__ void convert_item(Ctx& F, int l, int it, LAS float* scr, int lane) {
    unsigned char* wb = F.ws + WS_WB;
    if (it < CV_IN) { const int kb = it / 96, nb = it % 96, nd = 32 * nb, ns = nd + (nd >= 1792 ? 12 : 0);
        transpose_item(inptr(F, I_WIN) + (size_t)l * DM * DIN, DIN, DM, (bf16*)(wb + WB_IN), 64 * kb, ns, nd, scr, lane); return; }
    it -= CV_IN;
    if (it < CV_OUT) { const int kb = it / 32, nb = it % 32;
        transpose_item(inptr(F, I_WOUT) + (size_t)l * DM * DM, DM, DM, (bf16*)(wb + WB_OUT), 64 * kb, 32 * nb, 32 * nb, scr, lane); return; }
    it -= CV_OUT;
    if (it < 2 * CV_G) { const int up = it >= CV_G; if (up) it -= CV_G; const int e = it / 128, r = it % 128, kb = r / 8, nb = r % 8, j0 = 32 * nb;
        const int nd = 256 * (j0 / 128) + (j0 % 128) + (up ? 128 : 0);
        transpose_item(inptr(F, up ? I_MUP : I_MGATE) + ((size_t)l * NE + e) * DM * DE, DE, DM, (bf16*)(wb + WB_GU) + (size_t)e * 512 * DM, 64 * kb, j0, nd, scr, lane); return; }
    it -= 2 * CV_G;
    { const int e = it / 128, r = it % 128, kb = r / 32, nb = r % 32;
        transpose_item(inptr(F, I_MDOWN) + ((size_t)l * NE + e) * DE * DM, DM, DE, (bf16*)(wb + WB_DN) + (size_t)e * DM * DE, 64 * kb, 32 * nb, 32 * nb, scr, lane); }
}

__device__ __forceinline__ void build_tiles(const Ctx& F, int lc) {
    if (F.tid == 0) {
        const unsigned* cnt = (const unsigned*)(F.ws + WS_CTL) + CW_CNT + lc * NE; int acc = 0;
        for (int e = 0; e < NE; ++e) { const int c = (int)__hip_atomic_load(cnt + e, __ATOMIC_RELAXED, __HIP_MEMORY_SCOPE_AGENT); F.misc[16 + e] = acc; F.misc[64 + e] = c;
            const int nt = (c + 255) / 256; for (int t = 0; t < nt; ++t) F.misc[128 + acc + t] = e; acc += nt; }
        F.misc[16 + NE] = acc;
    }
}

__device__ __forceinline__ void ph_n1(const Ctx& F0, int l, int mode) {
    Ctx F = launder(F0);
    const float* MOD = (const float*)(F.ws + WS_MOD);
    const int lp = mode ? NL - 1 : l - 1;
    LAS float* sw = (LAS float*)F.lds;
    if (mode == 0) {
        const float* SMW = (const float*)(F.ws + WS_SMW) + (size_t)l * 18 * DM;
        for (int i = F.tid; i < 18 * DM / 4; i += 512) ((LAS v4f*)sw)[i] = ((const v4f*)SMW)[i];
    }
    if (lp >= 0) build_tiles(F, lp);
    __syncthreads();
    if (mode == 0) {
        LAS float* scr = (LAS float*)(F.lds + 73728 + F.wave * 8448);
        for (int it = F.wave * F.G + F.bid; it < CV_ITEMS; it += 8 * F.G) convert_item(F, l, it, scr, F.lane);
    }
    const int NGW = F.G * 8, gw = F.bid * 8 + F.wave, rows_per = (NTOK + NGW - 1) / NGW;
    const int r0 = gw * rows_per, r1 = (r0 + rows_per) < NTOK ? (r0 + rows_per) : NTOK;
    const float* xin = (mode == 0 && l == 0) ? inptr(F, I_X) : F.out;
    const bf16* MO = (const bf16*)(F.ws + WS_P); const int* TI = (const int*)(F.ws + WS_TI);
    bf16* H = (bf16*)(F.ws + WS_H); float* SM = (float*)(F.ws + WS_SM);
    int curb = -1; v4f An[4], Bn[4], Gp[4];
    float tc_a = 0.f, tc_b = 0.f;
    if (mode == 0) { if (F.lane < 6) { tc_a = -expf(inptr(F, I_GALOG)[l * 6 + F.lane]); tc_b = inptr(F, I_GDTB)[l * 6 + F.lane]; } else if (F.lane >= 12 && F.lane < 18) tc_b = inptr(F, I_SDTB)[l * 6 + F.lane - 12]; }
    const float* p_nrm = inptr(F, mode == 0 ? I_NMIX : I_NFIN);
#pragma unroll
    for (int j = 0; j < 4; ++j) { An[j] = (v4f){0, 0, 0, 0}; Bn[j] = An[j]; Gp[j] = An[j]; }
    for (int row = r0; row < r1; ++row) {
        const int b = row >> 12;
        if (b != curb) { curb = b;
#pragma unroll
            for (int j = 0; j < 4; ++j) { const int c = 4 * F.lane + 256 * j;
                if (mode == 0) { const v4f nm = *(const v4f*)(p_nrm + l * DM + c), sc = *(const v4f*)(MOD + ((size_t)l * NB + b) * 6 * DM + 1 * DM + c), sh = *(const v4f*)(MOD + ((size_t)l * NB + b) * 6 * DM + c);
                    An[j] = nm * (1.f + sc); Bn[j] = sh; }
                else { An[j] = *(const v4f*)(p_nrm + c); Bn[j] = (v4f){0, 0, 0, 0}; }
                if (lp >= 0) Gp[j] = *(const v4f*)(MOD + ((size_t)lp * NB + b) * 6 * DM + 5 * DM + c); }
        }
        v4f v[4];
#pragma unroll
        for (int j = 0; j < 4; ++j) v[j] = *(const v4f*)(xin + (size_t)row * DM + 4 * F.lane + 256 * j);
        if (lp >= 0) {
            const int e0 = TI[row * 8 + 0], s0 = TI[row * 8 + 1], e1 = TI[row * 8 + 3], s1 = TI[row * 8 + 4];
            const float w0 = __int_as_float(TI[row * 8 + 2]), w1 = __int_as_float(TI[row * 8 + 5]);
            const size_t ra = (size_t)(F.misc[16 + e0] * 256 + s0), rb = (size_t)(F.misc[16 + e1] * 256 + s1);
#pragma unroll
            for (int j = 0; j < 4; ++j) { const v2u a = *(const v2u*)(MO + ra * DM + 4 * F.lane + 256 * j), c = *(const v2u*)(MO + rb * DM + 4 * F.lane + 256 * j);
                const v4f ya = (v4f){bf2f(a.x & 0xffffu), bf2f(a.x >> 16), bf2f(a.y & 0xffffu), bf2f(a.y >> 16)}, yb = (v4f){bf2f(c.x & 0xffffu), bf2f(c.x >> 16), bf2f(c.y & 0xffffu), bf2f(c.y >> 16)};
                v[j] += Gp[j] * (w0 * ya + w1 * yb); }
            if (mode == 0) {
#pragma unroll
                for (int j = 0; j < 4; ++j) *(v4f*)(F.out + (size_t)row * DM + 4 * F.lane + 256 * j) = v[j];
            }
        }
        float ss = 0.f;
#pragma unroll
        for (int j = 0; j < 4; ++j) ss += dot4(v[j], v[j]);
        const float rs = rsqrtf(wave_sum(ss) * (1.f / DM) + EPS);
        v4f h[4];
#pragma unroll
        for (int j = 0; j < 4; ++j) h[j] = v[j] * rs * An[j] + Bn[j];
        if (mode == 1) {
#pragma unroll
            for (int j = 0; j < 4; ++j) *(v4f*)(F.out + (size_t)row * DM + 4 * F.lane + 256 * j) = h[j];
            continue;
        }
#pragma unroll
        for (int j = 0; j < 4; ++j) { v2u o; o.x = pk2(h[j].x, h[j].y); o.y = pk2(h[j].z, h[j].w); *(v2u*)(H + (size_t)row * DM + 4 * F.lane + 256 * j) = o; }
        float mine = 0.f;
#pragma unroll 2
        for (int c = 0; c < 18; ++c) { float s = 0.f;
#pragma unroll
            for (int j = 0; j < 4; ++j) s += dot4(h[j], ((const LAS v4f*)sw)[c * 256 + 64 * j + F.lane]);
            s = wave_sum(s); mine = (F.lane == c) ? s : mine; }
        if (F.lane < 18) { float r;
            if (F.lane < 6) r = tc_a * softplus_f(mine + tc_b);
            else if (F.lane < 12) r = sigm(mine);
            else r = softplus_f(mine + tc_b);
            SM[(size_t)row * 18 + F.lane] = r; }
    }
}

constexpr int TB = 8;
__device__ __forceinline__ void gdn_naive(Ctx& F, int l, int b, int hh, int cq, LAS float* wl, int lane) {
    const bf16* P = (const bf16*)(F.ws + WS_P); const float* SM = (const float*)(F.ws + WS_SM); float* YR = (float*)(F.ws + WS_YRAW);
    const int el = lane & 15, dq = lane >> 4;
    float S[16];
#pragma unroll
    for (int i = 0; i < 16; ++i) S[i] = 0.f;
    const float* cw = inptr(F, I_GCW) + (size_t)l * 4 * 1152; const int chq = hh * 64 + lane, chk = 384 + chq, chv = 768 + chq;
    float wq[4], wk[4], wv[4];
#pragma unroll
    for (int j = 0; j < 4; ++j) { wq[j] = cw[j * 1152 + chq]; wk[j] = cw[j * 1152 + chk]; wv[j] = cw[j * 1152 + chv]; }
    float q1 = 0, q2 = 0, q3 = 0, k1 = 0, k2 = 0, k3 = 0, v1 = 0, v2 = 0, v3 = 0;
    for (int t0 = 0; t0 < SEQ; t0 += TB) {
        float xq[TB], xk[TB], xv[TB], gg[TB], bb[TB];
#pragma unroll
        for (int i = 0; i < TB; ++i) { const size_t row = (size_t)b * SEQ + t0 + i; const bf16* pr = P + row * NP + PC_GQKV;
            xq[i] = bf2f(pr[chq]); xk[i] = bf2f(pr[chk]); xv[i] = bf2f(pr[chv]); gg[i] = SM[row * 18 + hh]; bb[i] = SM[row * 18 + 6 + hh]; }
#pragma unroll
        for (int i = 0; i < TB; ++i) {
            const size_t row = (size_t)b * SEQ + t0 + i;
            float cq_ = wq[0] * q3 + wq[1] * q2 + wq[2] * q1 + wq[3] * xq[i]; q3 = q2; q2 = q1; q1 = xq[i];
            float ck_ = wk[0] * k3 + wk[1] * k2 + wk[2] * k1 + wk[3] * xk[i]; k3 = k2; k2 = k1; k1 = xk[i];
            float cv_ = wv[0] * v3 + wv[1] * v2 + wv[2] * v1 + wv[3] * xv[i]; v3 = v2; v2 = v1; v1 = xv[i];
            cq_ = silu_f(cq_); ck_ = silu_f(ck_); cv_ = silu_f(cv_);
            const float qn = cq_ * rsqrtf(wave_sum(cq_ * cq_) + EPS) * 0.125f, kn = ck_ * rsqrtf(wave_sum(ck_ * ck_) + EPS);
            wl[lane] = qn; wl[64 + lane] = kn; wl[128 + lane] = cv_;
            LDS_WAIT();
            float kd[16], qd[16];
#pragma unroll
            for (int j = 0; j < 4; ++j) { const v4f a = *(const LAS v4f*)(wl + 64 + 16 * dq + 4 * j), c = *(const LAS v4f*)(wl + 16 * dq + 4 * j);
                kd[4 * j] = a.x; kd[4 * j + 1] = a.y; kd[4 * j + 2] = a.z; kd[4 * j + 3] = a.w; qd[4 * j] = c.x; qd[4 * j + 1] = c.y; qd[4 * j + 2] = c.z; qd[4 * j + 3] = c.w; }
            const float ve = wl[128 + 16 * cq + el];
            LDS_WAIT();
            const float a = __expf(gg[i]);
            float ks = 0.f;
#pragma unroll
            for (int j = 0; j < 16; ++j) ks += kd[j] * S[j];
            ks += __shfl_xor(ks, 16); ks += __shfl_xor(ks, 32);
            const float vn = bb[i] * (ve - a * ks);
            float o = 0.f;
#pragma unroll
            for (int j = 0; j < 16; ++j) { S[j] = a * S[j] + kd[j] * vn; o += qd[j] * S[j]; }
            o += __shfl_xor(o, 16); o += __shfl_xor(o, 32);
            if (dq == 0) YR[row * DM + 256 + hh * 64 + 16 * cq + el] = o;
        }
    }
}
__device__ __forceinline__ void ssd_naive(Ctx& F, int l, int b, int hh, int pq, LAS float* wl, int lane) {
    const bf16* P = (const bf16*)(F.ws + WS_P); const float* SM = (const float*)(F.ws + WS_SM); float* YR = (float*)(F.ws + WS_YRAW);
    const int pl = lane & 15, nq = lane >> 4, gi = hh / 3, p = 16 * pq + pl;
    float hs[32];
#pragma unroll
    for (int i = 0; i < 32; ++i) hs[i] = 0.f;
    const float* cw = inptr(F, I_SCW) + (size_t)l * 4 * 896; const float* cb = inptr(F, I_SCB) + (size_t)l * 896;
    const int cB0 = 384 + gi * 128 + lane, cB1 = cB0 + 64, cC0 = 640 + gi * 128 + lane, cC1 = cC0 + 64, cX = hh * 64 + p;
    float wB0[4], wB1[4], wC0[4], wC1[4], wX[4];
#pragma unroll
    for (int j = 0; j < 4; ++j) { wB0[j] = cw[j * 896 + cB0]; wB1[j] = cw[j * 896 + cB1]; wC0[j] = cw[j * 896 + cC0]; wC1[j] = cw[j * 896 + cC1]; wX[j] = cw[j * 896 + cX]; }
    const float bB0 = cb[cB0], bB1 = cb[cB1], bC0 = cb[cC0], bC1 = cb[cC1], bX = cb[cX];
    const float Aneg = -expf(inptr(F, I_SALOG)[l * 6 + hh]), Dsk = inptr(F, I_SD)[l * 6 + hh];
    float hB0[3] = {0, 0, 0}, hB1[3] = {0, 0, 0}, hC0[3] = {0, 0, 0}, hC1[3] = {0, 0, 0}, hX[3] = {0, 0, 0};
    for (int t0 = 0; t0 < SEQ; t0 += TB) {
        float xB0[TB], xB1[TB], xC0[TB], xC1[TB], xX[TB], xZ[TB], dts[TB];
#pragma unroll
        for (int i = 0; i < TB; ++i) { const size_t row = (size_t)b * SEQ + t0 + i; const bf16* pr = P + row * NP;
            xB0[i] = bf2f(pr[PC_SX + cB0]); xB1[i] = bf2f(pr[PC_SX + cB1]); xC0[i] = bf2f(pr[PC_SX + cC0]); xC1[i] = bf2f(pr[PC_SX + cC1]); xX[i] = bf2f(pr[PC_SX + cX]);
            xZ[i] = bf2f(pr[PC_SZ + hh * 64 + p]); dts[i] = SM[row * 18 + 12 + hh]; }
#pragma unroll
        for (int i = 0; i < TB; ++i) {
            const size_t row = (size_t)b * SEQ + t0 + i;
#define CONV1(w, hst, x, bias) ({ float _y = w[0] * hst[2] + w[1] * hst[1] + w[2] * hst[0] + w[3] * (x) + (bias); hst[2] = hst[1]; hst[1] = hst[0]; hst[0] = (x); silu_f(_y); })
            const float vB0 = CONV1(wB0, hB0, xB0[i], bB0), vB1 = CONV1(wB1, hB1, xB1[i], bB1), vC0 = CONV1(wC0, hC0, xC0[i], bC0), vC1 = CONV1(wC1, hC1, xC1[i], bC1), vX = CONV1(wX, hX, xX[i], bX);
#undef CONV1
            wl[lane] = vB0; wl[64 + lane] = vB1; wl[128 + lane] = vC0; wl[192 + lane] = vC1;
            LDS_WAIT();
            float Bv[32], Cv[32];
#pragma unroll
            for (int j = 0; j < 8; ++j) { const v4f a = *(const LAS v4f*)(wl + 32 * nq + 4 * j), c = *(const LAS v4f*)(wl + 128 + 32 * nq + 4 * j);
                Bv[4 * j] = a.x; Bv[4 * j + 1] = a.y; Bv[4 * j + 2] = a.z; Bv[4 * j + 3] = a.w; Cv[4 * j] = c.x; Cv[4 * j + 1] = c.y; Cv[4 * j + 2] = c.z; Cv[4 * j + 3] = c.w; }
            LDS_WAIT();
            const float dt = dts[i], dA = __expf(dt * Aneg), xdt = vX * dt;
            float y = 0.f;
#pragma unroll
            for (int j = 0; j < 32; ++j) { hs[j] = dA * hs[j] + xdt * Bv[j]; y += Cv[j] * hs[j]; }
            y += __shfl_xor(y, 16); y += __shfl_xor(y, 32);
            y = (y + Dsk * vX) * silu_f(xZ[i]);
            if (nq == 0) YR[row * DM + 640 + hh * 64 + p] = y;
        }
    }
}
__device__ __forceinline__ void s5_naive(Ctx& F, int l, int b, int g, int lane) {
    const bf16* P = (const bf16*)(F.ws + WS_P); float* YR = (float*)(F.ws + WS_YRAW);
    const int gp = (l * 16 + g) * 64 + lane;
    const float are = inptr(F, I_S5ARE)[gp], aim = inptr(F, I_S5AIM)[gp], step = expf(inptr(F, I_S5LDT)[l * 16 + g]);
    const float mag = expf(are * step); float sn, cs; sincosf(aim * step, &sn, &cs);
    const float lbr = mag * cs, lbi = mag * sn;
    const float nr = lbr - 1.f, ni = lbi, den = are * are + aim * aim;
    const float fr = (nr * are + ni * aim) / den, fi = (ni * are - nr * aim) / den;
    float Br[16], Bi[16], Cr[16], Ci[16], Dk[16];
#pragma unroll
    for (int c = 0; c < 16; ++c) { const float br = inptr(F, I_S5BRE)[(size_t)gp * 16 + c], bi = inptr(F, I_S5BIM)[(size_t)gp * 16 + c];
        Br[c] = fr * br - fi * bi; Bi[c] = fr * bi + fi * br;
        Cr[c] = inptr(F, I_S5CRE)[((size_t)(l * 16 + g) * 16 + c) * 64 + lane]; Ci[c] = inptr(F, I_S5CIM)[((size_t)(l * 16 + g) * 16 + c) * 64 + lane];
        Dk[c] = inptr(F, I_S5D)[l * 256 + g * 16 + c]; }
    float sr = 0.f, si = 0.f;
    for (int t0 = 0; t0 < SEQ; t0 += TB) {
        v4u ua[TB], ub[TB];
#pragma unroll
        for (int i = 0; i < TB; ++i) { const size_t row = (size_t)b * SEQ + t0 + i; const v4u* pr = (const v4u*)(P + row * NP + PC_S5 + g * 16); ua[i] = pr[0]; ub[i] = pr[1]; }
#pragma unroll
        for (int i = 0; i < TB; ++i) {
            const size_t row = (size_t)b * SEQ + t0 + i;
            float u[16];
            u[0] = bf2f(ua[i].x & 0xffffu); u[1] = bf2f(ua[i].x >> 16); u[2] = bf2f(ua[i].y & 0xffffu); u[3] = bf2f(ua[i].y >> 16);
            u[4] = bf2f(ua[i].z & 0xffffu); u[5] = bf2f(ua[i].z >> 16); u[6] = bf2f(ua[i].w & 0xffffu); u[7] = bf2f(ua[i].w >> 16);
            u[8] = bf2f(ub[i].x & 0xffffu); u[9] = bf2f(ub[i].x >> 16); u[10] = bf2f(ub[i].y & 0xffffu); u[11] = bf2f(ub[i].y >> 16);
            u[12] = bf2f(ub[i].z & 0xffffu); u[13] = bf2f(ub[i].z >> 16); u[14] = bf2f(ub[i].w & 0xffffu); u[15] = bf2f(ub[i].w >> 16);
            float bur = 0.f, bui = 0.f;
#pragma unroll
            for (int c = 0; c < 16; ++c) { bur += Br[c] * u[c]; bui += Bi[c] * u[c]; }
            const float nsr = lbr * sr - lbi * si + bur, nsi = lbr * si + lbi * sr + bui; sr = nsr; si = nsi;
            float mine = 0.f;
#pragma unroll
            for (int c = 0; c < 16; ++c) { float y = wave_sum(Cr[c] * sr - Ci[c] * si) + Dk[c] * u[c]; mine = (lane == c) ? y : mine; }
            if (lane < 16) YR[row * DM + g * 16 + lane] = gelu_tanh(mine);
        }
    }
}
__device__ __forceinline__ void ph_m2(const Ctx& F0, int l) {
    Ctx F = launder(F0);
    const int u = F.wave * F.G + F.bid;
    LAS float* wl = (LAS float*)(F.lds + F.wave * 4096);
    if (u < 192) gdn_naive(F, l, u / 24, (u % 24) / 4, u % 4, wl, F.lane);
    else if (u < 384) { const int v = u - 192; ssd_naive(F, l, v / 24, (v % 24) / 4, v % 4, wl, F.lane); }
    else if (u < 512) { const int v = u - 384; s5_naive(F, l, v / 16, v % 16, F.lane); }
}

__device__ __forceinline__ void ph_m3(const Ctx& F0, int l) {
    Ctx F = launder(F0);
    const bf16* P = (const bf16*)(F.ws + WS_P); const float* YR = (const float*)(F.ws + WS_YRAW); bf16* Y = (bf16*)(F.ws + WS_Y);
    const int NGW = F.G * 8, gw = F.bid * 8 + F.wave;
    LAS float* ys = (LAS float*)(F.lds + F.wave * 8192);
    const float* wg = inptr(F, I_S5GLU) + (size_t)l * 65536;
    const v4f s5n = *(const v4f*)(inptr(F, I_S5NORM) + l * 256 + 4 * F.lane);
    for (int tg = gw; tg < NTOK / 8; tg += NGW) {
        const int tok0 = tg * 8; v4f yv[8];
#pragma unroll
        for (int t = 0; t < 8; ++t) yv[t] = *(const v4f*)(YR + (size_t)(tok0 + t) * DM + 4 * F.lane);
#pragma unroll
        for (int i = 0; i < 4; ++i) { *(LAS v4f*)(ys + (4 * F.lane + i) * 8) = (v4f){yv[0][i], yv[1][i], yv[2][i], yv[3][i]}; *(LAS v4f*)(ys + (4 * F.lane + i) * 8 + 4) = (v4f){yv[4][i], yv[5][i], yv[6][i], yv[7][i]}; }
        LDS_WAIT();
        v4f acc[8];
#pragma unroll
        for (int t = 0; t < 8; ++t) acc[t] = (v4f){0, 0, 0, 0};
#pragma unroll 4
        for (int k = 0; k < 256; ++k) { const v4f w = *(const v4f*)(wg + k * 256 + 4 * F.lane); const v4f a0 = *(const LAS v4f*)(ys + k * 8), a1 = *(const LAS v4f*)(ys + k * 8 + 4);
            acc[0] += a0.x * w; acc[1] += a0.y * w; acc[2] += a0.z * w; acc[3] += a0.w * w; acc[4] += a1.x * w; acc[5] += a1.y * w; acc[6] += a1.z * w; acc[7] += a1.w * w; }
        LDS_WAIT();
#pragma unroll
        for (int t = 0; t < 8; ++t) { v4f v = yv[t]; v.x *= sigm(acc[t].x); v.y *= sigm(acc[t].y); v.z *= sigm(acc[t].z); v.w *= sigm(acc[t].w);
            const float rs = rsqrtf(wave_sum(dot4(v, v)) * (1.f / 256.f) + EPS); v = v * rs * s5n;
            v2u o; o.x = pk2(v.x, v.y); o.y = pk2(v.z, v.w); *(v2u*)(Y + (size_t)(tok0 + t) * DM + 4 * F.lane) = o; }
    }
    const float gn = inptr(F, I_GNORM)[l * 64 + F.lane];
    float sn[6];
#pragma unroll
    for (int j = 0; j < 6; ++j) sn[j] = inptr(F, I_SNORM)[l * 384 + j * 64 + F.lane];
    for (int tok = gw; tok < NTOK; tok += NGW) {
#pragma unroll
        for (int hh = 0; hh < 6; ++hh) { const float o = YR[(size_t)tok * DM + 256 + hh * 64 + F.lane]; const float rs = rsqrtf(wave_sum(o * o) * (1.f / 64.f) + EPS);
            const float z = bf2f(P[(size_t)tok * NP + PC_GZ + hh * 64 + F.lane]);
            Y[(size_t)tok * DM + 256 + hh * 64 + F.lane] = (bf16)f2bf(o * rs * gn * silu_f(z)); }
#pragma unroll
        for (int g = 0; g < 2; ++g) { float v[3], ss = 0.f;
#pragma unroll
            for (int j = 0; j < 3; ++j) { v[j] = YR[(size_t)tok * DM + 640 + g * 192 + j * 64 + F.lane]; ss += v[j] * v[j]; }
            const float rs = rsqrtf(wave_sum(ss) * (1.f / 192.f) + EPS);
#pragma unroll
            for (int j = 0; j < 3; ++j) Y[(size_t)tok * DM + 640 + g * 192 + j * 64 + F.lane] = (bf16)f2bf(v[j] * rs * sn[g * 3 + j]); }
    }
}

__device__ __forceinline__ void ph_n2(const Ctx& F0, int l) {
    Ctx F = launder(F0);
    const float* MOD = (const float*)(F.ws + WS_MOD);
    LAS float* rw = (LAS float*)F.lds;
    { const float* RW = (const float*)(F.ws + WS_RW) + (size_t)l * 36 * DM;
      for (int i = F.tid; i < 36 * DM / 4; i += 512) ((LAS v4f*)rw)[i] = ((const v4f*)RW)[i]; }
    __syncthreads();
    const int NGW = F.G * 8, gw = F.bid * 8 + F.wave, rows_per = (NTOK + NGW - 1) / NGW;
    const int r0 = gw * rows_per, r1 = (r0 + rows_per) < NTOK ? (r0 + rows_per) : NTOK;
    bf16* H = (bf16*)(F.ws + WS_H); int* TI = (int*)(F.ws + WS_TI); int* LIST = (int*)(F.ws + WS_LIST);
    unsigned* cnt = (unsigned*)(F.ws + WS_CTL) + CW_CNT + l * NE;
    int curb = -1; v4f An[4], Bn[4];
    const float* p_nffn = inptr(F, I_NFFN); const float* p_mbg = inptr(F, I_MBG) + l * 4; const float* p_mbr = inptr(F, I_MBR) + l * 32;
#pragma unroll
    for (int j = 0; j < 4; ++j) { An[j] = (v4f){0, 0, 0, 0}; Bn[j] = An[j]; }
    for (int c0 = r0; c0 < r1; c0 += 64) {
        const int c1 = (c0 + 64) < r1 ? (c0 + 64) : r1;
        int me0 = 0, me1 = 0; float mw0 = 0.f, mw1 = 0.f;
        for (int row = c0; row < c1; ++row) {
            const int b = row >> 12;
            if (b != curb) { curb = b;
#pragma unroll
                for (int j = 0; j < 4; ++j) { const int c = 4 * F.lane + 256 * j;
                    const v4f nm = *(const v4f*)(p_nffn + l * DM + c), sc = *(const v4f*)(MOD + ((size_t)l * NB + b) * 6 * DM + 4 * DM + c), sh = *(const v4f*)(MOD + ((size_t)l * NB + b) * 6 * DM + 3 * DM + c);
                    An[j] = nm * (1.f + sc); Bn[j] = sh; }
            }
            v4f v[4]; float ss = 0.f;
#pragma unroll
            for (int j = 0; j < 4; ++j) { v[j] = *(const v4f*)(F.out + (size_t)row * DM + 4 * F.lane + 256 * j); ss += dot4(v[j], v[j]); }
            const float rs = rsqrtf(wave_sum(ss) * (1.f / DM) + EPS);
            v4f h[4];
#pragma unroll
            for (int j = 0; j < 4; ++j) { h[j] = v[j] * rs * An[j] + Bn[j]; v2u o; o.x = pk2(h[j].x, h[j].y); o.y = pk2(h[j].z, h[j].w); *(v2u*)(H + (size_t)row * DM + 4 * F.lane + 256 * j) = o; }
            float lg[4];
#pragma unroll
            for (int c = 0; c < 4; ++c) { float s = 0.f;
#pragma unroll
                for (int j = 0; j < 4; ++j) s += dot4(h[j], ((const LAS v4f*)rw)[c * 256 + 64 * j + F.lane]);
                lg[c] = wave_sum(s) + p_mbg[c]; }
            int gi = 0; float gm = lg[0];
#pragma unroll
            for (int c = 1; c < 4; ++c) if (lg[c] > gm) { gm = lg[c]; gi = c; }
            float den = 0.f;
#pragma unroll
            for (int c = 0; c < 4; ++c) den += __expf(lg[c] - gm);
            const float gwt = 1.f / den;
            float le[8];
#pragma unroll
            for (int c = 0; c < 8; ++c) { float s = 0.f; const LAS v4f* wr_ = (const LAS v4f*)rw + (4 + gi * 8 + c) * 256;
#pragma unroll
                for (int j = 0; j < 4; ++j) s += dot4(h[j], wr_[64 * j + F.lane]);
                le[c] = wave_sum(s) + p_mbr[gi * 8 + c]; }
            int i1 = 0; float v1 = le[0];
#pragma unroll
            for (int c = 1; c < 8; ++c) if (le[c] > v1) { v1 = le[c]; i1 = c; }
            int i2 = -1; float v2 = -3.0e38f;
#pragma unroll
            for (int c = 0; c < 8; ++c) if (c != i1 && le[c] > v2) { v2 = le[c]; i2 = c; }
            const float ex = __expf(v2 - v1), we1 = 1.f / (1.f + ex), we2 = ex / (1.f + ex);
            if (F.lane == row - c0) { me0 = gi * 8 + i1; me1 = gi * 8 + i2; mw0 = gwt * we1; mw1 = gwt * we2; }
        }
        if (c0 + F.lane < c1) {
            const int row = c0 + F.lane;
            const int s0 = (int)__hip_atomic_fetch_add(cnt + me0, 1u, __ATOMIC_RELAXED, __HIP_MEMORY_SCOPE_AGENT);
            const int s1 = (int)__hip_atomic_fetch_add(cnt + me1, 1u, __ATOMIC_RELAXED, __HIP_MEMORY_SCOPE_AGENT);
            int* ti = TI + (size_t)row * 8; ti[0] = me0; ti[1] = s0; ti[2] = __float_as_int(mw0); ti[3] = me1; ti[4] = s1; ti[5] = __float_as_int(mw1);
            LIST[(size_t)me0 * NTOK + s0] = row; LIST[(size_t)me1 * NTOK + s1] = row;
        }
    }
}

__device__ __forceinline__ void ph_e0(const Ctx& F0, int l) {
    Ctx F = launder(F0);
    build_tiles(F, l); __syncthreads();
    const int ntiles = F.misc[16 + NE];
    const bf16* H = (const bf16*)(F.ws + WS_H); bf16* XG = (bf16*)(F.ws + WS_P); const int* LIST = (const int*)(F.ws + WS_LIST);
    for (int tile = F.bid; tile < ntiles; tile += F.G) {
        const int e = F.misc[128 + tile], ts = F.misc[16 + e], ce = F.misc[64 + e];
        for (int r = F.wave; r < 256; r += 8) { const int slot = (tile - ts) * 256 + r;
            if (slot < ce) { const int tok = LIST[(size_t)e * NTOK + slot]; const v4u* s = (const v4u*)(H + (size_t)tok * DM); v4u* d = (v4u*)(XG + ((size_t)tile * 256 + r) * DM);
                d[F.lane] = s[F.lane]; d[64 + F.lane] = s[64 + F.lane]; } }
    }
}

struct EpiResid {
    static constexpr bool PERM = false, AFTER_DRAIN = false;
    const float* xin; float* xout; const float* gate;
    __device__ __forceinline__ void operator()(const pg8::f32x4 (&acc)[2][2][4][2], const pg8::Unit& u, int wr, int wc, int fr, int fq) const {
        const int row0 = u.pm * 256 + wr * 64 + fr, col0 = u.pn * 256 + wc * 32 + 4 * fq, b = u.pm >> 4;
        pg8::f32x4 gv[2][2];
#pragma unroll
        for (int bj = 0; bj < 2; ++bj)
#pragma unroll
            for (int n = 0; n < 2; ++n) gv[bj][n] = *(const pg8::f32x4*)(gate + (size_t)b * 6 * DM + col0 + bj * 128 + n * 16);
#pragma unroll
        for (int ai = 0; ai < 2; ++ai)
#pragma unroll
            for (int m = 0; m < 4; ++m) { const size_t off = (size_t)(row0 + ai * 128 + m * 16) * DM + col0;
#pragma unroll
                for (int bj = 0; bj < 2; ++bj)
#pragma unroll
                    for (int n = 0; n < 2; ++n) { const pg8::f32x4 xv = *(const pg8::f32x4*)(xin + off + bj * 128 + n * 16); *(pg8::f32x4*)(xout + off + bj * 128 + n * 16) = xv + gv[bj][n] * acc[ai][bj][m][n]; } }
    }
};
struct EpiGLU {
    static constexpr bool PERM = true, AFTER_DRAIN = false;
    bf16* O;
    __device__ __forceinline__ void operator()(const pg8::f32x4 (&acc)[2][2][4][2], const pg8::Unit& u, int wr, int wc, int fr, int fq) const {
        const int row0 = u.pm * 256 + wr * 64 + fr, col0 = u.pn * 128 + wc * 32 + 8 * fq;
#pragma unroll
        for (int ai = 0; ai < 2; ++ai)
#pragma unroll
            for (int m = 0; m < 4; ++m) { bf16* rowp = O + (size_t)(row0 + ai * 128 + m * 16) * DE + col0; float hv[8];
#pragma unroll
                for (int n = 0; n < 2; ++n)
#pragma unroll
                    for (int i = 0; i < 4; ++i) { const float g = acc[ai][0][m][n][i], uu = acc[ai][1][m][n][i]; hv[4 * n + i] = g / (1.f + __expf(-g)) * uu; }
                v4u w; w.x = pg8::cvt_pk_bf16(hv[0], hv[1]); w.y = pg8::cvt_pk_bf16(hv[2], hv[3]); w.z = pg8::cvt_pk_bf16(hv[4], hv[5]); w.w = pg8::cvt_pk_bf16(hv[6], hv[7]);
                *(v4u*)rowp = w; }
    }
};
struct MoeOrder {
    int nunits, NT, G, c; volatile LAS int* misc;
    __device__ __forceinline__ bool next(int i, pg8::Unit& u) const { const int L = i * G + c; if (L >= nunits) return false; const int tile = L / NT; u.pm = tile; u.pn = L % NT; u.e = misc[128 + tile]; return true; }
    __device__ __forceinline__ void a_ready(const pg8::Unit&) const {}
    __device__ __forceinline__ void done(const pg8::Unit&) const {}
};

constexpr int PH_PER_LAYER = 9, N_PHASES = 2 + NL * PH_PER_LAYER;

__global__ void __launch_bounds__(512, 2) fwd(Args A) {
    extern __shared__ __attribute__((aligned(16))) unsigned char lds_raw[];
    Ctx F; F.lds = (LAS unsigned char*)lds_raw; F.misc = (volatile LAS int*)(F.lds + LDS_MISC);
    F.tid = threadIdx.x; F.lane = F.tid & 63; F.wave = __builtin_amdgcn_readfirstlane(F.tid >> 6); F.G = gridDim.x; F.bid = blockIdx.x; F.ws = A.ws; F.out = A.out;
    for (int i = F.tid; i < (LDS_BYTES - LDS_MISC) / 4; i += 512) F.misc[i] = 0;
    __syncthreads();
    if (F.tid < 36) { const unsigned long long p = (unsigned long long)A.in[F.tid]; F.misc[MISC_PTR + 2 * F.tid] = (int)(unsigned)p; F.misc[MISC_PTR + 2 * F.tid + 1] = (int)(unsigned)(p >> 32); }
    __syncthreads();
#if ONE_LAUNCH
    XcdBarrier bar = xcd_barrier_post((unsigned*)(F.ws + WS_CTL) + CW_BAR, (volatile LAS unsigned*)F.misc);
#define GRID_BAR() xcd_barrier(bar)
#else
#define GRID_BAR() do {} while (0)
#endif
    const int lo = A.ph_lo, hi = A.ph_hi;
#ifndef DISMASK
#define DISMASK 0
#endif
#define IN(k) (lo <= (k) && (k) < hi)
#define EN(j) (!((DISMASK >> (j)) & 1))
#define SEAM(k) do { if (IN((k) + 1)) GRID_BAR(); } while (0)
    if (EN(9) && IN(0)) { ph_prologue(F); SEAM(0); }
    for (int l = 0; l < NL; ++l) {
        const int p0 = 1 + l * PH_PER_LAYER;
        if (EN(0) && IN(p0 + 0)) { ph_n1(F, l, 0); SEAM(p0 + 0); }
        if (EN(1) && IN(p0 + 1)) { const Ctx P = launder(F);
            pg8::Gemm g{(const bf16*)(P.ws + WS_H), (const bf16*)((P.ws + WS_WB) + WB_IN), NTOK, NP, DM, 0}; pg8::StaticOrder S; S.init(NTOK, NP, P.G, P.bid);
            pg8::EpiBf16<0> E{(bf16*)(P.ws + WS_P), NP, nullptr, 0, 0, 1.f};
            pg8::gemm_phase<pg8::EpiBf16<0>, pg8::StaticOrder, true, true>(P.lds, g, S, E);
            SEAM(p0 + 1); }
        if (EN(2) && IN(p0 + 2)) { ph_m2(F, l); SEAM(p0 + 2); }
        if (EN(3) && IN(p0 + 3)) { ph_m3(F, l); SEAM(p0 + 3); }
        if (EN(4) && IN(p0 + 4)) { const Ctx P = launder(F);
            pg8::Gemm g{(const bf16*)(P.ws + WS_Y), (const bf16*)((P.ws + WS_WB) + WB_OUT), NTOK, DM, DM, 0}; pg8::StaticOrder S; S.init(NTOK, DM, P.G, P.bid);
            EpiResid E{l == 0 ? inptr(F, I_X) : P.out, P.out, (const float*)(P.ws + WS_MOD) + (size_t)l * NB * 6 * DM + 2 * DM};
            pg8::gemm_phase<EpiResid, pg8::StaticOrder, true, true>(P.lds, g, S, E);
            SEAM(p0 + 4); }
        if (EN(5) && IN(p0 + 5)) { ph_n2(F, l); SEAM(p0 + 5); }
        if (EN(6) && IN(p0 + 6)) { ph_e0(F, l); SEAM(p0 + 6); }
        if (EN(7) && IN(p0 + 7)) { const Ctx P = launder(F);
            __syncthreads(); build_tiles(P, l); __syncthreads();
            const int ntiles = P.misc[16 + NE];
            pg8::Gemm g{(const bf16*)(P.ws + WS_P), (const bf16*)((P.ws + WS_WB) + WB_GU), MAXROWS, 512, DM, (size_t)512 * DM * 2};
            MoeOrder S{ntiles * 2, 2, P.G, P.bid, P.misc};
            EpiGLU E{(bf16*)(P.ws + WS_HID)};
            pg8::gemm_phase<EpiGLU, MoeOrder, true, true>(P.lds, g, S, E);
            SEAM(p0 + 7); }
        if (EN(8) && IN(p0 + 8)) { const Ctx P = launder(F);
            __syncthreads(); build_tiles(P, l); __syncthreads();
            const int ntiles = P.misc[16 + NE];
            pg8::Gemm g{(const bf16*)(P.ws + WS_HID), (const bf16*)((P.ws + WS_WB) + WB_DN), MAXROWS, DM, DE, (size_t)DM * DE * 2};
            MoeOrder S{ntiles * 4, 4, P.G, P.bid, P.misc};
            pg8::EpiBf16<0> E{(bf16*)(P.ws + WS_P), DM, nullptr, 0, 0, 1.f};
            pg8::gemm_phase<pg8::EpiBf16<0>, MoeOrder, true, true>(P.lds, g, S, E);
            SEAM(p0 + 8); }
    }
    if (EN(10) && IN(N_PHASES - 1)) ph_n1(F, 0, 1);
}

extern "C" void kernel_launch(void* const* d_in, const int* in_sizes, int n_in, void* d_out, int out_size, void* d_ws, size_t ws_size, hipStream_t stream) {
    static int grid = 0;
    if (grid == 0) {
        if (n_in != 36 || out_size != NTOK * DM || ws_size < WS_END) { fprintf(stderr, "kernel_launch: unexpected shapes: n_in %d out %d ws %zu (need %zu)\n", n_in, out_size, ws_size, (size_t)WS_END); grid = -1; return; }
        int dev = 0, cus = 0, per_cu = 0;
        if (hipGetDevice(&dev) != hipSuccess || hipDeviceGetAttribute(&cus, hipDeviceAttributeMultiprocessorCount, dev) != hipSuccess) { grid = -1; return; }
        if (hipFuncSetAttribute((const void*)fwd, hipFuncAttributeMaxDynamicSharedMemorySize, LDS_BYTES) != hipSuccess) { fprintf(stderr, "kernel_launch: hipFuncSetAttribute failed\n"); grid = -1; return; }
        if (hipOccupancyMaxActiveBlocksPerMultiprocessor(&per_cu, (const void*)fwd, 512, LDS_BYTES) != hipSuccess || per_cu < 1) fprintf(stderr, "kernel_launch: occupancy query says %d\n", per_cu);
        (void)hipGetLastError();
        grid = cus;
    }
    if (grid < 0) return;
    (void)hipMemsetAsync((char*)d_ws + WS_CTL, 0, CTL_BYTES, stream);
    Args a{};
    for (int i = 0; i < 36; ++i) a.in[i] = (const float*)d_in[i];
    a.out = (float*)d_out; a.ws = (unsigned char*)d_ws;
#if ONE_LAUNCH
    a.ph_lo = 0; a.ph_hi = N_PHASES;
    hipLaunchKernelGGL(fwd, dim3(grid), dim3(512), LDS_BYTES, stream, a);
#else
    for (int ph = 0; ph < N_PHASES; ++ph) { a.ph_lo = ph; a.ph_hi = ph + 1; hipLaunchKernelGGL(fwd, dim3(grid), dim3(512), LDS_BYTES, stream, a); }
#endif
}
```

```cpp
#include <hip/hip_runtime.h>
#include <cstdio>
#include <cstdint>
namespace pg8 {
#define PG8_LAS __attribute__((address_space(3)))
typedef unsigned short bf16_t;
typedef short bf16x8 __attribute__((ext_vector_type(8)));
typedef float f32x4 __attribute__((ext_vector_type(4)));
typedef unsigned u32x4 __attribute__((ext_vector_type(4)));
constexpr int BM = 256, BK = 64, HALF = 128, HTB = HALF * BK * 2  , STAGE_BYTES = 8 * HTB, NXCD = 8, WGM = 8;

__host__ __device__ __forceinline__ int lds_byte(int r, int c) { const int st = (r >> 4) * 2 + (c >> 5), rr = r & 15, cc = c & 31, ob = rr * 64 + cc * 2; return st * 1024 + (ob ^ (((ob >> 9) & 1) << 5)); }
__host__ __device__ __forceinline__ void stage_rc(int b, int& R, int& C) { const int st = b / 1024, sb = b % 1024, swz = sb ^ (((sb >> 9) & 1) << 5); R = (st >> 1) * 16 + swz / 64; C = (st & 1) * 32 + (swz % 64) / 2; }
__host__ __device__ __forceinline__ int perm32(int rho) { const int n = rho >> 4, i = rho & 15; return 8 * (i >> 2) + 4 * n + (i & 3); }

struct Unit { int pm, pn, e; };
struct Gemm { const bf16_t* A; const bf16_t* Bt; int M, N, K; size_t estride; };

struct StaticOrder {
    int nM, nN, nwg, G, c;
    __host__ __device__ void init(int M, int N, int G_, int c_) { nM = M / BM; nN = N / BM; nwg = nM * nN; G = G_; c = c_; }
    __host__ __device__ bool next(int i, Unit& u) const {
        const long L = (long)i * G + c; if (L >= nwg) return false;
        int wgid = (int)L; { const int q = nwg / NXCD, r = nwg % NXCD, xcd = wgid % NXCD, off = wgid / NXCD; wgid = (xcd < r ? xcd * (q + 1) : r * (q + 1) + (xcd - r) * q) + off; }
        const int nig = WGM * nN, gid = wgid / nig, fm = gid * WGM, gsz = (nM - fm) < WGM ? (nM - fm) : WGM;
        u.pm = fm + ((wgid % nig) % gsz); u.pn = (wgid % nig) / gsz; u.e = 0; return true;
    }
    __device__ __forceinline__ void a_ready(const Unit&) const {}
    __device__ __forceinline__ void done(const Unit&) const {}
};

__device__ __forceinline__ unsigned cvt_pk_bf16(float lo, float hi) { unsigned r; asm volatile("v_cvt_pk_bf16_f32 %0, %1, %2" : "=v"(r) : "v"(lo), "v"(hi)); return r; }
typedef float f32x2 __attribute__((ext_vector_type(2)));
__device__ __forceinline__ f32x2 gelu_pk(f32x2 v) {
    const f32x2 av = __builtin_elementwise_abs(v), d = av * 0.2316418882f + 1.0f;
    f32x2 t; t.x = __builtin_amdgcn_rcpf(d.x); t.y = __builtin_amdgcn_rcpf(d.y);
    f32x2 q = t * 0.5307027145f + (-0.7265760135f); q = q * t + 0.7107068705f; q = q * t + (-0.142248368f); q = q * t + 0.127414796f; q = q * t;
    const f32x2 s = (v * v) * (-0.72134752044f);
    f32x2 e; e.x = __builtin_amdgcn_exp2f(s.x); e.y = __builtin_amdgcn_exp2f(s.y);
    const f32x2 m = v * (q * e), r = v - m;
    f32x2 o; o.x = v.x < 0.f ? m.x : r.x; o.y = v.y < 0.f ? m.y : r.y; return o;
}

template <int ACT  > struct EpiBf16 {
    static constexpr bool PERM = true, AFTER_DRAIN = false; static_assert(ACT == 0 || ACT == 1, "EpiBf16: ACT is 0 (none) or 1 (gelu_pk)");
    bf16_t* O; int ldc; const float* bias; int split_cols; size_t split_stride; float scale0;
    __device__ __forceinline__ void operator()(const f32x4 (&acc)[2][2][4][2], const Unit& u, int wr, int wc, int fr, int fq) const {
        const int row0 = u.pm * BM + wr * 64 + fr; int colt = u.pn * BM; bf16_t* base = O;
        float sc = 1.f; if (split_cols) { const int t = colt / split_cols; base += (size_t)t * split_stride; colt -= t * split_cols; if (t == 0) sc = scale0; }
        const int col0 = colt + wc * 32 + 8 * fq, bcol0 = u.pn * BM + wc * 32 + 8 * fq;
#pragma unroll
        for (int ai = 0; ai < 2; ++ai)
#pragma unroll
            for (int m = 0; m < 4; ++m) { bf16_t* rowp = base + (size_t)(row0 + ai * HALF + m * 16) * ldc + col0;
#pragma unroll
                for (int bj = 0; bj < 2; ++bj) { f32x4 v0 = acc[ai][bj][m][0], v1 = acc[ai][bj][m][1];
                    if (ACT == 1) { f32x2 a = gelu_pk((f32x2){v0[0], v0[1]}), b = gelu_pk((f32x2){v0[2], v0[3]}), c = gelu_pk((f32x2){v1[0], v1[1]}), d = gelu_pk((f32x2){v1[2], v1[3]});
                        v0 = (f32x4){a.x, a.y, b.x, b.y}; v1 = (f32x4){c.x, c.y, d.x, d.y}; }
                    v0 = v0 * sc; v1 = v1 * sc; u32x4 w; w.x = cvt_pk_bf16(v0[0], v0[1]); w.y = cvt_pk_bf16(v0[2], v0[3]); w.z = cvt_pk_bf16(v1[0], v1[1]); w.w = cvt_pk_bf16(v1[2], v1[3]);
                    *(u32x4*)(rowp + bj * HALF) = w; } }
    }
};
template <class Epi, class Sched, bool ALIGN_EPI = false, bool SP2 = false>
__device__ __forceinline__ void gemm_phase(PG8_LAS unsigned char* lds, const Gemm g, const Sched& S, const Epi& E, const int wave_index) {
    int tid_; { int ln_; asm volatile("v_mbcnt_lo_u32_b32 %0, -1, 0\n\tv_mbcnt_hi_u32_b32 %0, -1, %0" : "=v"(ln_)); tid_ = wave_index * 64 + ln_; }
    const int tid = tid_, wid = __builtin_amdgcn_readfirstlane(tid >> 6), lane = tid & 63, wr = wid >> 2, wc = wid & 3, fr = lane & 15, fq = lane >> 4;
    const int K = g.K, nt = K / BK;
    unsigned voffA[2], voffB[2];
#pragma unroll
    for (int i = 0; i < 2; ++i) { int R, C; stage_rc(tid * 16 + i * 8192, R, C); const int Rb = Epi::PERM ? ((R & ~31) + perm32(R & 31)) : R;
        voffA[i] = (unsigned)(R * K + C) * 2u; voffB[i] = (unsigned)(Rb * K + C) * 2u; }
    const size_t kstep = (size_t)(BK * 2);
    const size_t hstep = (size_t)HALF * K * 2;
    const size_t tstep = 2 * hstep;
    const unsigned ldsw = (unsigned)wid * 1024u;
    const int aoff = lds_byte(wr * 64 + fr, fq * 8), boff = lds_byte(wc * 32 + fr, fq * 8);
#define PG8_SA(b, h) (((b) * 2 + (h)) * HTB)
#define PG8_SB(b, h) ((4 + (b) * 2 + (h)) * HTB)
#define PG8_STAGE(bufoff, gbase, voff) do { _Pragma("unroll") for (int _i = 0; _i < 2; ++_i) \
        __builtin_amdgcn_global_load_lds((const unsigned*)((const char*)(gbase) + (voff)[_i]), (PG8_LAS unsigned*)(lds + (bufoff) + ldsw + _i * 8192), 16, 0, 0); } while (0)
#define PG8_LDA(dst, b, h) do { _Pragma("unroll") for (int m = 0; m < 4; ++m) _Pragma("unroll") for (int k = 0; k < 2; ++k) dst[m][k] = *(const PG8_LAS bf16x8*)(lds + PG8_SA(b, h) + aoff + m * 2048 + k * 1024); } while (0)
#define PG8_LDB(dst, b, h) do { _Pragma("unroll") for (int n = 0; n < 2; ++n) _Pragma("unroll") for (int k = 0; k < 2; ++k) dst[n][k] = *(const PG8_LAS bf16x8*)(lds + PG8_SB(b, h) + boff + n * 2048 + k * 1024); } while (0)
#define PG8_MMA(ai, bj, At, Bt) do { __builtin_amdgcn_s_setprio(1); _Pragma("unroll") for (int m = 0; m < 4; ++m) _Pragma("unroll") for (int n = 0; n < 2; ++n) _Pragma("unroll") for (int k = 0; k < 2; ++k) \
        acc[ai][bj][m][n] = __builtin_amdgcn_mfma_f32_16x16x32_bf16(Bt[n][k], At[m][k], acc[ai][bj][m][n], 0, 0, 0); __builtin_amdgcn_s_setprio(0); } while (0)
#define PG8_WAIT_V(n) asm volatile("s_waitcnt vmcnt(" #n ")" ::: "memory")
#define PG8_WAIT_L(n) asm volatile("s_waitcnt lgkmcnt(" #n ")" ::: "memory")
#define PG8_BAR __builtin_amdgcn_s_barrier()
#define PG8_SCHED __builtin_amdgcn_sched_barrier(0)
    Unit cur, nxt; int ui = 0;
    if (!S.next(0, cur)) return;
    float z0_ = 0.f; asm volatile("" : "+v"(z0_));
    f32x4 acc[2][2][4][2];
#pragma unroll
    for (int a = 0; a < 2; ++a)
#pragma unroll
        for (int b = 0; b < 2; ++b)
#pragma unroll
            for (int m = 0; m < 4; ++m)
#pragma unroll
                for (int n = 0; n < 2; ++n) acc[a][b][m][n] = (f32x4){z0_, z0_, z0_, z0_};
    bf16x8 At[4][2], B0[2][2], B1[2][2];
    const char* cA = (const char*)g.A + (size_t)cur.pm * tstep; const char* cB = (const char*)g.Bt + (size_t)cur.e * g.estride + (size_t)cur.pn * tstep;
    S.a_ready(cur);
    if constexpr (SP2) {
        PG8_STAGE(PG8_SB(0, 0), cB, voffB); PG8_STAGE(PG8_SB(0, 1), cB + hstep, voffB); PG8_STAGE(PG8_SA(0, 0), cA, voffA); PG8_STAGE(PG8_SA(0, 1), cA + hstep, voffA);
        if (wr == 1) PG8_BAR;
        PG8_WAIT_V(2); PG8_BAR;
        PG8_STAGE(PG8_SB(1, 0), cB + kstep, voffB); PG8_STAGE(PG8_SA(1, 0), cA + kstep, voffA); PG8_STAGE(PG8_SB(1, 1), cB + hstep + kstep, voffB);
        PG8_WAIT_V(6); PG8_BAR;
    } else {
        PG8_STAGE(PG8_SB(0, 0), cB, voffB); PG8_STAGE(PG8_SA(0, 0), cA, voffA); PG8_STAGE(PG8_SB(0, 1), cB + hstep, voffB); PG8_STAGE(PG8_SA(0, 1), cA + hstep, voffA);
        if (wr == 1) PG8_BAR;
        PG8_WAIT_V(4); PG8_BAR;
        PG8_STAGE(PG8_SB(1, 0), cB + kstep, voffB); PG8_STAGE(PG8_SA(1, 0), cA + kstep, voffA); PG8_STAGE(PG8_SB(1, 1), cB + hstep + kstep, voffB);
        PG8_WAIT_V(6); PG8_BAR;
    }
    for (;;) {
        const bool has_next = S.next(ui + 1, nxt);
        const char* nA = has_next ? (const char*)g.A + (size_t)nxt.pm * tstep : cA; const char* nB = has_next ? (const char*)g.Bt + (size_t)nxt.e * g.estride + (size_t)nxt.pn * tstep : cB;
        for (int t = 0; t < nt; t += 2) {
            const bool last = (t == nt - 2);
            const char* a1 = cA + (size_t)(t + 1) * kstep;
            const char* a2 = last ? nA : cA + (size_t)(t + 2) * kstep; const char* b2 = last ? nB : cB + (size_t)(t + 2) * kstep;
            const char* a3 = a2 + kstep; const char* b3 = b2 + kstep;
            if (last && has_next) S.a_ready(nxt);
            if constexpr (SP2) {
            PG8_LDB(B0, 0, 0); PG8_LDB(B1, 0, 1); PG8_SCHED; PG8_LDA(At, 0, 0); PG8_STAGE(PG8_SA(1, 1), a1 + hstep, voffA);
            PG8_WAIT_V(8); PG8_WAIT_L(0); PG8_BAR; PG8_MMA(0, 0, At, B0); PG8_MMA(0, 1, At, B1); PG8_BAR; PG8_SCHED;
            PG8_LDA(At, 0, 1); PG8_STAGE(PG8_SB(0, 0), b2, voffB); PG8_STAGE(PG8_SB(0, 1), b2 + hstep, voffB); PG8_STAGE(PG8_SA(0, 0), a2, voffA);
            PG8_WAIT_V(8); PG8_WAIT_L(0); PG8_BAR; PG8_MMA(1, 0, At, B0); PG8_MMA(1, 1, At, B1); PG8_BAR; PG8_SCHED;
            PG8_LDB(B0, 1, 0); PG8_LDB(B1, 1, 1); PG8_SCHED; PG8_LDA(At, 1, 0); PG8_STAGE(PG8_SA(0, 1), a2 + hstep, voffA);
            PG8_WAIT_V(8); PG8_WAIT_L(0); PG8_BAR; PG8_MMA(0, 0, At, B0); PG8_MMA(0, 1, At, B1); PG8_BAR; PG8_SCHED;
            PG8_LDA(At, 1, 1); PG8_STAGE(PG8_SB(1, 0), b3, voffB); PG8_STAGE(PG8_SB(1, 1), b3 + hstep, voffB); PG8_STAGE(PG8_SA(1, 0), a3, voffA);
            PG8_WAIT_V(8); PG8_WAIT_L(0); PG8_BAR; PG8_MMA(1, 0, At, B0); PG8_MMA(1, 1, At, B1); PG8_BAR; PG8_SCHED;
            } else {
            PG8_LDB(B0, 0, 0); PG8_SCHED; PG8_LDA(At, 0, 0); PG8_STAGE(PG8_SA(1, 1), a1 + hstep, voffA);
            PG8_WAIT_L(8); PG8_BAR; PG8_WAIT_L(0); PG8_MMA(0, 0, At, B0); PG8_BAR; PG8_SCHED;
            PG8_LDB(B1, 0, 1); PG8_STAGE(PG8_SB(0, 0), b2, voffB);
            PG8_BAR; PG8_WAIT_L(0); PG8_MMA(0, 1, At, B1); PG8_BAR;
            PG8_LDA(At, 0, 1); PG8_STAGE(PG8_SA(0, 0), a2, voffA);
            PG8_BAR; PG8_WAIT_L(0); PG8_MMA(1, 0, At, B0); PG8_BAR; PG8_SCHED;
            PG8_STAGE(PG8_SB(0, 1), b2 + hstep, voffB);
            PG8_WAIT_V(6); PG8_BAR; PG8_MMA(1, 1, At, B1); PG8_BAR;
            PG8_LDB(B0, 1, 0); PG8_SCHED; PG8_LDA(At, 1, 0); PG8_STAGE(PG8_SA(0, 1), a2 + hstep, voffA);
            PG8_WAIT_L(8); PG8_BAR; PG8_WAIT_L(0); PG8_MMA(0, 0, At, B0); PG8_BAR; PG8_SCHED;
            PG8_LDB(B1, 1, 1); PG8_STAGE(PG8_SB(1, 0), b3, voffB);
            PG8_BAR; PG8_WAIT_L(0); PG8_MMA(0, 1, At, B1); PG8_BAR;
            PG8_LDA(At, 1, 1); PG8_STAGE(PG8_SA(1, 0), a3, voffA);
            PG8_BAR; PG8_WAIT_L(0); PG8_MMA(1, 0, At, B0); PG8_BAR; PG8_SCHED;
            PG8_STAGE(PG8_SB(1, 1), b3 + hstep, voffB);
            PG8_WAIT_V(6); PG8_BAR; PG8_MMA(1, 1, At, B1); PG8_BAR;
            }
        }
        if constexpr (ALIGN_EPI) { if (wr == 0) PG8_BAR; }
        if constexpr (!Epi::AFTER_DRAIN) { int ln2_; asm volatile("v_mbcnt_lo_u32_b32 %0, -1, 0\n\tv_mbcnt_hi_u32_b32 %0, -1, %0" : "=v"(ln2_)); E(acc, cur, wr, wc, ln2_ & 15, ln2_ >> 4); S.done(cur); }
        if (!has_next) break;
#pragma unroll
        for (int a = 0; a < 2; ++a)
#pragma unroll
            for (int b = 0; b < 2; ++b)
#pragma unroll
                for (int m = 0; m < 4; ++m)
#pragma unroll
                    for (int n = 0; n < 2; ++n) acc[a][b][m][n] = (f32x4){z0_, z0_, z0_, z0_};
        cur = nxt; cA = nA; cB = nB; ++ui;
        if constexpr (ALIGN_EPI) { if (wr == 1) PG8_BAR; }
    }
    PG8_WAIT_V(0);
    if constexpr (!ALIGN_EPI) { if (wr == 0) PG8_BAR; }
    PG8_BAR;
    if constexpr (Epi::AFTER_DRAIN) { E.fused(acc, cur, wr, wc, fr, fq, lds, wid, lane); S.done(cur); }
#undef PG8_SA
#undef PG8_SB
#undef PG8_STAGE
#undef PG8_LDA
#undef PG8_LDB
#undef PG8_MMA
#undef PG8_WAIT_V
#undef PG8_WAIT_L
#undef PG8_BAR
#undef PG8_SCHED
}
}

#ifndef ONE_LAUNCH
#define ONE_LAUNCH 1
#endif

#define GAS __attribute__((address_space(1)))
#define LAS __attribute__((address_space(3)))
typedef unsigned short bf16;
typedef float v4f __attribute__((ext_vector_type(4)));
typedef unsigned v4u __attribute__((ext_vector_type(4)));
typedef unsigned v2u __attribute__((ext_vector_type(2)));

constexpr int NB = 8, SEQ = 4096, NTOK = NB * SEQ, DM = 1024, NL = 4;
constexpr int DIN = 3090, NP = 3072;
constexpr int PC_S5 = 0, PC_GQKV = 256, PC_GZ = 1408, PC_SZ = 1792, PC_SX = 2176;
constexpr int NE = 32, DE = 256;
constexpr int MAXROWS = 2 * NTOK + NE * 256;
constexpr int MAXTILES = MAXROWS / 256;
constexpr float EPS = 1e-6f;

constexpr size_t MiB = 1u << 20;
constexpr size_t WS_CTL = 0, CTL_BYTES = 1 * MiB;
constexpr size_t WS_MOD = 1 * MiB;
constexpr size_t WS_SMW = 2 * MiB;
constexpr size_t WS_RW = 3 * MiB;
constexpr size_t WS_TI = 4 * MiB;
constexpr size_t WS_LIST = 5 * MiB;
constexpr size_t WS_SM = 9 * MiB;
constexpr size_t WS_WB = 16 * MiB;
constexpr size_t WB_IN = 0, WB_OUT = 6 * MiB, WB_GU = 8 * MiB, WB_DN = 40 * MiB;
constexpr size_t WS_P = 72 * MiB;
constexpr size_t WS_HID = WS_P + 144 * MiB;
constexpr size_t WS_H = 264 * MiB;
constexpr size_t WS_Y = 328 * MiB;
constexpr size_t WS_YRAW = 392 * MiB;
constexpr size_t WS_CS2 = 424 * MiB;
constexpr size_t WS_CD = 12 * MiB;
constexpr size_t WS_END = 600 * MiB;
static_assert((size_t)MAXROWS * DM * 2 <= 144 * MiB && (size_t)MAXROWS * DE * 2 <= 48 * MiB, "moe overlay");
constexpr int CW_BAR = 4096;
constexpr int CW_CNT = 16384;

constexpr int LDS_MISC = 147456;
constexpr int LDS_BYTES = LDS_MISC + 4096;

struct Args {
    const float* in[36]; float* out; unsigned char* ws; int ph_lo, ph_hi;
};
enum { I_X = 0, I_C, I_WADA, I_BADA, I_NMIX, I_NFFN, I_WIN, I_WOUT, I_S5ARE, I_S5AIM, I_S5BRE, I_S5BIM, I_S5CRE, I_S5CIM, I_S5D, I_S5LDT, I_S5GLU, I_S5NORM,
       I_GCW, I_GALOG, I_GDTB, I_GNORM, I_SCW, I_SCB, I_SALOG, I_SDTB, I_SD, I_SNORM, I_MWG, I_MBG, I_MWR, I_MBR, I_MGATE, I_MUP, I_MDOWN, I_NFIN };

struct Ctx { LAS unsigned char* lds; volatile LAS int* misc; unsigned char* ws; float* out; int tid, lane, wave, G, bid; };
constexpr int MISC_PTR = 448;
__device__ __forceinline__ const float* inptr(const Ctx& F, int i) { unsigned lo = (unsigned)F.misc[MISC_PTR + 2 * i], hi = (unsigned)F.misc[MISC_PTR + 2 * i + 1];
    lo = __builtin_amdgcn_readfirstlane(lo); hi = __builtin_amdgcn_readfirstlane(hi); return (const float*)(((unsigned long long)hi << 32) | lo); }

__device__ __forceinline__ Ctx launder(const Ctx& F) { Ctx G = F; int ln; asm volatile("v_mbcnt_lo_u32_b32 %0, -1, 0\n\tv_mbcnt_hi_u32_b32 %0, -1, %0" : "=v"(ln));
    int wv = F.wave; asm volatile("" : "+s"(wv)); G.wave = wv; G.lane = ln; G.tid = wv * 64 + ln;
    unsigned long long w = (unsigned long long)F.ws, o = (unsigned long long)F.out; unsigned l0 = (unsigned)(unsigned long long)F.lds; int gg = F.G, bb = F.bid; asm volatile("" : "+s"(w), "+s"(o), "+s"(l0), "+s"(gg), "+s"(bb)); G.G = gg; G.bid = bb;
    G.ws = (unsigned char*)w; G.out = (float*)o; G.lds = (LAS unsigned char*)(unsigned long long)l0; G.misc = (volatile LAS int*)(G.lds + LDS_MISC); return G; }
__device__ __forceinline__ int fresh_lane() { int ln; asm volatile("v_mbcnt_lo_u32_b32 %0, -1, 0\n\tv_mbcnt_hi_u32_b32 %0, -1, %0" : "=v"(ln)); return ln; }
__device__ __forceinline__ v4f zero4() { float z = 0.f; asm volatile("" : "+v"(z)); return (v4f){z, z, z, z}; }
__device__ __forceinline__ v4u zero4u() { unsigned z = 0u; asm volatile("" : "+v"(z)); return (v4u){z, z, z, z}; }
__device__ __forceinline__ v2u zero2u() { unsigned z = 0u; asm volatile("" : "+v"(z)); return (v2u){z, z}; }
#define LDS_WAIT() asm volatile("s_waitcnt lgkmcnt(0)" ::: "memory")
#define VM_WAIT() asm volatile("s_waitcnt vmcnt(0)" ::: "memory")

__device__ __forceinline__ float bf2f(unsigned v) { return __uint_as_float(v << 16); }
__device__ __forceinline__ unsigned f2bf(float f) { unsigned u = __float_as_uint(f); return (u + 0x7fffu + ((u >> 16) & 1u)) >> 16; }
__device__ __forceinline__ unsigned pk2(float lo, float hi) { return f2bf(lo) | (f2bf(hi) << 16); }
__device__ __forceinline__ float shx(float v, int m, int lane) { return __int_as_float(__builtin_amdgcn_ds_bpermute((lane ^ m) << 2, __float_as_int(v))); }
__device__ __forceinline__ float wave_sum_l(float v, int lane) {
#pragma unroll
    for (int o = 1; o < 64; o <<= 1) v += shx(v, o, lane);
    return v;
}
#define wave_sum(v) wave_sum_l((v), LN)
#define SHX(v, m) shx((v), (m), LN)
__device__ __forceinline__ float sigm(float x) { return 1.f / (1.f + __expf(-x)); }
__device__ __forceinline__ float silu_f(float x) { return x / (1.f + __expf(-x)); }
__device__ __forceinline__ float log1p_small(float e) { return e < 0.03125f ? e * (1.f + e * (-0.5f + e * (0.33333334f - 0.25f * e))) : __logf(1.f + e); }
__device__ __forceinline__ float softplus_f(float x) { return fmaxf(x, 0.f) + log1p_small(__expf(-fabsf(x))); }
__device__ __forceinline__ float gelu_tanh(float x) { const float u = 0.7978845608028654f * (x + 0.044715f * x * x * x); return x / (1.f + __expf(-2.f * u)); }
__device__ __forceinline__ float dot4(v4f a, v4f b) { return (a.x * b.x + a.y * b.y) + (a.z * b.z + a.w * b.w); }

#define XB_TMO      128
#define XB_XCNT(j)  (256  + 64 * (j))
#define XB_XSUB(j)  (1280 + 64 * (j))
#define XB_XGEN(j)  (2304 + 64 * (j))
#define XB_TOP      3328
#define XB_TOPGEN   3392
#define XCD_BAR_WORDS 3456
#define XB_SPIN_CAP (1u << 20)
__device__ __forceinline__ unsigned xb_ld(unsigned* p)              { return __hip_atomic_load(p, __ATOMIC_RELAXED, __HIP_MEMORY_SCOPE_AGENT); }
__device__ __forceinline__ unsigned xb_add(unsigned* p, unsigned v) { return __hip_atomic_fetch_add(p, v, __ATOMIC_RELAXED, __HIP_MEMORY_SCOPE_AGENT); }
__device__ __forceinline__ unsigned xb_xcc_id() { return (unsigned)__builtin_amdgcn_s_getreg((3 << 11) | 20) & 0xFu; }
#define XB_SPIN(cond, bar) do { unsigned _sp = 0; while (cond) { __builtin_amdgcn_s_sleep(1); \
    if ((++_sp & 255u) == 0u) { if (xb_ld(&(bar)[XB_TMO])) break; if (_sp > XB_SPIN_CAP) { atomicAdd(&(bar)[XB_TMO], 1u); break; } } } } while (0)
struct XcdBarrier { unsigned* bar; unsigned x; volatile LAS unsigned* st; };
__device__ __forceinline__ XcdBarrier xcd_barrier_post(unsigned* bar, volatile LAS unsigned* st) {
    XcdBarrier b; b.bar = bar; b.x = xb_xcc_id(); b.st = st;
    if (threadIdx.x == 0) (void)xb_add(&bar[XB_XCNT(b.x)], 1u);
    return b;
}
__device__ __forceinline__ void xcd_barrier_complete(unsigned* bar, unsigned x, unsigned& nloc, unsigned& nx) {
    const unsigned G = gridDim.x * gridDim.y * gridDim.z;
    unsigned sum, cnt, mine, sp = 0u;
    for (;;) {
        sum = 0u; cnt = 0u; mine = 0u;
#pragma unroll
        for (unsigned j = 0; j < 16; ++j) { const unsigned c = xb_ld(&bar[XB_XCNT(j)]); sum += c; cnt += (c > 0u) ? 1u : 0u; mine = (j == x) ? c : mine; }
        if (sum == G) break;
        __builtin_amdgcn_s_sleep(1);
        if ((++sp & 255u) == 0u) { if (xb_ld(&bar[XB_TMO])) break; if (sp > XB_SPIN_CAP) { atomicAdd(&bar[XB_TMO], 1u); break; } }
    }
    nloc = mine > 0u ? mine : 1u; nx = cnt > 0u ? cnt : 1u;
}
__device__ __forceinline__ void xcd_barrier(const XcdBarrier& b) {
    asm volatile("s_waitcnt vmcnt(0)" ::: "memory");
    __syncthreads();
    if (threadIdx.x == 0) {
        unsigned* bar = b.bar;
        __builtin_amdgcn_s_waitcnt(0);
        unsigned nloc = b.st[0], nx = b.st[1];
        if (nloc == 0u) { xcd_barrier_complete(bar, b.x, nloc, nx); b.st[0] = nloc; b.st[1] = nx; }
        const unsigned old = xb_add(&bar[XB_XSUB(b.x)], 1u);
        const unsigned gen = old / nloc;
        if (old + 1u == (gen + 1u) * nloc) {
            __builtin_amdgcn_fence(__ATOMIC_RELEASE, "agent");
            asm volatile("s_waitcnt vmcnt(0)" ::: "memory");
            const unsigned og = xb_add(&bar[XB_TOP], 1u);
            const unsigned tg = og / nx;
            if (og + 1u == (tg + 1u) * nx) xb_add(&bar[XB_TOPGEN], 1u);
            else XB_SPIN(xb_ld(&bar[XB_TOPGEN]) == tg, bar);
            __builtin_amdgcn_fence(__ATOMIC_ACQUIRE, "agent");
            xb_add(&bar[XB_XGEN(b.x)], 1u);
            asm volatile("s_waitcnt vmcnt(0)" ::: "memory");
        } else {
            XB_SPIN(xb_ld(&bar[XB_XGEN(b.x)]) == gen, bar);
            __builtin_amdgcn_fence(__ATOMIC_ACQUIRE, "agent");
            asm volatile("s_waitcnt vmcnt(0)" ::: "memory");
        }
    }
    __syncthreads();
}

__device__ __forceinline__ void ph_prologue(const Ctx& F0) {
    Ctx F = launder(F0);
    float* SMW = (float*)(F.ws + WS_SMW); float* RW = (float*)(F.ws + WS_RW); float* MOD = (float*)(F.ws + WS_MOD);
    const int gt = F.bid * 512 + F.tid, NT = F.G * 512;
    const float* p_win = inptr(F, I_WIN); const float* p_mwg = inptr(F, I_MWG); const float* p_mwr = inptr(F, I_MWR); const float* p_c = inptr(F, I_C); const float* p_bada = inptr(F, I_BADA);
    for (int i = gt; i < NL * 54 * DM; i += NT) {
        const int l = i / (54 * DM), r = i % (54 * DM), j = r / DM, k = r % DM;
        if (j < 18) { const int col = j < 12 ? 1792 + j : 3084 + (j - 12); SMW[(l * 18 + j) * DM + k] = p_win[((size_t)l * DM + k) * DIN + col]; }
        else { const int jj = j - 18; RW[(l * 36 + jj) * DM + k] = jj < 4 ? p_mwg[((size_t)l * DM + k) * 4 + jj] : p_mwr[((size_t)l * DM + k) * 32 + (jj - 4)]; }
    }
    LAS float* cond = (LAS float*)F.lds; LAS float* red = (LAS float*)(F.lds + 32768);
    for (int item = F.bid; item < NL * 24; item += F.G) {
        for (int i = F.tid; i < NB * DM; i += 512) cond[i] = silu_f(p_c[i]);
        __syncthreads();
        const int l = item / 24, cg = item % 24;
        v4f acc[NB];
#pragma unroll
        for (int b = 0; b < NB; ++b) acc[b] = zero4();
        const float* wp = inptr(F, I_WADA) + ((size_t)l * DM + F.wave * 128) * (6 * DM) + cg * 256 + 4 * F.lane;
#pragma unroll 8
        for (int kk = 0; kk < 128; ++kk) {
            const v4f w = *(const v4f*)(wp + (size_t)kk * (6 * DM)); const int k = F.wave * 128 + kk;
#pragma unroll
            for (int b = 0; b < NB; ++b) acc[b] += cond[b * DM + k] * w;
        }
#pragma unroll
        for (int b = 0; b < NB; ++b) *(LAS v4f*)(red + (F.wave * NB + b) * 256 + 4 * F.lane) = acc[b];
        __syncthreads();
        for (int o = F.tid; o < NB * 256; o += 512) { const int b = o / 256, col = o % 256; float s = 0.f;
#pragma unroll
            for (int w = 0; w < 8; ++w) s += red[(w * NB + b) * 256 + col];
            MOD[((size_t)l * NB + b) * (6 * DM) + cg * 256 + col] = s + p_bada[l * 6 * DM + cg * 256 + col]; }
        __syncthreads();
    }
}

__device__ __forceinline__ void transpose_item(const float* W, int ldw, int K, bf16* WT, int k0, int nsrc0, int ndst0, LAS float* scr, int lane) {
#pragma unroll 8
    for (int i = 0; i < 32; ++i) { const int kk = 2 * i + (lane >> 5); scr[kk * 33 + (lane & 31)] = W[(size_t)(k0 + kk) * ldw + nsrc0 + (lane & 31)]; }
    LDS_WAIT();
    const int c = lane & 7;
#pragma unroll
    for (int j = 0; j < 4; ++j) { const int n = (lane >> 3) + 8 * j; const LAS float* s = scr + (8 * c) * 33 + n;
        v4u o; o.x = pk2(s[0 * 33], s[1 * 33]); o.y = pk2(s[2 * 33], s[3 * 33]); o.z = pk2(s[4 * 33], s[5 * 33]); o.w = pk2(s[6 * 33], s[7 * 33]);
        *(v4u*)(WT + (size_t)(ndst0 + n) * K + k0 + 8 * c) = o; }
    LDS_WAIT();
}
constexpr int CV_IN = 16 * 96, CV_OUT = 16 * 32, CV_G = NE * 16 * 8, CV_D = NE * 4 * 32, CV_ITEMS = CV_IN + CV_OUT + 2 * CV_G + CV_D;
__device__ __forceinline__ void convert_item(Ctx& F, int l, int it, LAS float* scr, int lane) {
    unsigned char* wb = F.ws + WS_WB;
    if (it < CV_IN) { const int kb = it / 96, nb = it % 96, nd = 32 * nb, ns = nd + (nd >= 1792 ? 12 : 0);
        transpose_item(inptr(F, I_WIN) + (size_t)l * DM * DIN, DIN, DM, (bf16*)(wb + WB_IN), 64 * kb, ns, nd, scr, lane); return; }
    it -= CV_IN;
    if (it < CV_OUT) { const int kb = it / 32, nb = it % 32;
        transpose_item(inptr(F, I_WOUT) + (size_t)l * DM * DM, DM, DM, (bf16*)(wb + WB_OUT), 64 * kb, 32 * nb, 32 * nb, scr, lane); return; }
    it -= CV_OUT;
    if (it < 2 * CV_G) { const int up = it >= CV_G; if (up) it -= CV_G; const int e = it / 128, r = it % 128, kb = r / 8, nb = r % 8, j0 = 32 * nb;
        const int nd = 256 * (j0 / 128) + (j0 % 128) + (up ? 128 : 0);
        transpose_item(inptr(F, up ? I_MUP : I_MGATE) + ((size_t)l * NE + e) * DM * DE, DE, DM, (bf16*)(wb + WB_GU) + (size_t)e * 512 * DM, 64 * kb, j0, nd, scr, lane); return; }
    it -= 2 * CV_G;
    { const int e = it / 128, r = it % 128, kb = r / 32, nb = r % 32;
        transpose_item(inptr(F, I_MDOWN) + ((size_t)l * NE + e) * DE * DM, DM, DE, (bf16*)(wb + WB_DN) + (size_t)e * DM * DE, 64 * kb, 32 * nb, 32 * nb, scr, lane); }
}

__device__ __forceinline__ void build_tiles(const Ctx& F, int lc) {
    if (F.tid == 0) {
        const unsigned* cnt = (const unsigned*)(F.ws + WS_CTL) + CW_CNT + lc * NE; int acc = 0;
        for (int e = 0; e < NE; ++e) { const int c = (int)__hip_atomic_load(cnt + e, __ATOMIC_RELAXED, __HIP_MEMORY_SCOPE_AGENT); F.misc[16 + e] = acc; F.misc[64 + e] = c;
            const int nt = (c + 255) / 256; for (int t = 0; t < nt; ++t) F.misc[128 + acc + t] = e; acc += nt; }
        F.misc[16 + NE] = acc;
    }
}

__device__ __forceinline__ void ph_n1(const Ctx& F0, int l, int mode) {
    Ctx F = launder(F0);
    const int LN = F.lane;
    const float* MOD = (const float*)(F.ws + WS_MOD);
    const int lp = mode ? NL - 1 : l - 1;
    LAS float* sw = (LAS float*)F.lds;
    if (mode == 0) {
        const float* SMW = (const float*)(F.ws + WS_SMW) + (size_t)l * 18 * DM;
        for (int i = F.tid; i < 18 * DM / 4; i += 512) ((LAS v4f*)sw)[i] = ((const v4f*)SMW)[i];
    }
    if (lp >= 0) build_tiles(F, lp);
    __syncthreads();
    if (mode == 0) {
        LAS float* scr = (LAS float*)(F.lds + 73728 + F.wave * 8448);
        for (int it = F.wave * F.G + F.bid; it < CV_ITEMS; it += 8 * F.G) convert_item(F, l, it, scr, F.lane);
    }
    const int NGW = F.G * 8, gw = F.bid * 8 + F.wave, rows_per = (NTOK + NGW - 1) / NGW;
    const int r0 = gw * rows_per, r1 = (r0 + rows_per) < NTOK ? (r0 + rows_per) : NTOK;
    const float* xin = (mode == 0 && l == 0) ? inptr(F, I_X) : F.out;
    const bf16* MO = (const bf16*)(F.ws + WS_P); const int* TI = (const int*)(F.ws + WS_TI);
    bf16* H = (bf16*)(F.ws + WS_H); float* SM = (float*)(F.ws + WS_SM);
    int curb = -1; v4f An[4], Bn[4], Gp[4];
    float tc_a = 0.f, tc_b = 0.f;
    if (mode == 0) { if (F.lane < 6) { tc_a = -expf(inptr(F, I_GALOG)[l * 6 + F.lane]); tc_b = inptr(F, I_GDTB)[l * 6 + F.lane]; } else if (F.lane >= 12 && F.lane < 18) tc_b = inptr(F, I_SDTB)[l * 6 + F.lane - 12]; }
    const float* p_nrm = inptr(F, mode == 0 ? I_NMIX : I_NFIN);
#pragma unroll
    for (int j = 0; j < 4; ++j) { An[j] = zero4(); Bn[j] = An[j]; Gp[j] = An[j]; }
    for (int row = r0; row < r1; ++row) {
        const int b = row >> 12;
        if (b != curb) { curb = b;
#pragma unroll
            for (int j = 0; j < 4; ++j) { const int c = 4 * F.lane + 256 * j;
                if (mode == 0) { const v4f nm = *(const v4f*)(p_nrm + l * DM + c), sc = *(const v4f*)(MOD + ((size_t)l * NB + b) * 6 * DM + 1 * DM + c), sh = *(const v4f*)(MOD + ((size_t)l * NB + b) * 6 * DM + c);
                    An[j] = nm * (1.f + sc); Bn[j] = sh; }
                else { An[j] = *(const v4f*)(p_nrm + c); Bn[j] = zero4(); }
                if (lp >= 0) Gp[j] = *(const v4f*)(MOD + ((size_t)lp * NB + b) * 6 * DM + 5 * DM + c); }
        }
        v4f v[4];
#pragma unroll
        for (int j = 0; j < 4; ++j) v[j] = *(const v4f*)(xin + (size_t)row * DM + 4 * F.lane + 256 * j);
        if (lp >= 0) {
            const int e0 = TI[row * 8 + 0], s0 = TI[row * 8 + 1], e1 = TI[row * 8 + 3], s1 = TI[row * 8 + 4];
            const float w0 = __int_as_float(TI[row * 8 + 2]), w1 = __int_as_float(TI[row * 8 + 5]);
            const size_t ra = (size_t)(F.misc[16 + e0] * 256 + s0), rb = (size_t)(F.misc[16 + e1] * 256 + s1);
#pragma unroll
            for (int j = 0; j < 4; ++j) { const v2u a = *(const v2u*)(MO + ra * DM + 4 * F.lane + 256 * j), c = *(const v2u*)(MO + rb * DM + 4 * F.lane + 256 * j);
                const v4f ya = (v4f){bf2f(a.x & 0xffffu), bf2f(a.x >> 16), bf2f(a.y & 0xffffu), bf2f(a.y >> 16)}, yb = (v4f){bf2f(c.x & 0xffffu), bf2f(c.x >> 16), bf2f(c.y & 0xffffu), bf2f(c.y >> 16)};
                v[j] += Gp[j] * (w0 * ya + w1 * yb); }
            if (mode == 0) {
#pragma unroll
                for (int j = 0; j < 4; ++j) *(v4f*)(F.out + (size_t)row * DM + 4 * F.lane + 256 * j) = v[j];
            }
        }
        float ss = 0.f;
#pragma unroll
        for (int j = 0; j < 4; ++j) ss += dot4(v[j], v[j]);
        const float rs = rsqrtf(wave_sum(ss) * (1.f / DM) + EPS);
        v4f h[4];
#pragma unroll
        for (int j = 0; j < 4; ++j) h[j] = v[j] * rs * An[j] + Bn[j];
        if (mode == 1) {
#pragma unroll
            for (int j = 0; j < 4; ++j) *(v4f*)(F.out + (size_t)row * DM + 4 * F.lane + 256 * j) = h[j];
            continue;
        }
#pragma unroll
        for (int j = 0; j < 4; ++j) { v2u o; o.x = pk2(h[j].x, h[j].y); o.y = pk2(h[j].z, h[j].w); *(v2u*)(H + (size_t)row * DM + 4 * F.lane + 256 * j) = o; }
        float mine = 0.f;
#pragma unroll 2
        for (int c = 0; c < 18; ++c) { float s = 0.f;
#pragma unroll
            for (int j = 0; j < 4; ++j) s += dot4(h[j], ((const LAS v4f*)sw)[c * 256 + 64 * j + F.lane]);
            s = wave_sum(s); mine = (F.lane == c) ? s : mine; }
        if (F.lane < 18) { float r;
            if (F.lane < 6) r = tc_a * softplus_f(mine + tc_b);
            else if (F.lane < 12) r = sigm(mine);
            else r = softplus_f(mine + tc_b);
            SM[(size_t)row * 18 + F.lane] = r; }
    }
}

constexpr int TB = 8;
__device__ __forceinline__ void gdn_naive(Ctx& F, int l, int b, int hh, int cq, LAS float* wl, int lane) {
    const int LN = lane;
    const bf16* P = (const bf16*)(F.ws + WS_P); const float* SM = (const float*)(F.ws + WS_SM); float* YR = (float*)(F.ws + WS_YRAW);
    const int el = lane & 15, dq = lane >> 4;
    float S[16];
#pragma unroll
    for (int i = 0; i < 16; ++i) S[i] = 0.f;
    const float* cw = inptr(F, I_GCW) + (size_t)l * 4 * 1152; const int chq = hh * 64 + lane, chk = 384 + chq, chv = 768 + chq;
    float wq[4], wk[4], wv[4];
#pragma unroll
    for (int j = 0; j < 4; ++j) { wq[j] = cw[j * 1152 + chq]; wk[j] = cw[j * 1152 + chk]; wv[j] = cw[j * 1152 + chv]; }
    float q1 = 0, q2 = 0, q3 = 0, k1 = 0, k2 = 0, k3 = 0, v1 = 0, v2 = 0, v3 = 0;
    for (int t0 = 0; t0 < SEQ; t0 += TB) {
        float xq[TB], xk[TB], xv[TB], gg[TB], bb[TB];
#pragma unroll
        for (int i = 0; i < TB; ++i) { const size_t row = (size_t)b * SEQ + t0 + i; const bf16* pr = P + row * NP + PC_GQKV;
            xq[i] = bf2f(pr[chq]); xk[i] = bf2f(pr[chk]); xv[i] = bf2f(pr[chv]); gg[i] = SM[row * 18 + hh]; bb[i] = SM[row * 18 + 6 + hh]; }
#pragma unroll
        for (int i = 0; i < TB; ++i) {
            const size_t row = (size_t)b * SEQ + t0 + i;
            float cq_ = wq[0] * q3 + wq[1] * q2 + wq[2] * q1 + wq[3] * xq[i]; q3 = q2; q2 = q1; q1 = xq[i];
            float ck_ = wk[0] * k3 + wk[1] * k2 + wk[2] * k1 + wk[3] * xk[i]; k3 = k2; k2 = k1; k1 = xk[i];
            float cv_ = wv[0] * v3 + wv[1] * v2 + wv[2] * v1 + wv[3] * xv[i]; v3 = v2; v2 = v1; v1 = xv[i];
            cq_ = silu_f(cq_); ck_ = silu_f(ck_); cv_ = silu_f(cv_);
            const float qn = cq_ * rsqrtf(wave_sum(cq_ * cq_) + EPS) * 0.125f, kn = ck_ * rsqrtf(wave_sum(ck_ * ck_) + EPS);
            wl[lane] = qn; wl[64 + lane] = kn; wl[128 + lane] = cv_;
            LDS_WAIT();
            float kd[16], qd[16];
#pragma unroll
            for (int j = 0; j < 4; ++j) { const v4f a = *(const LAS v4f*)(wl + 64 + 16 * dq + 4 * j), c = *(const LAS v4f*)(wl + 16 * dq + 4 * j);
                kd[4 * j] = a.x; kd[4 * j + 1] = a.y; kd[4 * j + 2] = a.z; kd[4 * j + 3] = a.w; qd[4 * j] = c.x; qd[4 * j + 1] = c.y; qd[4 * j + 2] = c.z; qd[4 * j + 3] = c.w; }
            const float ve = wl[128 + 16 * cq + el];
            LDS_WAIT();
            const float a = __expf(gg[i]);
            float ks = 0.f;
#pragma unroll
            for (int j = 0; j < 16; ++j) ks += kd[j] * S[j];
            ks += SHX(ks, 16); ks += SHX(ks, 32);
            const float vn = bb[i] * (ve - a * ks);
            float o = 0.f;
#pragma unroll
            for (int j = 0; j < 16; ++j) { S[j] = a * S[j] + kd[j] * vn; o += qd[j] * S[j]; }
            o += SHX(o, 16); o += SHX(o, 32);
            if (dq == 0) YR[row * DM + 256 + hh * 64 + 16 * cq + el] = o;
        }
    }
}
__device__ __forceinline__ void ssd_naive(Ctx& F, int l, int b, int hh, int pq, LAS float* wl, int lane) {
    const int LN = lane;
    const bf16* P = (const bf16*)(F.ws + WS_P); const float* SM = (const float*)(F.ws + WS_SM); float* YR = (float*)(F.ws + WS_YRAW);
    const int pl = lane & 15, nq = lane >> 4, gi = hh / 3, p = 16 * pq + pl;
    float hs[32];
#pragma unroll
    for (int i = 0; i < 32; ++i) hs[i] = 0.f;
    const float* cw = inptr(F, I_SCW) + (size_t)l * 4 * 896; const float* cb = inptr(F, I_SCB) + (size_t)l * 896;
    const int cB0 = 384 + gi * 128 + lane, cB1 = cB0 + 64, cC0 = 640 + gi * 128 + lane, cC1 = cC0 + 64, cX = hh * 64 + p;
    float wB0[4], wB1[4], wC0[4], wC1[4], wX[4];
#pragma unroll
    for (int j = 0; j < 4; ++j) { wB0[j] = cw[j * 896 + cB0]; wB1[j] = cw[j * 896 + cB1]; wC0[j] = cw[j * 896 + cC0]; wC1[j] = cw[j * 896 + cC1]; wX[j] = cw[j * 896 + cX]; }
    const float bB0 = cb[cB0], bB1 = cb[cB1], bC0 = cb[cC0], bC1 = cb[cC1], bX = cb[cX];
    const float Aneg = -expf(inptr(F, I_SALOG)[l * 6 + hh]), Dsk = inptr(F, I_SD)[l * 6 + hh];
    float hB0[3] = {0, 0, 0}, hB1[3] = {0, 0, 0}, hC0[3] = {0, 0, 0}, hC1[3] = {0, 0, 0}, hX[3] = {0, 0, 0};
    for (int t0 = 0; t0 < SEQ; t0 += TB) {
        float xB0[TB], xB1[TB], xC0[TB], xC1[TB], xX[TB], xZ[TB], dts[TB];
#pragma unroll
        for (int i = 0; i < TB; ++i) { const size_t row = (size_t)b * SEQ + t0 + i; const bf16* pr = P + row * NP;
            xB0[i] = bf2f(pr[PC_SX + cB0]); xB1[i] = bf2f(pr[PC_SX + cB1]); xC0[i] = bf2f(pr[PC_SX + cC0]); xC1[i] = bf2f(pr[PC_SX + cC1]); xX[i] = bf2f(pr[PC_SX + cX]);
            xZ[i] = bf2f(pr[PC_SZ + hh * 64 + p]); dts[i] = SM[row * 18 + 12 + hh]; }
#pragma unroll
        for (int i = 0; i < TB; ++i) {
            const size_t row = (size_t)b * SEQ + t0 + i;
#define CONV1(w, hst, x, bias) ({ float _y = w[0] * hst[2] + w[1] * hst[1] + w[2] * hst[0] + w[3] * (x) + (bias); hst[2] = hst[1]; hst[1] = hst[0]; hst[0] = (x); silu_f(_y); })
            const float vB0 = CONV1(wB0, hB0, xB0[i], bB0), vB1 = CONV1(wB1, hB1, xB1[i], bB1), vC0 = CONV1(wC0, hC0, xC0[i], bC0), vC1 = CONV1(wC1, hC1, xC1[i], bC1), vX = CONV1(wX, hX, xX[i], bX);
#undef CONV1
            wl[lane] = vB0; wl[64 + lane] = vB1; wl[128 + lane] = vC0; wl[192 + lane] = vC1;
            LDS_WAIT();
            float Bv[32], Cv[32];
#pragma unroll
            for (int j = 0; j < 8; ++j) { const v4f a = *(const LAS v4f*)(wl + 32 * nq + 4 * j), c = *(const LAS v4f*)(wl + 128 + 32 * nq + 4 * j);
                Bv[4 * j] = a.x; Bv[4 * j + 1] = a.y; Bv[4 * j + 2] = a.z; Bv[4 * j + 3] = a.w; Cv[4 * j] = c.x; Cv[4 * j + 1] = c.y; Cv[4 * j + 2] = c.z; Cv[4 * j + 3] = c.w; }
            LDS_WAIT();
            const float dt = dts[i], dA = __expf(dt * Aneg), xdt = vX * dt;
            float y = 0.f;
#pragma unroll
            for (int j = 0; j < 32; ++j) { hs[j] = dA * hs[j] + xdt * Bv[j]; y += Cv[j] * hs[j]; }
            y += SHX(y, 16); y += SHX(y, 32);
            y = (y + Dsk * vX) * silu_f(xZ[i]);
            if (nq == 0) YR[row * DM + 640 + hh * 64 + p] = y;
        }
    }
}
__device__ __forceinline__ void s5_naive(Ctx& F, int l, int b, int g, int lane) {
    const int LN = lane;
    const bf16* P = (const bf16*)(F.ws + WS_P); float* YR = (float*)(F.ws + WS_YRAW);
    const int gp = (l * 16 + g) * 64 + lane;
    const float are = inptr(F, I_S5ARE)[gp], aim = inptr(F, I_S5AIM)[gp], step = expf(inptr(F, I_S5LDT)[l * 16 + g]);
    const float mag = expf(are * step); float sn, cs; sincosf(aim * step, &sn, &cs);
    const float lbr = mag * cs, lbi = mag * sn;
    const float nr = lbr - 1.f, ni = lbi, den = are * are + aim * aim;
    const float fr = (nr * are + ni * aim) / den, fi = (ni * are - nr * aim) / den;
    float Br[16], Bi[16], Cr[16], Ci[16], Dk[16];
#pragma unroll
    for (int c = 0; c < 16; ++c) { const float br = inptr(F, I_S5BRE)[(size_t)gp * 16 + c], bi = inptr(F, I_S5BIM)[(size_t)gp * 16 + c];
        Br[c] = fr * br - fi * bi; Bi[c] = fr * bi + fi * br;
        Cr[c] = inptr(F, I_S5CRE)[((size_t)(l * 16 + g) * 16 + c) * 64 + lane]; Ci[c] = inptr(F, I_S5CIM)[((size_t)(l * 16 + g) * 16 + c) * 64 + lane];
        Dk[c] = inptr(F, I_S5D)[l * 256 + g * 16 + c]; }
    float sr = 0.f, si = 0.f;
    for (int t0 = 0; t0 < SEQ; t0 += TB) {
        v4u ua[TB], ub[TB];
#pragma unroll
        for (int i = 0; i < TB; ++i) { const size_t row = (size_t)b * SEQ + t0 + i; const v4u* pr = (const v4u*)(P + row * NP + PC_S5 + g * 16); ua[i] = pr[0]; ub[i] = pr[1]; }
#pragma unroll
        for (int i = 0; i < TB; ++i) {
            const size_t row = (size_t)b * SEQ + t0 + i;
            float u[16];
            u[0] = bf2f(ua[i].x & 0xffffu); u[1] = bf2f(ua[i].x >> 16); u[2] = bf2f(ua[i].y & 0xffffu); u[3] = bf2f(ua[i].y >> 16);
            u[4] = bf2f(ua[i].z & 0xffffu); u[5] = bf2f(ua[i].z >> 16); u[6] = bf2f(ua[i].w & 0xffffu); u[7] = bf2f(ua[i].w >> 16);
            u[8] = bf2f(ub[i].x & 0xffffu); u[9] = bf2f(ub[i].x >> 16); u[10] = bf2f(ub[i].y & 0xffffu); u[11] = bf2f(ub[i].y >> 16);
            u[12] = bf2f(ub[i].z & 0xffffu); u[13] = bf2f(ub[i].z >> 16); u[14] = bf2f(ub[i].w & 0xffffu); u[15] = bf2f(ub[i].w >> 16);
            float bur = 0.f, bui = 0.f;
#pragma unroll
            for (int c = 0; c < 16; ++c) { bur += Br[c] * u[c]; bui += Bi[c] * u[c]; }
            const float nsr = lbr * sr - lbi * si + bur, nsi = lbr * si + lbi * sr + bui; sr = nsr; si = nsi;
            float mine = 0.f;
#pragma unroll
            for (int c = 0; c < 16; ++c) { float y = wave_sum(Cr[c] * sr - Ci[c] * si) + Dk[c] * u[c]; mine = (lane == c) ? y : mine; }
            if (lane < 16) YR[row * 256 + g * 16 + lane] = gelu_tanh(mine);
        }
    }
}
__device__ __forceinline__ void ph_m2(const Ctx& F0, int l) {
    Ctx F = launder(F0);
    const int u = F.wave * F.G + F.bid;
    LAS float* wl = (LAS float*)(F.lds + F.wave * 4096);
    if (u < 128) s5_naive(F, l, u / 16, u % 16, F.lane);
}


typedef short bf16x8 __attribute__((ext_vector_type(8)));
#define MFMA16(a, b, c) __builtin_amdgcn_mfma_f32_16x16x32_bf16((a), (b), (c), 0, 0, 0)
__device__ __forceinline__ bf16x8 ldsfrag(LAS unsigned char* base, int row, int stride, int kb) { return *(const LAS bf16x8*)(base + row * stride + kb); }
__device__ __forceinline__ float wave_incl_scan(float v, int lane) {
#pragma unroll
    for (int o = 1; o < 64; o <<= 1) { const float t = __int_as_float(__builtin_amdgcn_ds_bpermute((lane >= o ? lane - o : lane) << 2, __float_as_int(v))); if (lane >= o) v += t; }
    return v;
}
__device__ __forceinline__ float lane63(float v) { return __int_as_float(__builtin_amdgcn_readlane(__float_as_int(v), 63)); }
__device__ __forceinline__ void conv8x8(const bf16* P, size_t rowbase, int t0, bool has_prev, int pcol, const float* cw, int cstride, const float* cb, float (&out)[8][8]) {
    float xf[11][8];
#pragma unroll
    for (int i = 0; i < 11; ++i) {
        v4u v = zero4u();
        if (has_prev || t0 + i >= 3) v = *(const v4u*)(P + (rowbase + t0 + i - 3) * NP + pcol);
        xf[i][0] = bf2f(v.x & 0xffffu); xf[i][1] = bf2f(v.x >> 16); xf[i][2] = bf2f(v.y & 0xffffu); xf[i][3] = bf2f(v.y >> 16);
        xf[i][4] = bf2f(v.z & 0xffffu); xf[i][5] = bf2f(v.z >> 16); xf[i][6] = bf2f(v.w & 0xffffu); xf[i][7] = bf2f(v.w >> 16);
    }
    float w[4][8], bs[8];
#pragma unroll
    for (int j = 0; j < 4; ++j) { const v4f a = *(const v4f*)(cw + j * cstride), c = *(const v4f*)(cw + j * cstride + 4);
        w[j][0] = a.x; w[j][1] = a.y; w[j][2] = a.z; w[j][3] = a.w; w[j][4] = c.x; w[j][5] = c.y; w[j][6] = c.z; w[j][7] = c.w; }
    if (cb) { const v4f a = *(const v4f*)cb, c = *(const v4f*)(cb + 4); bs[0] = a.x; bs[1] = a.y; bs[2] = a.z; bs[3] = a.w; bs[4] = c.x; bs[5] = c.y; bs[6] = c.z; bs[7] = c.w; }
    else {
#pragma unroll
        for (int c = 0; c < 8; ++c) bs[c] = 0.f; }
#pragma unroll
    for (int t = 0; t < 8; ++t)
#pragma unroll
        for (int c = 0; c < 8; ++c) out[t][c] = silu_f(w[0][c] * xf[t][c] + w[1][c] * xf[t + 1][c] + w[2][c] * xf[t + 2][c] + w[3][c] * xf[t + 3][c] + bs[c]);
}
constexpr int SS_XST = 0, SS_XST_S = 144;
constexpr int SS_BROW = 27648, SS_ROW_S = 272;
constexpr int SS_CROW = 45056;
constexpr int SS_BT = 27648, SS_BT_S = 144;
constexpr int SS_MH = 62464, SS_MH_S = 144;
constexpr int SS_Z = 90112, SS_Z_S = 400;
constexpr int SS_F = 115712;
__device__ __forceinline__ void ssd_s1_unit(Ctx& F, int l, int unit) {
    const int b = unit >> 7, n = (unit >> 1) & 63, g = unit & 1; const size_t rowbase = (size_t)b * SEQ + n * 64;
    const bf16* P = (const bf16*)(F.ws + WS_P); const float* SM = (const float*)(F.ws + WS_SM);
    bf16* CS = (bf16*)(F.ws + WS_CS2); float* CD = (float*)(F.ws + WS_CD);
    LAS float* ff = (LAS float*)(F.lds + SS_F);
    if (F.wave < 3) { const int hh = 3 * g + F.wave; const float dt = SM[(rowbase + F.lane) * 18 + 12 + hh], An = -__expf(inptr(F, I_SALOG)[l * 6 + hh]);
        const float acs = wave_incl_scan(dt * An, F.lane), last = lane63(acs);
        ff[F.wave * 64 + F.lane] = acs; ff[384 + F.wave * 64 + F.lane] = dt * __expf(last - acs);
        if (F.lane == 63) CD[(b * 6 + hh) * 64 + n] = __expf(last); }
    __syncthreads();
    if (F.tid < 320) { const int cg = F.tid >> 3, t0 = (F.tid & 7) * 8; float o[8][8];
        const float* cw = inptr(F, I_SCW) + (size_t)l * 4 * 896; const float* cb = inptr(F, I_SCB) + (size_t)l * 896;
        if (cg < 24) { const int ch = g * 192 + cg * 8, hl = cg >> 3;
            conv8x8(P, rowbase, t0, n > 0, PC_SX + ch, cw + ch, 896, cb + ch, o);
#pragma unroll
            for (int c = 0; c < 8; ++c) { v4u w; const LAS float* wv = ff + 384 + hl * 64 + t0;
                w.x = pk2(o[0][c] * wv[0], o[1][c] * wv[1]); w.y = pk2(o[2][c] * wv[2], o[3][c] * wv[3]); w.z = pk2(o[4][c] * wv[4], o[5][c] * wv[5]); w.w = pk2(o[6][c] * wv[6], o[7][c] * wv[7]);
                *(LAS v4u*)(F.lds + SS_XST + (cg * 8 + c) * SS_XST_S + t0 * 2) = w; } }
        else { const int d0 = (cg - 24) * 8, ch = 384 + g * 128 + d0;
            conv8x8(P, rowbase, t0, n > 0, PC_SX + ch, cw + ch, 896, cb + ch, o);
#pragma unroll
            for (int c = 0; c < 8; ++c) { v4u w; w.x = pk2(o[0][c], o[1][c]); w.y = pk2(o[2][c], o[3][c]); w.z = pk2(o[4][c], o[5][c]); w.w = pk2(o[6][c], o[7][c]);
                *(LAS v4u*)(F.lds + SS_BT + (d0 + c) * SS_BT_S + t0 * 2) = w; } }
    }
    __syncthreads();
    const int fr = F.lane & 15, fq = F.lane >> 4;
    for (int ti = F.wave * 12; ti < F.wave * 12 + 12; ++ti) {
        const int h = ti >> 5, dtl = (ti >> 2) & 7, pt = ti & 3;
        pg8::f32x4 acc = zero4();
#pragma unroll
        for (int ks = 0; ks < 2; ++ks) acc = MFMA16(ldsfrag(F.lds + SS_BT, 16 * dtl + fr, SS_BT_S, 64 * ks + 16 * fq), ldsfrag(F.lds + SS_XST, 64 * h + 16 * pt + fr, SS_XST_S, 64 * ks + 16 * fq), acc);
        v2u w; w.x = pk2(acc[0], acc[1]); w.y = pk2(acc[2], acc[3]);
        *(v2u*)(CS + ((size_t)((b * 6 + 3 * g + h) * 64 + n) * 64 + 16 * pt + fr) * 128 + 16 * dtl + 4 * fq) = w;
    }
    __syncthreads();
}
__device__ __forceinline__ void ssd_s2(Ctx& F) {
    bf16* CS = (bf16*)(F.ws + WS_CS2); const float* CD = (const float*)(F.ws + WS_CD);
    for (int task = F.bid * 512 + F.tid; task < 48 * 1024; task += F.G * 512) {
        const int bh = task >> 10, e = (task & 1023) * 8; float s[8];
#pragma unroll
        for (int i = 0; i < 8; ++i) s[i] = 0.f;
        for (int n0 = 0; n0 < 64; n0 += 8) { v4u v[8]; float cd[8];
#pragma unroll
            for (int i = 0; i < 8; ++i) { v[i] = *(const v4u*)(CS + (size_t)(bh * 64 + n0 + i) * 8192 + e); cd[i] = CD[bh * 64 + n0 + i]; }
#pragma unroll
            for (int i = 0; i < 8; ++i) { v4u o; o.x = pk2(s[0], s[1]); o.y = pk2(s[2], s[3]); o.z = pk2(s[4], s[5]); o.w = pk2(s[6], s[7]);
                *(v4u*)(CS + (size_t)(bh * 64 + n0 + i) * 8192 + e) = o;
                s[0] = cd[i] * s[0] + bf2f(v[i].x & 0xffffu); s[1] = cd[i] * s[1] + bf2f(v[i].x >> 16); s[2] = cd[i] * s[2] + bf2f(v[i].y & 0xffffu); s[3] = cd[i] * s[3] + bf2f(v[i].y >> 16);
                s[4] = cd[i] * s[4] + bf2f(v[i].z & 0xffffu); s[5] = cd[i] * s[5] + bf2f(v[i].z >> 16); s[6] = cd[i] * s[6] + bf2f(v[i].w & 0xffffu); s[7] = cd[i] * s[7] + bf2f(v[i].w >> 16); }
        }
    }
}
__device__ __forceinline__ void ssd_s3_unit(Ctx& F, int l, int unit) {
    const int LN = F.lane;
    const int b = unit >> 7, n = (unit >> 1) & 63, g = unit & 1; const size_t rowbase = (size_t)b * SEQ + n * 64;
    const bf16* P = (const bf16*)(F.ws + WS_P); const float* SM = (const float*)(F.ws + WS_SM);
    const bf16* CS = (const bf16*)(F.ws + WS_CS2); bf16* Y = (bf16*)(F.ws + WS_Y);
    LAS float* ff = (LAS float*)(F.lds + SS_F);
    const int fr = F.lane & 15, fq = F.lane >> 4;
    if (F.wave < 3) { const int hh = 3 * g + F.wave; const float dt = SM[(rowbase + F.lane) * 18 + 12 + hh], An = -__expf(inptr(F, I_SALOG)[l * 6 + hh]);
        ff[F.wave * 64 + F.lane] = wave_incl_scan(dt * An, F.lane); ff[192 + F.wave * 64 + F.lane] = dt; }
    if (F.tid < 448) { const int cg = F.tid >> 3, t0 = (F.tid & 7) * 8; float o[8][8];
        const float* cw = inptr(F, I_SCW) + (size_t)l * 4 * 896; const float* cb = inptr(F, I_SCB) + (size_t)l * 896;
        if (cg < 24) { const int ch = g * 192 + cg * 8;
            conv8x8(P, rowbase, t0, n > 0, PC_SX + ch, cw + ch, 896, cb + ch, o);
#pragma unroll
            for (int c = 0; c < 8; ++c) { v4u w; w.x = pk2(o[0][c], o[1][c]); w.y = pk2(o[2][c], o[3][c]); w.z = pk2(o[4][c], o[5][c]); w.w = pk2(o[6][c], o[7][c]);
                *(LAS v4u*)(F.lds + SS_XST + (cg * 8 + c) * SS_XST_S + t0 * 2) = w; } }
        else { const int isC = cg >= 40, d0 = (cg - (isC ? 40 : 24)) * 8, ch = (isC ? 640 : 384) + g * 128 + d0;
            conv8x8(P, rowbase, t0, n > 0, PC_SX + ch, cw + ch, 896, cb + ch, o);
#pragma unroll
            for (int t = 0; t < 8; ++t) { v4u w; w.x = pk2(o[t][0], o[t][1]); w.y = pk2(o[t][2], o[t][3]); w.z = pk2(o[t][4], o[t][5]); w.w = pk2(o[t][6], o[t][7]);
                *(LAS v4u*)(F.lds + (isC ? SS_CROW : SS_BROW) + (t0 + t) * SS_ROW_S + d0 * 2) = w; } }
    }
    for (int c = F.tid; c < 64 * 24; c += 512) { const int t = c / 24, c8 = c % 24;
        *(LAS v4u*)(F.lds + SS_Z + t * SS_Z_S + c8 * 16) = *(const v4u*)(P + (rowbase + t) * NP + PC_SZ + g * 192 + c8 * 8); }
    __syncthreads();
    for (int ti = F.wave; ti < 10; ti += 8) {
        int lt = 0, mt = ti; while (mt > lt) { mt -= lt + 1; ++lt; }
        pg8::f32x4 acc = zero4();
#pragma unroll
        for (int ks = 0; ks < 4; ++ks) acc = MFMA16(ldsfrag(F.lds + SS_BROW, 16 * mt + fr, SS_ROW_S, 64 * ks + 16 * fq), ldsfrag(F.lds + SS_CROW, 16 * lt + fr, SS_ROW_S, 64 * ks + 16 * fq), acc);
        const int lrow = 16 * lt + fr, m0 = 16 * mt + 4 * fq;
#pragma unroll
        for (int h = 0; h < 3; ++h) { const float al = ff[h * 64 + lrow], Dh = inptr(F, I_SD)[l * 6 + 3 * g + h]; float mv[4];
#pragma unroll
            for (int r = 0; r < 4; ++r) { const int m = m0 + r; mv[r] = m <= lrow ? acc[r] * __expf(al - ff[h * 64 + m]) * ff[192 + h * 64 + m] + (m == lrow ? Dh : 0.f) : 0.f; }
            v2u w; w.x = pk2(mv[0], mv[1]); w.y = pk2(mv[2], mv[3]);
            *(LAS v2u*)(F.lds + SS_MH + h * (64 * SS_MH_S) + lrow * SS_MH_S + m0 * 2) = w;
            if (lt == mt && (lt & 1) == 0) *(LAS v2u*)(F.lds + SS_MH + h * (64 * SS_MH_S) + lrow * SS_MH_S + (m0 + 16) * 2) = zero2u(); }
    }
    __syncthreads();
    const int lt = F.wave & 3, ph = F.wave >> 2, tokl = 16 * lt + fr;
    float yv[6][4]; float ss = 0.f;
#pragma unroll
    for (int i = 0; i < 6; ++i) { const int pt = ph * 6 + i, h = pt >> 2;
        pg8::f32x4 ad = zero4(), ao = ad;
#pragma unroll
        for (int ks = 0; ks < 2; ++ks) if (2 * ks <= lt) ad = MFMA16(ldsfrag(F.lds + SS_XST, 16 * pt + fr, SS_XST_S, 64 * ks + 16 * fq), ldsfrag(F.lds + SS_MH + h * (64 * SS_MH_S), tokl, SS_MH_S, 64 * ks + 16 * fq), ad);
        const bf16* sp = CS + ((size_t)((b * 6 + 3 * g + h) * 64 + n) * 64 + 16 * (pt & 3) + fr) * 128 + 8 * fq;
#pragma unroll
        for (int ks = 0; ks < 4; ++ks) ao = MFMA16(*(const bf16x8*)(sp + 32 * ks), ldsfrag(F.lds + SS_CROW, tokl, SS_ROW_S, 64 * ks + 16 * fq), ao);
        const float ea = __expf(ff[h * 64 + tokl]);
        const v2u zz = *(const LAS v2u*)(F.lds + SS_Z + tokl * SS_Z_S + (16 * pt + 4 * fq) * 2);
        const float z0 = bf2f(zz.x & 0xffffu), z1 = bf2f(zz.x >> 16), z2 = bf2f(zz.y & 0xffffu), z3 = bf2f(zz.y >> 16);
        yv[i][0] = (ad[0] + ea * ao[0]) * silu_f(z0); yv[i][1] = (ad[1] + ea * ao[1]) * silu_f(z1); yv[i][2] = (ad[2] + ea * ao[2]) * silu_f(z2); yv[i][3] = (ad[3] + ea * ao[3]) * silu_f(z3);
        ss += (yv[i][0] * yv[i][0] + yv[i][1] * yv[i][1]) + (yv[i][2] * yv[i][2] + yv[i][3] * yv[i][3]);
    }
    ss += SHX(ss, 16); ss += SHX(ss, 32);
    if (fq == 0) ff[576 + ph * 64 + tokl] = ss;
    __syncthreads();
    const float rs = rsqrtf((ff[576 + tokl] + ff[576 + 64 + tokl]) * (1.f / 192.f) + EPS);
    const float* nw = inptr(F, I_SNORM) + l * 384 + g * 192;
#pragma unroll
    for (int i = 0; i < 6; ++i) { const int pt = ph * 6 + i; const v4f wv = *(const v4f*)(nw + 16 * pt + 4 * fq);
        v2u w; w.x = pk2(yv[i][0] * rs * wv.x, yv[i][1] * rs * wv.y); w.y = pk2(yv[i][2] * rs * wv.z, yv[i][3] * rs * wv.w);
        *(v2u*)(Y + (rowbase + tokl) * DM + 640 + g * 192 + 16 * pt + 4 * fq) = w; }
    __syncthreads();
}
__device__ __forceinline__ void ph_s1(const Ctx& F0, int l) { Ctx F = launder(F0); for (int u = F.bid; u < 1024; u += F.G) ssd_s1_unit(F, l, u); }
__device__ __forceinline__ void ph_s2(const Ctx& F0) { Ctx F = launder(F0); ssd_s2(F); }
__device__ __forceinline__ void ph_s3(const Ctx& F0, int l) { Ctx F = launder(F0); for (int u = F.bid; u < 1024; u += F.G) ssd_s3_unit(F, l, u); }


constexpr int GD_KN = 0, GD_QN = 9216, GD_KDT = 18432, GD_RV = 27648, GD_RK = 36864, GD_AT = 46080, GD_L = 55296, GD_F = 72704, GD_HALF = 73728, GD_S = 144, GD_LS = 272;
constexpr size_t WS_GAN = 472 * MiB, WS_GBN = 496 * MiB, WS_GQE = 520 * MiB, WS_GO1 = 544 * MiB, WS_GSP = 568 * MiB;
__device__ __forceinline__ void decode_lower(int ti, int& lt, int& mt) { lt = 0; mt = ti; while (mt > lt) { mt -= lt + 1; ++lt; } }
__device__ __forceinline__ void gdn_g1_pair(const Ctx& F0, int l, int pair) {
    Ctx F = F0; F.lane = fresh_lane(); F.tid = F.wave * 64 + F.lane;
    int LN = F.lane;
    const int half = F.wave >> 2, uw = F.wave & 3, unit = 2 * pair + half, hh = unit % 6, bn = unit / 6, b = bn >> 6, n = bn & 63;
    const size_t rowbase = (size_t)b * SEQ + n * 64;
    const bf16* P = (const bf16*)(F.ws + WS_P); const float* SM = (const float*)(F.ws + WS_SM);
    LAS unsigned char* lb = F.lds + half * GD_HALF; LAS float* fg = (LAS float*)(lb + GD_F);
    int fr = F.lane & 15, fq = F.lane >> 4;
    float o[8][8]; const int seg = F.lane & 7, cg = F.lane >> 3, t0 = seg * 8;
    if (uw < 3) {
        const int ch = uw * 384 + hh * 64 + cg * 8;
        conv8x8(P, rowbase, t0, n > 0, PC_GQKV + ch, inptr(F, I_GCW) + (size_t)l * 4 * 1152 + ch, 1152, nullptr, o);
        if (uw < 2) {
#pragma unroll
            for (int t = 0; t < 8; ++t) { float ss = 0.f;
#pragma unroll
                for (int c = 0; c < 8; ++c) ss += o[t][c] * o[t][c];
                ss += SHX(ss, 8); ss += SHX(ss, 16); ss += SHX(ss, 32);
                const float sc = rsqrtf(ss + EPS) * (uw == 0 ? 0.125f : 1.f);
#pragma unroll
                for (int c = 0; c < 8; ++c) o[t][c] *= sc; }
        }
    } else {
        const float g = SM[(rowbase + F.lane) * 18 + hh], be = SM[(rowbase + F.lane) * 18 + 6 + hh];
        const float gc = wave_incl_scan(g, F.lane);
        fg[F.lane] = gc; fg[64 + F.lane] = be;
    }
    __syncthreads();
    if (uw == 0) {
#pragma unroll
        for (int t = 0; t < 8; ++t) { v4u w; w.x = pk2(o[t][0], o[t][1]); w.y = pk2(o[t][2], o[t][3]); w.z = pk2(o[t][4], o[t][5]); w.w = pk2(o[t][6], o[t][7]);
            *(LAS v4u*)(lb + GD_QN + (t0 + t) * GD_S + cg * 16) = w; }
    } else if (uw == 1) {
        const float gl = fg[63]; float fk[8], fw[8];
#pragma unroll
        for (int t = 0; t < 8; ++t) { const float gc = fg[t0 + t]; fk[t] = __expf(gl - gc); fw[t] = fg[64 + t0 + t] * __expf(gc); }
#pragma unroll
        for (int t = 0; t < 8; ++t) { v4u w; w.x = pk2(o[t][0], o[t][1]); w.y = pk2(o[t][2], o[t][3]); w.z = pk2(o[t][4], o[t][5]); w.w = pk2(o[t][6], o[t][7]);
            *(LAS v4u*)(lb + GD_KN + (t0 + t) * GD_S + cg * 16) = w; }
#pragma unroll
        for (int c = 0; c < 8; ++c) { v4u w;
            w.x = pk2(o[0][c] * fk[0], o[1][c] * fk[1]); w.y = pk2(o[2][c] * fk[2], o[3][c] * fk[3]); w.z = pk2(o[4][c] * fk[4], o[5][c] * fk[5]); w.w = pk2(o[6][c] * fk[6], o[7][c] * fk[7]);
            *(LAS v4u*)(lb + GD_KDT + (cg * 8 + c) * GD_S + t0 * 2) = w;
            w.x = pk2(o[0][c] * fw[0], o[1][c] * fw[1]); w.y = pk2(o[2][c] * fw[2], o[3][c] * fw[3]); w.z = pk2(o[4][c] * fw[4], o[5][c] * fw[5]); w.w = pk2(o[6][c] * fw[6], o[7][c] * fw[7]);
            *(LAS v4u*)(lb + GD_RK + (cg * 8 + c) * GD_S + t0 * 2) = w; }
    } else if (uw == 2) {
        float fb[8];
#pragma unroll
        for (int t = 0; t < 8; ++t) fb[t] = fg[64 + t0 + t];
#pragma unroll
        for (int c = 0; c < 8; ++c) { v4u w;
            w.x = pk2(o[0][c] * fb[0], o[1][c] * fb[1]); w.y = pk2(o[2][c] * fb[2], o[3][c] * fb[3]); w.z = pk2(o[4][c] * fb[4], o[5][c] * fb[5]); w.w = pk2(o[6][c] * fb[6], o[7][c] * fb[7]);
            *(LAS v4u*)(lb + GD_RV + (cg * 8 + c) * GD_S + t0 * 2) = w; }
    }
    __syncthreads();
    F.lane = fresh_lane(); LN = F.lane; fr = F.lane & 15; fq = F.lane >> 4;
    for (int ti = uw; ti < 20; ti += 4) {
        const int kind = ti >= 10; int lt, mt; decode_lower(ti - 10 * kind, lt, mt);
        pg8::f32x4 acc = zero4();
#pragma unroll
        for (int ks = 0; ks < 2; ++ks) acc = MFMA16(ldsfrag(lb + GD_KN, 16 * mt + fr, GD_S, 64 * ks + 16 * fq), ldsfrag(lb + (kind ? GD_QN : GD_KN), 16 * lt + fr, GD_S, 64 * ks + 16 * fq), acc);
        const int col = 16 * lt + fr, r0 = 16 * mt + 4 * fq; const float gcc = fg[col];
        if (kind == 0) { const float bc = fg[64 + col]; v4f w;
            w.x = (r0 + 0 < col) ? bc * acc[0] * __expf(gcc - fg[r0 + 0]) : 0.f; w.y = (r0 + 1 < col) ? bc * acc[1] * __expf(gcc - fg[r0 + 1]) : 0.f;
            w.z = (r0 + 2 < col) ? bc * acc[2] * __expf(gcc - fg[r0 + 2]) : 0.f; w.w = (r0 + 3 < col) ? bc * acc[3] * __expf(gcc - fg[r0 + 3]) : 0.f;
            *(LAS v4f*)(lb + GD_L + col * GD_LS + r0 * 4) = w; }
        else { float a0 = (r0 + 0 <= col) ? acc[0] * __expf(gcc - fg[r0 + 0]) : 0.f, a1 = (r0 + 1 <= col) ? acc[1] * __expf(gcc - fg[r0 + 1]) : 0.f,
                     a2 = (r0 + 2 <= col) ? acc[2] * __expf(gcc - fg[r0 + 2]) : 0.f, a3 = (r0 + 3 <= col) ? acc[3] * __expf(gcc - fg[r0 + 3]) : 0.f;
            v2u w; w.x = pk2(a0, a1); w.y = pk2(a2, a3);
            *(LAS v2u*)(lb + GD_AT + col * GD_S + r0 * 2) = w;
            if (lt == mt && (lt & 1) == 0) *(LAS v2u*)(lb + GD_AT + col * GD_S + (r0 + 16) * 2) = zero2u(); }
    }
    __syncthreads();
    F.lane = fresh_lane(); LN = F.lane; fr = F.lane & 15; fq = F.lane >> 4;
    if (uw < 2) {
        LAS unsigned char* rb = lb + (uw == 0 ? GD_RV : GD_RK) + F.lane * GD_S; float x[64];
        unsigned lpv = (unsigned)(unsigned long long)(lb + GD_L); asm volatile("" : "+v"(lpv));
        LAS unsigned char* Lp = (LAS unsigned char*)(unsigned long long)lpv;
#pragma unroll
        for (int j = 0; j < 8; ++j) { const v4u v = *(const LAS v4u*)(rb + j * 16);
            x[8 * j] = bf2f(v.x & 0xffffu); x[8 * j + 1] = bf2f(v.x >> 16); x[8 * j + 2] = bf2f(v.y & 0xffffu); x[8 * j + 3] = bf2f(v.y >> 16);
            x[8 * j + 4] = bf2f(v.z & 0xffffu); x[8 * j + 5] = bf2f(v.z >> 16); x[8 * j + 6] = bf2f(v.w & 0xffffu); x[8 * j + 7] = bf2f(v.w >> 16); }
        v4f cur[16], nxt[8];
        cur[0] = *(const LAS v4f*)(Lp + 1 * GD_LS);
#pragma unroll
        for (int c = 1; c < 64; ++c) {
            constexpr int dummy = 0; (void)dummy;
#pragma unroll
            for (int mc = 8; mc <= (c - 1) / 4; ++mc) cur[mc] = *(const LAS v4f*)(Lp + c * GD_LS + mc * 16);
            if (c < 63) {
#pragma unroll
                for (int mc = 0; mc <= c / 4 && mc < 8; ++mc) nxt[mc] = *(const LAS v4f*)(Lp + (c + 1) * GD_LS + mc * 16); }
            float s = 0.f;
#pragma unroll
            for (int mc = 0; mc <= (c - 1) / 4; ++mc) s += cur[mc].x * x[4 * mc] + cur[mc].y * x[4 * mc + 1] + cur[mc].z * x[4 * mc + 2] + cur[mc].w * x[4 * mc + 3];
            x[c] -= s;
            asm volatile("" : "+v"(x[c]) :: "memory");
#pragma unroll
            for (int mc = 0; mc <= c / 4 && mc < 8; ++mc) cur[mc] = nxt[mc];
        }
        const float sg = uw == 0 ? 1.f : -1.f;
#pragma unroll
        for (int j = 0; j < 8; ++j) { v4u w; w.x = pk2(sg * x[8 * j], sg * x[8 * j + 1]); w.y = pk2(sg * x[8 * j + 2], sg * x[8 * j + 3]); w.z = pk2(sg * x[8 * j + 4], sg * x[8 * j + 5]); w.w = pk2(sg * x[8 * j + 6], sg * x[8 * j + 7]);
            *(LAS v4u*)(rb + j * 16) = w; }
    }
    __syncthreads();
    {
        F.lane = fresh_lane(); LN = F.lane; fr = F.lane & 15; fq = F.lane >> 4;
        const int aoff = (uw == 0 || uw == 2) ? GD_RK : (uw == 1 ? GD_KDT : GD_RV), boff = uw == 0 ? GD_KDT : (uw == 1 ? GD_RV : GD_AT);
        bf16* dst = (bf16*)(F.ws + (uw == 0 ? WS_GAN : uw == 1 ? WS_GBN : uw == 2 ? WS_GQE : WS_GO1)) + (size_t)unit * 4096;
        const float gtot = __expf(fg[63]);
        for (int ct = 0; ct < 4; ++ct) { const int col = 16 * ct + fr; const float eg = __expf(fg[col]);
#pragma unroll
            for (int rt = 0; rt < 4; ++rt) { const int r0 = 16 * rt + 4 * fq;
                pg8::f32x4 acc = zero4();
                if (uw == 0) { acc[0] = (r0 + 0 == col) ? gtot : 0.f; acc[1] = (r0 + 1 == col) ? gtot : 0.f; acc[2] = (r0 + 2 == col) ? gtot : 0.f; acc[3] = (r0 + 3 == col) ? gtot : 0.f; }
                if (uw == 2) { const v2u q = *(const LAS v2u*)(lb + GD_QN + col * GD_S + r0 * 2);
                    acc[0] = bf2f(q.x & 0xffffu) * eg; acc[1] = bf2f(q.x >> 16) * eg; acc[2] = bf2f(q.y & 0xffffu) * eg; acc[3] = bf2f(q.y >> 16) * eg; }
#pragma unroll
                for (int ks = 0; ks < 2; ++ks) if (uw < 2 || 2 * ks <= ct) acc = MFMA16(ldsfrag(lb + aoff, 16 * rt + fr, GD_S, 64 * ks + 16 * fq), ldsfrag(lb + boff, col, GD_S, 64 * ks + 16 * fq), acc);
                v2u w; w.x = pk2(acc[0], acc[1]); w.y = pk2(acc[2], acc[3]);
                *(v2u*)(dst + col * 64 + r0) = w; }
        }
    }
    __syncthreads();
}
__device__ __forceinline__ void ph_g1(const Ctx& F0, int l) { Ctx F = launder(F0); for (int p = F.bid; p < 1536; p += F.G) gdn_g1_pair(F, l, p); }

__device__ __forceinline__ void gdn_g2_task(Ctx& F, int task) {
    const int cq = task & 3, bh = task >> 2, b = bh / 6, hh = bh % 6; const int fr = F.lane & 15, fq = F.lane >> 4;
    const bf16* AN = (const bf16*)(F.ws + WS_GAN); const bf16* BN = (const bf16*)(F.ws + WS_GBN); bf16* SP = (bf16*)(F.ws + WS_GSP);
    pg8::f32x4 acc[4];
#pragma unroll
    for (int i = 0; i < 4; ++i) acc[i] = zero4();
    v2u af[4][2][2], bi[4];
    { const size_t u0 = (size_t)(b * 64) * 6 + hh;
#pragma unroll
      for (int it = 0; it < 4; ++it) { bi[it] = *(const v2u*)(BN + u0 * 4096 + (16 * cq + fr) * 64 + 16 * it + 4 * fq);
#pragma unroll
          for (int s = 0; s < 2; ++s) { const bf16* ap = AN + u0 * 4096 + (16 * it + fr) * 64 + 32 * s + 4 * fq; af[it][s][0] = *(const v2u*)ap; af[it][s][1] = *(const v2u*)(ap + 16); } } }
    for (int n = 0; n < 64; ++n) {
        const size_t unit = (size_t)(b * 64 + n) * 6 + hh;
        v2u afn[4][2][2], bin[4];
        if (n < 63) { const size_t u1 = unit + 6;
#pragma unroll
            for (int it = 0; it < 4; ++it) { bin[it] = *(const v2u*)(BN + u1 * 4096 + (16 * cq + fr) * 64 + 16 * it + 4 * fq);
#pragma unroll
                for (int s = 0; s < 2; ++s) { const bf16* ap = AN + u1 * 4096 + (16 * it + fr) * 64 + 32 * s + 4 * fq; afn[it][s][0] = *(const v2u*)ap; afn[it][s][1] = *(const v2u*)(ap + 16); } } }
        else {
#pragma unroll
            for (int it = 0; it < 4; ++it) { bin[it] = bi[it];
#pragma unroll
                for (int s = 0; s < 2; ++s) { afn[it][s][0] = af[it][s][0]; afn[it][s][1] = af[it][s][1]; } } }
        unsigned pk[4][2];
#pragma unroll
        for (int it = 0; it < 4; ++it) { pk[it][0] = pg8::cvt_pk_bf16(acc[it][0], acc[it][1]); pk[it][1] = pg8::cvt_pk_bf16(acc[it][2], acc[it][3]);
            *(v2u*)(SP + unit * 4096 + (16 * cq + fr) * 64 + 16 * it + 4 * fq) = (v2u){pk[it][0], pk[it][1]}; }
        bf16x8 bfr[2];
#pragma unroll
        for (int s = 0; s < 2; ++s) { const v4u t = (v4u){pk[2 * s][0], pk[2 * s][1], pk[2 * s + 1][0], pk[2 * s + 1][1]}; bfr[s] = __builtin_bit_cast(bf16x8, t); }
#pragma unroll
        for (int it = 0; it < 4; ++it) {
            pg8::f32x4 a = (pg8::f32x4){bf2f(bi[it].x & 0xffffu), bf2f(bi[it].x >> 16), bf2f(bi[it].y & 0xffffu), bf2f(bi[it].y >> 16)};
#pragma unroll
            for (int s = 0; s < 2; ++s) { const v4u t = (v4u){af[it][s][0].x, af[it][s][0].y, af[it][s][1].x, af[it][s][1].y}; a = MFMA16(__builtin_bit_cast(bf16x8, t), bfr[s], a); }
            acc[it] = a; }
#pragma unroll
        for (int it = 0; it < 4; ++it) { bi[it] = bin[it];
#pragma unroll
            for (int s = 0; s < 2; ++s) { af[it][s][0] = afn[it][s][0]; af[it][s][1] = afn[it][s][1]; } }
    }
}
__device__ __forceinline__ void ph_g2(const Ctx& F0) { Ctx F = launder(F0); const int t = F.wave * F.G + F.bid; if (t < 192) gdn_g2_task(F, t); }

__device__ __forceinline__ void ph_g3(const Ctx& F0, int l) {
    Ctx F = launder(F0); const int LN = F.lane;
    const bf16* P = (const bf16*)(F.ws + WS_P); bf16* Y = (bf16*)(F.ws + WS_Y);
    const bf16* QE = (const bf16*)(F.ws + WS_GQE); const bf16* O1 = (const bf16*)(F.ws + WS_GO1); const bf16* SP = (const bf16*)(F.ws + WS_GSP);
    const int fr = F.lane & 15, fq = F.lane >> 4; const float* gnp = inptr(F, I_GNORM) + l * 64;
    for (int task = F.bid * 8 + F.wave; task < 3072 * 4; task += F.G * 8) {
        const int unit = task >> 2, tt = task & 3, hh = unit % 6, bn = unit / 6; const size_t row = (size_t)bn * 64 + 16 * tt + fr;
        bf16x8 bq[2];
#pragma unroll
        for (int ks = 0; ks < 2; ++ks) bq[ks] = *(const bf16x8*)(QE + (size_t)unit * 4096 + (16 * tt + fr) * 64 + 32 * ks + 8 * fq);
        float ov[4][4]; float ss = 0.f;
#pragma unroll
        for (int et = 0; et < 4; ++et) { const v2u oi = *(const v2u*)(O1 + (size_t)unit * 4096 + (16 * tt + fr) * 64 + 16 * et + 4 * fq);
            pg8::f32x4 a = (pg8::f32x4){bf2f(oi.x & 0xffffu), bf2f(oi.x >> 16), bf2f(oi.y & 0xffffu), bf2f(oi.y >> 16)};
#pragma unroll
            for (int ks = 0; ks < 2; ++ks) a = MFMA16(*(const bf16x8*)(SP + (size_t)unit * 4096 + (16 * et + fr) * 64 + 32 * ks + 8 * fq), bq[ks], a);
            ov[et][0] = a[0]; ov[et][1] = a[1]; ov[et][2] = a[2]; ov[et][3] = a[3]; ss += (a[0] * a[0] + a[1] * a[1]) + (a[2] * a[2] + a[3] * a[3]); }
        ss += SHX(ss, 16); ss += SHX(ss, 32);
        const float rs = rsqrtf(ss * (1.f / 64.f) + EPS);
#pragma unroll
        for (int et = 0; et < 4; ++et) { const int e0 = 16 * et + 4 * fq; const v4f gw = *(const v4f*)(gnp + e0);
            const v2u zz = *(const v2u*)(P + row * NP + PC_GZ + hh * 64 + e0);
            v2u w; w.x = pk2(ov[et][0] * rs * gw.x * silu_f(bf2f(zz.x & 0xffffu)), ov[et][1] * rs * gw.y * silu_f(bf2f(zz.x >> 16)));
            w.y = pk2(ov[et][2] * rs * gw.z * silu_f(bf2f(zz.y & 0xffffu)), ov[et][3] * rs * gw.w * silu_f(bf2f(zz.y >> 16)));
            *(v2u*)(Y + row * DM + 256 + hh * 64 + e0) = w; }
    }
}


constexpr size_t WS_S5KT = 592 * MiB;
constexpr size_t WS_S5LP = 594 * MiB;
constexpr size_t WS_S5CM = 597 * MiB;
constexpr size_t WS_S5BB = 598 * MiB;
constexpr size_t WS_YS5 = 392 * MiB;
typedef float v2f __attribute__((ext_vector_type(2)));
__device__ __forceinline__ void s5_tables(const Ctx& F0) {
    Ctx F = launder(F0);
    LAS v2f* lp = (LAS v2f*)F.lds; LAS v2f* bb = (LAS v2f*)(F.lds + 33280); LAS v2f* cc = (LAS v2f*)(F.lds + 33280 + 8192);
    for (int task = F.bid; task < NL * 16 * 16; task += F.G) {
        const int lg = task >> 4, c = task & 15, l = lg >> 4, g = lg & 15;
        const float step = expf(inptr(F, I_S5LDT)[lg]);
        for (int i = F.tid; i < 65 * 64; i += 512) { const int k = i >> 6, p = i & 63; const float are = inptr(F, I_S5ARE)[lg * 64 + p], aim = inptr(F, I_S5AIM)[lg * 64 + p];
            const float mag = expf((float)k * are * step); float sn, cs; sincosf((float)k * aim * step, &sn, &cs); lp[i] = (v2f){mag * cs, mag * sn}; }
        __syncthreads();
        for (int i = F.tid; i < 64 * 16; i += 512) { const int p = i >> 4; const float are = inptr(F, I_S5ARE)[lg * 64 + p], aim = inptr(F, I_S5AIM)[lg * 64 + p];
            const v2f lb = lp[64 + p]; const float nr = lb.x - 1.f, ni = lb.y, den = are * are + aim * aim, fr_ = (nr * are + ni * aim) / den, fi_ = (ni * are - nr * aim) / den;
            const float br = inptr(F, I_S5BRE)[(size_t)lg * 1024 + i], bi = inptr(F, I_S5BIM)[(size_t)lg * 1024 + i];
            bb[i] = (v2f){fr_ * br - fi_ * bi, fr_ * bi + fi_ * br}; }
        if (F.tid < 64) cc[F.tid] = (v2f){inptr(F, I_S5CRE)[((size_t)lg * 16 + c) * 64 + F.tid], inptr(F, I_S5CIM)[((size_t)lg * 16 + c) * 64 + F.tid]};
        __syncthreads();
        bf16* KT = (bf16*)(F.ws + WS_S5KT) + (size_t)lg * 16384 + c * 1024;
        for (int o = F.tid; o < 1024; o += 512) { const int d = o >> 4, c2 = o & 15; float acc = 0.f;
            for (int p = 0; p < 64; ++p) { const v2f C = cc[p], L = lp[d * 64 + p], B = bb[p * 16 + c2]; const float mr = C.x * L.x - C.y * L.y, mi = C.x * L.y + C.y * L.x; acc += mr * B.x - mi * B.y; }
            KT[o] = (bf16)f2bf(acc); }
        if (c == 0) {
            float* LPg = (float*)(F.ws + WS_S5LP) + (size_t)lg * 65 * 128; bf16* CMg = (bf16*)(F.ws + WS_S5CM) + (size_t)lg * 2048; bf16* BBg = (bf16*)(F.ws + WS_S5BB) + (size_t)lg * 2048;
            for (int i = F.tid; i < 65 * 64; i += 512) { LPg[2 * i] = lp[i].x; LPg[2 * i + 1] = lp[i].y; }
            for (int i = F.tid; i < 64 * 16; i += 512) { const int p = i >> 4, c2 = i & 15; BBg[p * 16 + c2] = (bf16)f2bf(bb[i].x); BBg[(64 + p) * 16 + c2] = (bf16)f2bf(bb[i].y); }
            for (int i = F.tid; i < 16 * 64; i += 512) { const int c2 = i >> 6, p = i & 63; CMg[c2 * 128 + p] = (bf16)f2bf(inptr(F, I_S5CRE)[((size_t)lg * 16 + c2) * 64 + p]); CMg[c2 * 128 + 64 + p] = (bf16)f2bf(-inptr(F, I_S5CIM)[((size_t)lg * 16 + c2) * 64 + p]); }
        }
        __syncthreads();
    }
}
constexpr int S5_KT = 0, S5_KT_S = 2064, S5_LP = 33024, S5_CM = 66304, S5_CM_S = 272, S5_BB = 70656, S5_SL = 74752, S5_U = 107520;
__device__ __forceinline__ void s5_unit(const Ctx& F0, int l, int unit) {
    Ctx F = F0; F.lane = fresh_lane(); F.tid = F.wave * 64 + F.lane; int LN = F.lane;
    const int b = unit >> 4, g = unit & 15, lg = l * 16 + g; int fr = F.lane & 15, fq = F.lane >> 4;
    const bf16* P = (const bf16*)(F.ws + WS_P); bf16* YS = (bf16*)(F.ws + WS_YS5);
    { const bf16* KTg = (const bf16*)(F.ws + WS_S5KT) + (size_t)lg * 16384;
      for (int i = F.tid; i < 16 * 128; i += 512) { const int c = i >> 7, k8 = i & 127; *(LAS v4u*)(F.lds + S5_KT + c * S5_KT_S + k8 * 16) = *(const v4u*)(KTg + c * 1024 + k8 * 8); }
      const v4f* LPg = (const v4f*)((const float*)(F.ws + WS_S5LP) + (size_t)lg * 65 * 128);
      for (int i = F.tid; i < 65 * 32; i += 512) ((LAS v4f*)(F.lds + S5_LP))[i] = LPg[i];
      const bf16* CMg = (const bf16*)(F.ws + WS_S5CM) + (size_t)lg * 2048;
      for (int i = F.tid; i < 16 * 16; i += 512) { const int c = i >> 4, k8 = i & 15; *(LAS v4u*)(F.lds + S5_CM + c * S5_CM_S + k8 * 16) = *(const v4u*)(CMg + c * 128 + k8 * 8); }
      const v4u* BBg = (const v4u*)((const bf16*)(F.ws + WS_S5BB) + (size_t)lg * 2048);
      for (int i = F.tid; i < 256; i += 512) ((LAS v4u*)(F.lds + S5_BB))[i] = BBg[i];
      LAS v4u* uz = (LAS v4u*)(F.lds + S5_U + F.wave * 4096);
      for (int i = F.lane; i < 128; i += 64) uz[i] = zero4u(); }
    __syncthreads();
    LAS v2f* lp = (LAS v2f*)(F.lds + S5_LP); LAS v2f* sl = (LAS v2f*)(F.lds + S5_SL);
    const bf16x8 zf = __builtin_bit_cast(bf16x8, zero4u());
    for (int n = F.wave; n < 64; n += 8) {
        unsigned l0v = (unsigned)(unsigned long long)F.lds; asm volatile("" : "+v"(l0v)); LAS unsigned char* L0 = (LAS unsigned char*)(unsigned long long)l0v;
        LAS v2f* lp = (LAS v2f*)(L0 + S5_LP); LAS v2f* sl = (LAS v2f*)(L0 + S5_SL);
        const size_t rowbase = (size_t)b * SEQ + n * 64;
        bf16x8 ua[4];
#pragma unroll
        for (int st = 0; st < 4; ++st) ua[st] = fq < 2 ? *(const bf16x8*)(P + (rowbase + 16 * st + fr) * NP + PC_S5 + g * 16 + 8 * fq) : zf;
#pragma unroll 1
        for (int j = 0; j < 4; ++j) {
            const bf16* BBq = (const bf16*)(F.ws + WS_S5BB) + (size_t)lg * 2048; const bf16x8 bre = fq < 2 ? *(const bf16x8*)(BBq + (16 * j + fr) * 16 + 8 * fq) : zf, bim = fq < 2 ? *(const bf16x8*)(BBq + (64 + 16 * j + fr) * 16 + 8 * fq) : zf;
            float sr = 0.f, si = 0.f;
#pragma unroll
            for (int st = 0; st < 4; ++st) { const pg8::f32x4 z4 = zero4();
                const pg8::f32x4 ar = MFMA16(ua[st], bre, z4), ai = MFMA16(ua[st], bim, z4);
#pragma unroll
                for (int r = 0; r < 4; ++r) { const v2f w = lp[(63 - (16 * st + 4 * fq + r)) * 64 + 16 * j + fr]; sr += w.x * ar[r] - w.y * ai[r]; si += w.x * ai[r] + w.y * ar[r]; } }
            sr += SHX(sr, 16); sr += SHX(sr, 32); si += SHX(si, 16); si += SHX(si, 32);
            if (fq == 0) sl[n * 64 + 16 * j + fr] = (v2f){sr, si};
        }
    }
    __syncthreads();
    if (F.wave == 0) { const v2f l64 = lp[64 * 64 + F.lane]; float sr = 0.f, si = 0.f;
        for (int n = 0; n < 64; ++n) { const v2f loc = sl[n * 64 + F.lane]; sl[n * 64 + F.lane] = (v2f){sr, si};
            const float nr = l64.x * sr - l64.y * si + loc.x, ni = l64.x * si + l64.y * sr + loc.y; sr = nr; si = ni; } }
    __syncthreads();
    F.lane = fresh_lane(); LN = F.lane; fr = F.lane & 15; fq = F.lane >> 4;
    const float Dc = inptr(F, I_S5D)[l * 256 + g * 16 + fr];
    for (int n = F.wave; n < 64; n += 8) {
        unsigned l0v = (unsigned)(unsigned long long)F.lds; asm volatile("" : "+v"(l0v)); LAS unsigned char* L0 = (LAS unsigned char*)(unsigned long long)l0v;
        LAS unsigned char* ub = L0 + S5_U + F.wave * 4096;
        const size_t rowbase = (size_t)b * SEQ + n * 64;
#pragma unroll
        for (int i = 0; i < 2; ++i) { const int piece = F.lane + 64 * i, row = piece >> 1, hf = piece & 1; *(LAS v4u*)(ub + (64 + row) * 32 + hf * 16) = *(const v4u*)(P + (rowbase + row) * NP + PC_S5 + g * 16 + 8 * hf); }
        LDS_WAIT();
#pragma unroll 1
        for (int tt = 0; tt < 4; ++tt) {
            pg8::f32x4 a = zero4();
            const int t = 16 * tt + fr;
#pragma unroll
            for (int hp = 0; hp < 2; ++hp) { float zr[8], zi[8];
#pragma unroll
                for (int q4 = 0; q4 < 4; ++q4) { const v4f lw = *(const LAS v4f*)(L0 + S5_LP + ((t + 1) * 64 + 32 * hp + 8 * fq + 2 * q4) * 8), sv = *(const LAS v4f*)(L0 + S5_SL + (n * 64 + 32 * hp + 8 * fq + 2 * q4) * 8);
                    zr[2 * q4] = lw.x * sv.x - lw.y * sv.y; zi[2 * q4] = lw.x * sv.y + lw.y * sv.x; zr[2 * q4 + 1] = lw.z * sv.z - lw.w * sv.w; zi[2 * q4 + 1] = lw.z * sv.w + lw.w * sv.z; }
                const v4u fre = (v4u){pk2(zr[0], zr[1]), pk2(zr[2], zr[3]), pk2(zr[4], zr[5]), pk2(zr[6], zr[7])}, fim = (v4u){pk2(zi[0], zi[1]), pk2(zi[2], zi[3]), pk2(zi[4], zi[5]), pk2(zi[6], zi[7])};
                a = MFMA16(__builtin_bit_cast(bf16x8, fre), *(const LAS bf16x8*)(L0 + S5_CM + fr * S5_CM_S + (32 * hp + 8 * fq) * 2), a);
                a = MFMA16(__builtin_bit_cast(bf16x8, fim), *(const LAS bf16x8*)(L0 + S5_CM + fr * S5_CM_S + (64 + 32 * hp + 8 * fq) * 2), a); }
            for (int ks = 0; ks < 8 * (tt + 1); ++ks)
                a = MFMA16(*(const LAS bf16x8*)(ub + (64 + t - 2 * ks - (fq >> 1)) * 32 + (fq & 1) * 16), *(const LAS bf16x8*)(L0 + S5_KT + fr * S5_KT_S + (32 * ks + 8 * fq) * 2), a);
#pragma unroll
            for (int r = 0; r < 4; ++r) { const int t2 = 16 * tt + 4 * fq + r; const float u = bf2f(*(const LAS unsigned short*)(ub + (64 + t2) * 32 + fr * 2));
                YS[(rowbase + t2) * 256 + g * 16 + fr] = (bf16)f2bf(gelu_tanh(a[r] + Dc * u)); }
        }
        LDS_WAIT();
    }
    __syncthreads();
}
__device__ __forceinline__ void ph_s5(const Ctx& F0, int l) { Ctx F = launder(F0); for (int u = F.bid; u < 128; u += F.G) s5_unit(F, l, u); }

__device__ __forceinline__ void ph_m3(const Ctx& F0, int l) {
    Ctx F = launder(F0);
    const int LN = F.lane;
    const bf16* P = (const bf16*)(F.ws + WS_P); const float* YR = (const float*)(F.ws + WS_YRAW); bf16* Y = (bf16*)(F.ws + WS_Y);
    const int NGW = F.G * 8, gw = F.bid * 8 + F.wave;
    LAS float* ys = (LAS float*)(F.lds + F.wave * 8192);
    const float* wg = inptr(F, I_S5GLU) + (size_t)l * 65536;
    const v4f s5n = *(const v4f*)(inptr(F, I_S5NORM) + l * 256 + 4 * F.lane);
    for (int tg = gw; tg < NTOK / 8; tg += NGW) {
        const int tok0 = tg * 8; v4f yv[8];
#pragma unroll
        for (int t = 0; t < 8; ++t) { const v2u q = *(const v2u*)((const bf16*)(F.ws + WS_YS5) + (size_t)(tok0 + t) * 256 + 4 * F.lane); yv[t] = (v4f){bf2f(q.x & 0xffffu), bf2f(q.x >> 16), bf2f(q.y & 0xffffu), bf2f(q.y >> 16)}; }
#pragma unroll
        for (int i = 0; i < 4; ++i) { *(LAS v4f*)(ys + (4 * F.lane + i) * 8) = (v4f){yv[0][i], yv[1][i], yv[2][i], yv[3][i]}; *(LAS v4f*)(ys + (4 * F.lane + i) * 8 + 4) = (v4f){yv[4][i], yv[5][i], yv[6][i], yv[7][i]}; }
        LDS_WAIT();
        v4f acc[8];
#pragma unroll
        for (int t = 0; t < 8; ++t) acc[t] = zero4();
#pragma unroll 4
        for (int k = 0; k < 256; ++k) { const v4f w = *(const v4f*)(wg + k * 256 + 4 * F.lane); const v4f a0 = *(const LAS v4f*)(ys + k * 8), a1 = *(const LAS v4f*)(ys + k * 8 + 4);
            acc[0] += a0.x * w; acc[1] += a0.y * w; acc[2] += a0.z * w; acc[3] += a0.w * w; acc[4] += a1.x * w; acc[5] += a1.y * w; acc[6] += a1.z * w; acc[7] += a1.w * w; }
        LDS_WAIT();
#pragma unroll
        for (int t = 0; t < 8; ++t) { v4f v = yv[t]; v.x *= sigm(acc[t].x); v.y *= sigm(acc[t].y); v.z *= sigm(acc[t].z); v.w *= sigm(acc[t].w);
            const float rs = rsqrtf(wave_sum(dot4(v, v)) * (1.f / 256.f) + EPS); v = v * rs * s5n;
            v2u o; o.x = pk2(v.x, v.y); o.y = pk2(v.z, v.w); *(v2u*)(Y + (size_t)(tok0 + t) * DM + 4 * F.lane) = o; }
    }
}

__device__ __forceinline__ void ph_n2(const Ctx& F0, int l) {
    Ctx F = launder(F0);
    const int LN = F.lane;
    const float* MOD = (const float*)(F.ws + WS_MOD);
    LAS float* rw = (LAS float*)F.lds;
    { const float* RW = (const float*)(F.ws + WS_RW) + (size_t)l * 36 * DM;
      for (int i = F.tid; i < 36 * DM / 4; i += 512) ((LAS v4f*)rw)[i] = ((const v4f*)RW)[i]; }
    __syncthreads();
    const int NGW = F.G * 8, gw = F.bid * 8 + F.wave, rows_per = (NTOK + NGW - 1) / NGW;
    const int r0 = gw * rows_per, r1 = (r0 + rows_per) < NTOK ? (r0 + rows_per) : NTOK;
    bf16* H = (bf16*)(F.ws + WS_H); int* TI = (int*)(F.ws + WS_TI); int* LIST = (int*)(F.ws + WS_LIST);
    unsigned* cnt = (unsigned*)(F.ws + WS_CTL) + CW_CNT + l * NE;
    int curb = -1; v4f An[4], Bn[4];
    const float* p_nffn = inptr(F, I_NFFN); const float* p_mbg = inptr(F, I_MBG) + l * 4; const float* p_mbr = inptr(F, I_MBR) + l * 32;
#pragma unroll
    for (int j = 0; j < 4; ++j) { An[j] = zero4(); Bn[j] = An[j]; }
    for (int c0 = r0; c0 < r1; c0 += 64) {
        const int c1 = (c0 + 64) < r1 ? (c0 + 64) : r1;
        int me0 = 0, me1 = 0; float mw0 = 0.f, mw1 = 0.f;
        for (int row = c0; row < c1; ++row) {
            const int b = row >> 12;
            if (b != curb) { curb = b;
#pragma unroll
                for (int j = 0; j < 4; ++j) { const int c = 4 * F.lane + 256 * j;
                    const v4f nm = *(const v4f*)(p_nffn + l * DM + c), sc = *(const v4f*)(MOD + ((size_t)l * NB + b) * 6 * DM + 4 * DM + c), sh = *(const v4f*)(MOD + ((size_t)l * NB + b) * 6 * DM + 3 * DM + c);
                    An[j] = nm * (1.f + sc); Bn[j] = sh; }
            }
            v4f v[4]; float ss = 0.f;
#pragma unroll
            for (int j = 0; j < 4; ++j) { v[j] = *(const v4f*)(F.out + (size_t)row * DM + 4 * F.lane + 256 * j); ss += dot4(v[j], v[j]); }
            const float rs = rsqrtf(wave_sum(ss) * (1.f / DM) + EPS);
            v4f h[4];
#pragma unroll
            for (int j = 0; j < 4; ++j) { h[j] = v[j] * rs * An[j] + Bn[j]; v2u o; o.x = pk2(h[j].x, h[j].y); o.y = pk2(h[j].z, h[j].w); *(v2u*)(H + (size_t)row * DM + 4 * F.lane + 256 * j) = o; }
            float lg[4];
#pragma unroll
            for (int c = 0; c < 4; ++c) { float s = 0.f;
#pragma unroll
                for (int j = 0; j < 4; ++j) s += dot4(h[j], ((const LAS v4f*)rw)[c * 256 + 64 * j + F.lane]);
                lg[c] = wave_sum(s) + p_mbg[c]; }
            int gi = 0; float gm = lg[0];
#pragma unroll
            for (int c = 1; c < 4; ++c) if (lg[c] > gm) { gm = lg[c]; gi = c; }
            float den = 0.f;
#pragma unroll
            for (int c = 0; c < 4; ++c) den += __expf(lg[c] - gm);
            const float gwt = 1.f / den;
            float le[8];
#pragma unroll
            for (int c = 0; c < 8; ++c) { float s = 0.f; const LAS v4f* wr_ = (const LAS v4f*)rw + (4 + gi * 8 + c) * 256;
#pragma unroll
                for (int j = 0; j < 4; ++j) s += dot4(h[j], wr_[64 * j + F.lane]);
                le[c] = wave_sum(s) + p_mbr[gi * 8 + c]; }
            int i1 = 0; float v1 = le[0];
#pragma unroll
            for (int c = 1; c < 8; ++c) if (le[c] > v1) { v1 = le[c]; i1 = c; }
            int i2 = -1; float v2 = -3.0e38f;
#pragma unroll
            for (int c = 0; c < 8; ++c) if (c != i1 && le[c] > v2) { v2 = le[c]; i2 = c; }
            const float ex = __expf(v2 - v1), we1 = 1.f / (1.f + ex), we2 = ex / (1.f + ex);
            if (F.lane == row - c0) { me0 = gi * 8 + i1; me1 = gi * 8 + i2; mw0 = gwt * we1; mw1 = gwt * we2; }
        }
        if (c0 + F.lane < c1) {
            const int row = c0 + F.lane;
            const int s0 = (int)__hip_atomic_fetch_add(cnt + me0, 1u, __ATOMIC_RELAXED, __HIP_MEMORY_SCOPE_AGENT);
            const int s1 = (int)__hip_atomic_fetch_add(cnt + me1, 1u, __ATOMIC_RELAXED, __HIP_MEMORY_SCOPE_AGENT);
            int* ti = TI + (size_t)row * 8; ti[0] = me0; ti[1] = s0; ti[2] = __float_as_int(mw0); ti[3] = me1; ti[4] = s1; ti[5] = __float_as_int(mw1);
            LIST[(size_t)me0 * NTOK + s0] = row; LIST[(size_t)me1 * NTOK + s1] = row;
        }
    }
}

__device__ __forceinline__ void ph_e0(const Ctx& F0, int l) {
    Ctx F = launder(F0);
    build_tiles(F, l); __syncthreads();
    const int ntiles = F.misc[16 + NE];
    const bf16* H = (const bf16*)(F.ws + WS_H); bf16* XG = (bf16*)(F.ws + WS_P); const int* LIST = (const int*)(F.ws + WS_LIST);
    for (int tile = F.bid; tile < ntiles; tile += F.G) {
        const int e = F.misc[128 + tile], ts = F.misc[16 + e], ce = F.misc[64 + e];
        for (int r = F.wave; r < 256; r += 8) { const int slot = (tile - ts) * 256 + r;
            if (slot < ce) { const int tok = LIST[(size_t)e * NTOK + slot]; const v4u* s = (const v4u*)(H + (size_t)tok * DM); v4u* d = (v4u*)(XG + ((size_t)tile * 256 + r) * DM);
                d[F.lane] = s[F.lane]; d[64 + F.lane] = s[64 + F.lane]; } }
    }
}

struct EpiResid {
    static constexpr bool PERM = false, AFTER_DRAIN = false;
    const float* xin; float* xout; const float* gate;
    __device__ __forceinline__ void operator()(const pg8::f32x4 (&acc)[2][2][4][2], const pg8::Unit& u, int wr, int wc, int fr, int fq) const {
        const int row0 = u.pm * 256 + wr * 64 + fr, col0 = u.pn * 256 + wc * 32 + 4 * fq, b = u.pm >> 4;
        pg8::f32x4 gv[2][2];
#pragma unroll
        for (int bj = 0; bj < 2; ++bj)
#pragma unroll
            for (int n = 0; n < 2; ++n) gv[bj][n] = *(const pg8::f32x4*)(gate + (size_t)b * 6 * DM + col0 + bj * 128 + n * 16);
#pragma unroll
        for (int ai = 0; ai < 2; ++ai)
#pragma unroll
            for (int m = 0; m < 4; ++m) { const size_t off = (size_t)(row0 + ai * 128 + m * 16) * DM + col0;
#pragma unroll
                for (int bj = 0; bj < 2; ++bj)
#pragma unroll
                    for (int n = 0; n < 2; ++n) { const pg8::f32x4 xv = *(const pg8::f32x4*)(xin + off + bj * 128 + n * 16); *(pg8::f32x4*)(xout + off + bj * 128 + n * 16) = xv + gv[bj][n] * acc[ai][bj][m][n]; }
                if (m & 1) asm volatile("" ::: "memory"); }
    }
};
struct EpiGLU {
    static constexpr bool PERM = true, AFTER_DRAIN = false;
    bf16* O;
    __device__ __forceinline__ void operator()(const pg8::f32x4 (&acc)[2][2][4][2], const pg8::Unit& u, int wr, int wc, int fr, int fq) const {
        const int row0 = u.pm * 256 + wr * 64 + fr, col0 = u.pn * 128 + wc * 32 + 8 * fq;
#pragma unroll
        for (int ai = 0; ai < 2; ++ai)
#pragma unroll
            for (int m = 0; m < 4; ++m) { bf16* rowp = O + (size_t)(row0 + ai * 128 + m * 16) * DE + col0; float hv[8];
#pragma unroll
                for (int n = 0; n < 2; ++n)
#pragma unroll
                    for (int i = 0; i < 4; ++i) { const float g = acc[ai][0][m][n][i], uu = acc[ai][1][m][n][i]; hv[4 * n + i] = g / (1.f + __expf(-g)) * uu; }
                v4u w; w.x = pg8::cvt_pk_bf16(hv[0], hv[1]); w.y = pg8::cvt_pk_bf16(hv[2], hv[3]); w.z = pg8::cvt_pk_bf16(hv[4], hv[5]); w.w = pg8::cvt_pk_bf16(hv[6], hv[7]);
                *(v4u*)rowp = w; }
    }
};
struct MoeOrder {
    int nunits, NT, G, c; volatile LAS int* misc;
    __device__ __forceinline__ bool next(int i, pg8::Unit& u) const { const int L = i * G + c; if (L >= nunits) return false; const int tile = L / NT; u.pm = tile; u.pn = L % NT; u.e = misc[128 + tile]; return true; }
    __device__ __forceinline__ void a_ready(const pg8::Unit&) const {}
    __device__ __forceinline__ void done(const pg8::Unit&) const {}
};

constexpr int PH_PER_LAYER = 15, N_PHASES = 2 + NL * PH_PER_LAYER;

__global__ void __launch_bounds__(512, 2) fwd(Args A) {
    extern __shared__ __attribute__((aligned(16))) unsigned char lds_raw[];
    Ctx F; F.lds = (LAS unsigned char*)lds_raw; F.misc = (volatile LAS int*)(F.lds + LDS_MISC);
    F.tid = threadIdx.x; F.lane = F.tid & 63; F.wave = __builtin_amdgcn_readfirstlane(F.tid >> 6); F.G = gridDim.x; F.bid = blockIdx.x; F.ws = A.ws; F.out = A.out;
    for (int i = F.tid; i < (LDS_BYTES - LDS_MISC) / 4; i += 512) F.misc[i] = 0;
    __syncthreads();
    if (F.tid < 36) { const unsigned long long p = (unsigned long long)A.in[F.tid]; F.misc[MISC_PTR + 2 * F.tid] = (int)(unsigned)p; F.misc[MISC_PTR + 2 * F.tid + 1] = (int)(unsigned)(p >> 32); }
    __syncthreads();
#if ONE_LAUNCH
    (void)xcd_barrier_post((unsigned*)(F.ws + WS_CTL) + CW_BAR, (volatile LAS unsigned*)F.misc);
#define GRID_BAR() do { const Ctx Q_ = launder(F); XcdBarrier b_; b_.bar = (unsigned*)(Q_.ws + WS_CTL) + CW_BAR; b_.x = xb_xcc_id(); b_.st = (volatile LAS unsigned*)Q_.misc; xcd_barrier(b_); } while (0)
#else
#define GRID_BAR() do {} while (0)
#endif
#if ONE_LAUNCH
    constexpr int lo = 0, hi = N_PHASES;
#else
    const int lo = A.ph_lo, hi = A.ph_hi;
#endif
#ifndef DISMASK
#define DISMASK 0
#endif
#define IN(k) (lo <= (k) && (k) < hi)
#define EN(j) (!((DISMASK >> (j)) & 1))
#define SEAM(k) do { if (IN((k) + 1)) GRID_BAR(); } while (0)
    if (EN(15) && IN(0)) { ph_prologue(F); s5_tables(F); SEAM(0); }
    for (int l = 0; l < NL; ++l) {
        const int p0 = 1 + l * PH_PER_LAYER;
        if (EN(0) && IN(p0 + 0)) { ph_n1(F, l, 0); SEAM(p0 + 0); }
        if (EN(1) && IN(p0 + 1)) { const Ctx P = launder(F);
            pg8::Gemm g{(const bf16*)(P.ws + WS_H), (const bf16*)((P.ws + WS_WB) + WB_IN), NTOK, NP, DM, 0}; pg8::StaticOrder S; S.init(NTOK, NP, P.G, P.bid);
            pg8::EpiBf16<0> E{(bf16*)(P.ws + WS_P), NP, nullptr, 0, 0, 1.f};
            pg8::gemm_phase<pg8::EpiBf16<0>, pg8::StaticOrder, true, true>(P.lds, g, S, E, P.wave);
            SEAM(p0 + 1); }
        if (EN(2) && IN(p0 + 2)) { ph_s5(F, l); SEAM(p0 + 2); }
        if (EN(3) && IN(p0 + 3)) { ph_s1(F, l); SEAM(p0 + 3); }
        if (EN(4) && IN(p0 + 4)) { ph_s2(F); SEAM(p0 + 4); }
        if (EN(5) && IN(p0 + 5)) { ph_s3(F, l); SEAM(p0 + 5); }
        if (EN(6) && IN(p0 + 6)) { ph_g1(F, l); SEAM(p0 + 6); }
        if (EN(7) && IN(p0 + 7)) { ph_g2(F); SEAM(p0 + 7); }
        if (EN(8) && IN(p0 + 8)) { ph_g3(F, l); SEAM(p0 + 8); }
        if (EN(9) && IN(p0 + 9)) { ph_m3(F, l); SEAM(p0 + 9); }
        if (EN(10) && IN(p0 + 10)) { const Ctx P = launder(F);
            pg8::Gemm g{(const bf16*)(P.ws + WS_Y), (const bf16*)((P.ws + WS_WB) + WB_OUT), NTOK, DM, DM, 0}; pg8::StaticOrder S; S.init(NTOK, DM, P.G, P.bid);
            EpiResid E{l == 0 ? inptr(F, I_X) : P.out, P.out, (const float*)(P.ws + WS_MOD) + (size_t)l * NB * 6 * DM + 2 * DM};
            pg8::gemm_phase<EpiResid, pg8::StaticOrder, true, true>(P.lds, g, S, E, P.wave);
            SEAM(p0 + 10); }
        if (EN(11) && IN(p0 + 11)) { ph_n2(F, l); SEAM(p0 + 11); }
        if (EN(12) && IN(p0 + 12)) { ph_e0(F, l); SEAM(p0 + 12); }
        if (EN(13) && IN(p0 + 13)) { const Ctx P = launder(F);
            __syncthreads(); build_tiles(P, l); __syncthreads();
            const int ntiles = P.misc[16 + NE];
            pg8::Gemm g{(const bf16*)(P.ws + WS_P), (const bf16*)((P.ws + WS_WB) + WB_GU), MAXROWS, 512, DM, (size_t)512 * DM * 2};
            MoeOrder S{ntiles * 2, 2, P.G, P.bid, P.misc};
            EpiGLU E{(bf16*)(P.ws + WS_HID)};
            pg8::gemm_phase<EpiGLU, MoeOrder, true, true>(P.lds, g, S, E, P.wave);
            SEAM(p0 + 13); }
        if (EN(14) && IN(p0 + 14)) { const Ctx P = launder(F);
            __syncthreads(); build_tiles(P, l); __syncthreads();
            const int ntiles = P.misc[16 + NE];
            pg8::Gemm g{(const bf16*)(P.ws + WS_HID), (const bf16*)((P.ws + WS_WB) + WB_DN), MAXROWS, DM, DE, (size_t)DM * DE * 2};
            MoeOrder S{ntiles * 4, 4, P.G, P.bid, P.misc};
            pg8::EpiBf16<0> E{(bf16*)(P.ws + WS_P), DM, nullptr, 0, 0, 1.f};
            pg8::gemm_phase<pg8::EpiBf16<0>, MoeOrder, true, true>(P.lds, g, S, E, P.wave);
            SEAM(p0 + 14); }
    }
    if (EN(16) && IN(N_PHASES - 1)) ph_n1(F, 0, 1);
}

extern "C" void kernel_launch(void* const* d_in, const int* in_sizes, int n_in, void* d_out, int out_size, void* d_ws, size_t ws_size, hipStream_t stream) {
    static int grid = 0;
    if (grid == 0) {
        if (n_in != 36 || out_size != NTOK * DM || ws_size < WS_END) { fprintf(stderr, "kernel_launch: unexpected shapes: n_in %d out %d ws %zu (need %zu)\n", n_in, out_size, ws_size, (size_t)WS_END); grid = -1; return; }
        int dev = 0, cus = 0, per_cu = 0;
        if (hipGetDevice(&dev) != hipSuccess || hipDeviceGetAttribute(&cus, hipDeviceAttributeMultiprocessorCount, dev) != hipSuccess) { grid = -1; return; }
        if (hipFuncSetAttribute((const void*)fwd, hipFuncAttributeMaxDynamicSharedMemorySize, LDS_BYTES) != hipSuccess) { fprintf(stderr, "kernel_launch: hipFuncSetAttribute failed\n"); grid = -1; return; }
        if (hipOccupancyMaxActiveBlocksPerMultiprocessor(&per_cu, (const void*)fwd, 512, LDS_BYTES) != hipSuccess || per_cu < 1) fprintf(stderr, "kernel_launch: occupancy query says %d\n", per_cu);
        (void)hipGetLastError();
        grid = cus;
    }
    if (grid < 0) return;
    (void)hipMemsetAsync((char*)d_ws + WS_CTL, 0, CTL_BYTES, stream);
    Args a{};
    for (int i = 0; i < 36; ++i) a.in[i] = (const float*)d_in[i];
    a.out = (float*)d_out; a.ws = (unsigned char*)d_ws;
#if ONE_LAUNCH
    a.ph_lo = 0; a.ph_hi = N_PHASES;
    hipLaunchKernelGGL(fwd, dim3(grid), dim3(512), LDS_BYTES, stream, a);
#else
    for (int ph = 0; ph < N_PHASES; ++ph) { a.ph_lo = ph; a.ph_hi = ph + 1; hipLaunchKernelGGL(fwd, dim3(grid), dim3(512), LDS_BYTES, stream, a); }
#endif
}
```

```cpp
#include <hip/hip_runtime.h>
#include <cstdio>
#include <cstdint>
namespace pg8 {
#define PG8_LAS __attribute__((address_space(3)))
typedef unsigned short bf16_t;
typedef short bf16x8 __attribute__((ext_vector_type(8)));
typedef float f32x4 __attribute__((ext_vector_type(4)));
typedef unsigned u32x4 __attribute__((ext_vector_type(4)));
constexpr int BM = 256, BK = 64, HALF = 128, HTB = HALF * BK * 2  , STAGE_BYTES = 8 * HTB, NXCD = 8, WGM = 8;

__host__ __device__ __forceinline__ int lds_byte(int r, int c) { const int st = (r >> 4) * 2 + (c >> 5), rr = r & 15, cc = c & 31, ob = rr * 64 + cc * 2; return st * 1024 + (ob ^ (((ob >> 9) & 1) << 5)); }
__host__ __device__ __forceinline__ void stage_rc(int b, int& R, int& C) { const int st = b / 1024, sb = b % 1024, swz = sb ^ (((sb >> 9) & 1) << 5); R = (st >> 1) * 16 + swz / 64; C = (st & 1) * 32 + (swz % 64) / 2; }
__host__ __device__ __forceinline__ int perm32(int rho) { const int n = rho >> 4, i = rho & 15; return 8 * (i >> 2) + 4 * n + (i & 3); }

struct Unit { int pm, pn, e; };
struct Gemm { const bf16_t* A; const bf16_t* Bt; int M, N, K; size_t estride; };

struct StaticOrder {
    int nM, nN, nwg, G, c;
    __host__ __device__ void init(int M, int N, int G_, int c_) { nM = M / BM; nN = N / BM; nwg = nM * nN; G = G_; c = c_; }
    __host__ __device__ bool next(int i, Unit& u) const {
        const long L = (long)i * G + c; if (L >= nwg) return false;
        int wgid = (int)L; { const int q = nwg / NXCD, r = nwg % NXCD, xcd = wgid % NXCD, off = wgid / NXCD; wgid = (xcd < r ? xcd * (q + 1) : r * (q + 1) + (xcd - r) * q) + off; }
        const int nig = WGM * nN, gid = wgid / nig, fm = gid * WGM, gsz = (nM - fm) < WGM ? (nM - fm) : WGM;
        u.pm = fm + ((wgid % nig) % gsz); u.pn = (wgid % nig) / gsz; u.e = 0; return true;
    }
    __device__ __forceinline__ void a_ready(const Unit&) const {}
    __device__ __forceinline__ void done(const Unit&) const {}
    __device__ __forceinline__ unsigned rowbyte(const Unit&, int, int) const { return 0u; }
};

__device__ __forceinline__ unsigned cvt_pk_bf16(float lo, float hi) { unsigned r; asm volatile("v_cvt_pk_bf16_f32 %0, %1, %2" : "=v"(r) : "v"(lo), "v"(hi)); return r; }
typedef float f32x2 __attribute__((ext_vector_type(2)));
__device__ __forceinline__ f32x2 gelu_pk(f32x2 v) {
    const f32x2 av = __builtin_elementwise_abs(v), d = av * 0.2316418882f + 1.0f;
    f32x2 t; t.x = __builtin_amdgcn_rcpf(d.x); t.y = __builtin_amdgcn_rcpf(d.y);
    f32x2 q = t * 0.5307027145f + (-0.7265760135f); q = q * t + 0.7107068705f; q = q * t + (-0.142248368f); q = q * t + 0.127414796f; q = q * t;
    const f32x2 s = (v * v) * (-0.72134752044f);
    f32x2 e; e.x = __builtin_amdgcn_exp2f(s.x); e.y = __builtin_amdgcn_exp2f(s.y);
    const f32x2 m = v * (q * e), r = v - m;
    f32x2 o; o.x = v.x < 0.f ? m.x : r.x; o.y = v.y < 0.f ? m.y : r.y; return o;
}

template <int ACT  > struct EpiBf16 {
    static constexpr bool PERM = true, AFTER_DRAIN = false; static_assert(ACT == 0 || ACT == 1, "EpiBf16: ACT is 0 (none) or 1 (gelu_pk)");
    bf16_t* O; int ldc; const float* bias; int split_cols; size_t split_stride; float scale0;
    __device__ __forceinline__ void operator()(const f32x4 (&acc)[2][2][4][2], const Unit& u, int wr, int wc, int fr, int fq) const {
        const int row0 = u.pm * BM + wr * 64 + fr; int colt = u.pn * BM; bf16_t* base = O;
        float sc = 1.f; if (split_cols) { const int t = colt / split_cols; base += (size_t)t * split_stride; colt -= t * split_cols; if (t == 0) sc = scale0; }
        const int col0 = colt + wc * 32 + 8 * fq, bcol0 = u.pn * BM + wc * 32 + 8 * fq;
#pragma unroll
        for (int ai = 0; ai < 2; ++ai)
#pragma unroll
            for (int m = 0; m < 4; ++m) { bf16_t* rowp = base + (size_t)(row0 + ai * HALF + m * 16) * ldc + col0;
#pragma unroll
                for (int bj = 0; bj < 2; ++bj) { f32x4 v0 = acc[ai][bj][m][0], v1 = acc[ai][bj][m][1];
                    if (ACT == 1) { f32x2 a = gelu_pk((f32x2){v0[0], v0[1]}), b = gelu_pk((f32x2){v0[2], v0[3]}), c = gelu_pk((f32x2){v1[0], v1[1]}), d = gelu_pk((f32x2){v1[2], v1[3]});
                        v0 = (f32x4){a.x, a.y, b.x, b.y}; v1 = (f32x4){c.x, c.y, d.x, d.y}; }
                    v0 = v0 * sc; v1 = v1 * sc; u32x4 w; w.x = cvt_pk_bf16(v0[0], v0[1]); w.y = cvt_pk_bf16(v0[2], v0[3]); w.z = cvt_pk_bf16(v1[0], v1[1]); w.w = cvt_pk_bf16(v1[2], v1[3]);
                    *(u32x4*)(rowp + bj * HALF) = w; } }
    }
};
template <class Epi, class Sched, bool ALIGN_EPI = false, bool SP2 = false, bool GATHER = false>
__device__ __forceinline__ void gemm_phase(PG8_LAS unsigned char* lds, const Gemm g, const Sched& S, const Epi& E, const int wave_index) {
    int tid_; { int ln_; asm volatile("v_mbcnt_lo_u32_b32 %0, -1, 0\n\tv_mbcnt_hi_u32_b32 %0, -1, %0" : "=v"(ln_)); tid_ = wave_index * 64 + ln_; }
    const int tid = tid_, wid = __builtin_amdgcn_readfirstlane(tid >> 6), lane = tid & 63, wr = wid >> 2, wc = wid & 3, fr = lane & 15, fq = lane >> 4;
    int K_ = g.K; asm volatile("" : "+s"(K_)); const int K = K_, nt = K / BK;
    unsigned voffA[2], voffB[2]; unsigned vc[2][2], vn[2][2];
#pragma unroll
    for (int i = 0; i < 2; ++i) { int R, C; stage_rc(tid * 16 + i * 8192, R, C); const int Rb = Epi::PERM ? ((R & ~31) + perm32(R & 31)) : R;
        voffA[i] = (unsigned)(R * K + C) * 2u; voffB[i] = (unsigned)(Rb * K + C) * 2u; }
    const size_t kstep = (size_t)(BK * 2);
    const size_t hstep = (size_t)HALF * K * 2;
    const size_t tstep = 2 * hstep;
    const unsigned ldsw = (unsigned)wid * 1024u;
    const int aoff = lds_byte(wr * 64 + fr, fq * 8), boff = lds_byte(wc * 32 + fr, fq * 8);
#define PG8_SA(b, h) (((b) * 2 + (h)) * HTB)
#define PG8_SB(b, h) ((4 + (b) * 2 + (h)) * HTB)
#define PG8_STAGE(bufoff, gbase, voff) do { _Pragma("unroll") for (int _i = 0; _i < 2; ++_i) \
        __builtin_amdgcn_global_load_lds((const unsigned*)((const char*)(gbase) + (voff)[_i]), (PG8_LAS unsigned*)(lds + (bufoff) + ldsw + _i * 8192), 16, 0, 0); } while (0)
#define PG8_STAGE_A(bufoff, gbase, half, usenext) do { if constexpr (GATHER) { const unsigned oo_[2] = {(usenext) ? vn[half][0] : vc[half][0], (usenext) ? vn[half][1] : vc[half][1]}; PG8_STAGE(bufoff, gbase, oo_); } \
        else { PG8_STAGE(bufoff, (gbase) + (half) * hstep, voffA); } } while (0)
#define PG8_GSET(dst, u) do { _Pragma("unroll") for (int h_ = 0; h_ < 2; ++h_) _Pragma("unroll") for (int i_ = 0; i_ < 2; ++i_) { int R_, C_; stage_rc(tid * 16 + i_ * 8192, R_, C_); dst[h_][i_] = S.rowbyte(u, h_ * HALF + R_, K) + (unsigned)C_ * 2u; } } while (0)
#define PG8_LDA(dst, b, h) do { _Pragma("unroll") for (int m = 0; m < 4; ++m) _Pragma("unroll") for (int k = 0; k < 2; ++k) dst[m][k] = *(const PG8_LAS bf16x8*)(lds + PG8_SA(b, h) + aoff + m * 2048 + k * 1024); } while (0)
#define PG8_LDB(dst, b, h) do { _Pragma("unroll") for (int n = 0; n < 2; ++n) _Pragma("unroll") for (int k = 0; k < 2; ++k) dst[n][k] = *(const PG8_LAS bf16x8*)(lds + PG8_SB(b, h) + boff + n * 2048 + k * 1024); } while (0)
#define PG8_MMA(ai, bj, At, Bt) do { __builtin_amdgcn_s_setprio(1); _Pragma("unroll") for (int m = 0; m < 4; ++m) _Pragma("unroll") for (int n = 0; n < 2; ++n) _Pragma("unroll") for (int k = 0; k < 2; ++k) \
        acc[ai][bj][m][n] = __builtin_amdgcn_mfma_f32_16x16x32_bf16(Bt[n][k], At[m][k], acc[ai][bj][m][n], 0, 0, 0); __builtin_amdgcn_s_setprio(0); } while (0)
#define PG8_WAIT_V(n) asm volatile("s_waitcnt vmcnt(" #n ")" ::: "memory")
#define PG8_WAIT_L(n) asm volatile("s_waitcnt lgkmcnt(" #n ")" ::: "memory")
#define PG8_BAR __builtin_amdgcn_s_barrier()
#define PG8_SCHED __builtin_amdgcn_sched_barrier(0)
    Unit cur, nxt; int ui = 0;
    if (!S.next(0, cur)) return;
    float z0_ = 0.f; asm volatile("" : "+v"(z0_));
    f32x4 acc[2][2][4][2];
#pragma unroll
    for (int a = 0; a < 2; ++a)
#pragma unroll
        for (int b = 0; b < 2; ++b)
#pragma unroll
            for (int m = 0; m < 4; ++m)
#pragma unroll
                for (int n = 0; n < 2; ++n) acc[a][b][m][n] = (f32x4){z0_, z0_, z0_, z0_};
    bf16x8 At[4][2], B0[2][2], B1[2][2];
    const char* cA = (const char*)g.A + (GATHER ? (size_t)0 : (size_t)cur.pm * tstep); const char* cB = (const char*)g.Bt + (size_t)cur.e * g.estride + (size_t)cur.pn * tstep;
    S.a_ready(cur);
    if constexpr (GATHER) PG8_GSET(vc, cur);
    if constexpr (SP2) {
        PG8_STAGE(PG8_SB(0, 0), cB, voffB); PG8_STAGE(PG8_SB(0, 1), cB + hstep, voffB); PG8_STAGE_A(PG8_SA(0, 0), cA, 0, false); PG8_STAGE_A(PG8_SA(0, 1), cA, 1, false);
        if (wr == 1) PG8_BAR;
        PG8_WAIT_V(2); PG8_BAR;
        PG8_STAGE(PG8_SB(1, 0), cB + kstep, voffB); PG8_STAGE_A(PG8_SA(1, 0), cA + kstep, 0, false); PG8_STAGE(PG8_SB(1, 1), cB + hstep + kstep, voffB);
        PG8_WAIT_V(6); PG8_BAR;
    } else {
        PG8_STAGE(PG8_SB(0, 0), cB, voffB); PG8_STAGE(PG8_SA(0, 0), cA, voffA); PG8_STAGE(PG8_SB(0, 1), cB + hstep, voffB); PG8_STAGE(PG8_SA(0, 1), cA + hstep, voffA);
        if (wr == 1) PG8_BAR;
        PG8_WAIT_V(4); PG8_BAR;
        PG8_STAGE(PG8_SB(1, 0), cB + kstep, voffB); PG8_STAGE(PG8_SA(1, 0), cA + kstep, voffA); PG8_STAGE(PG8_SB(1, 1), cB + hstep + kstep, voffB);
        PG8_WAIT_V(6); PG8_BAR;
    }
    for (;;) {
        const bool has_next = S.next(ui + 1, nxt);
        const char* nA = (has_next && !GATHER) ? (const char*)g.A + (size_t)nxt.pm * tstep : cA; if constexpr (GATHER) { if (has_next) PG8_GSET(vn, nxt); }
        const bool un_ = has_next; (void)un_; const char* nB = has_next ? (const char*)g.Bt + (size_t)nxt.e * g.estride + (size_t)nxt.pn * tstep : cB;
        for (int t = 0; t < nt; t += 2) {
            const bool last = (t == nt - 2);
            const char* a1 = cA + (size_t)(t + 1) * kstep;
            const char* a2 = last ? nA : cA + (size_t)(t + 2) * kstep; const char* b2 = last ? nB : cB + (size_t)(t + 2) * kstep;
            const char* a3 = a2 + kstep; const char* b3 = b2 + kstep;
            if (last && has_next) S.a_ready(nxt);
            if constexpr (SP2) {
            PG8_LDB(B0, 0, 0); PG8_LDB(B1, 0, 1); PG8_SCHED; PG8_LDA(At, 0, 0); PG8_STAGE_A(PG8_SA(1, 1), a1, 1, false);
            PG8_WAIT_V(8); PG8_WAIT_L(0); PG8_BAR; PG8_MMA(0, 0, At, B0); PG8_MMA(0, 1, At, B1); PG8_BAR; PG8_SCHED;
            PG8_LDA(At, 0, 1); PG8_STAGE(PG8_SB(0, 0), b2, voffB); PG8_STAGE(PG8_SB(0, 1), b2 + hstep, voffB); PG8_STAGE_A(PG8_SA(0, 0), a2, 0, last && un_);
            PG8_WAIT_V(8); PG8_WAIT_L(0); PG8_BAR; PG8_MMA(1, 0, At, B0); PG8_MMA(1, 1, At, B1); PG8_BAR; PG8_SCHED;
            PG8_LDB(B0, 1, 0); PG8_LDB(B1, 1, 1); PG8_SCHED; PG8_LDA(At, 1, 0); PG8_STAGE_A(PG8_SA(0, 1), a2, 1, last && un_);
            PG8_WAIT_V(8); PG8_WAIT_L(0); PG8_BAR; PG8_MMA(0, 0, At, B0); PG8_MMA(0, 1, At, B1); PG8_BAR; PG8_SCHED;
            PG8_LDA(At, 1, 1); PG8_STAGE(PG8_SB(1, 0), b3, voffB); PG8_STAGE(PG8_SB(1, 1), b3 + hstep, voffB); PG8_STAGE_A(PG8_SA(1, 0), a3, 0, last && un_);
            PG8_WAIT_V(8); PG8_WAIT_L(0); PG8_BAR; PG8_MMA(1, 0, At, B0); PG8_MMA(1, 1, At, B1); PG8_BAR; PG8_SCHED;
            } else {
            PG8_LDB(B0, 0, 0); PG8_SCHED; PG8_LDA(At, 0, 0); PG8_STAGE(PG8_SA(1, 1), a1 + hstep, voffA);
            PG8_WAIT_L(8); PG8_BAR; PG8_WAIT_L(0); PG8_MMA(0, 0, At, B0); PG8_BAR; PG8_SCHED;
            PG8_LDB(B1, 0, 1); PG8_STAGE(PG8_SB(0, 0), b2, voffB);
            PG8_BAR; PG8_WAIT_L(0); PG8_MMA(0, 1, At, B1); PG8_BAR;
            PG8_LDA(At, 0, 1); PG8_STAGE(PG8_SA(0, 0), a2, voffA);
            PG8_BAR; PG8_WAIT_L(0); PG8_MMA(1, 0, At, B0); PG8_BAR; PG8_SCHED;
            PG8_STAGE(PG8_SB(0, 1), b2 + hstep, voffB);
            PG8_WAIT_V(6); PG8_BAR; PG8_MMA(1, 1, At, B1); PG8_BAR;
            PG8_LDB(B0, 1, 0); PG8_SCHED; PG8_LDA(At, 1, 0); PG8_STAGE(PG8_SA(0, 1), a2 + hstep, voffA);
            PG8_WAIT_L(8); PG8_BAR; PG8_WAIT_L(0); PG8_MMA(0, 0, At, B0); PG8_BAR; PG8_SCHED;
            PG8_LDB(B1, 1, 1); PG8_STAGE(PG8_SB(1, 0), b3, voffB);
            PG8_BAR; PG8_WAIT_L(0); PG8_MMA(0, 1, At, B1); PG8_BAR;
            PG8_LDA(At, 1, 1); PG8_STAGE(PG8_SA(1, 0), a3, voffA);
            PG8_BAR; PG8_WAIT_L(0); PG8_MMA(1, 0, At, B0); PG8_BAR; PG8_SCHED;
            PG8_STAGE(PG8_SB(1, 1), b3 + hstep, voffB);
            PG8_WAIT_V(6); PG8_BAR; PG8_MMA(1, 1, At, B1); PG8_BAR;
            }
        }
        if constexpr (ALIGN_EPI) { if (wr == 0) PG8_BAR; }
        if constexpr (!Epi::AFTER_DRAIN) { int ln2_; asm volatile("v_mbcnt_lo_u32_b32 %0, -1, 0\n\tv_mbcnt_hi_u32_b32 %0, -1, %0" : "=v"(ln2_)); E(acc, cur, wr, wc, ln2_ & 15, ln2_ >> 4); S.done(cur); }
        if (!has_next) break;
        float z1_ = 0.f; asm volatile("" : "+v"(z1_));
#pragma unroll
        for (int a = 0; a < 2; ++a)
#pragma unroll
            for (int b = 0; b < 2; ++b)
#pragma unroll
                for (int m = 0; m < 4; ++m)
#pragma unroll
                    for (int n = 0; n < 2; ++n) acc[a][b][m][n] = (f32x4){z1_, z1_, z1_, z1_};
        cur = nxt; cA = nA; cB = nB; ++ui;
        if constexpr (GATHER) { _Pragma("unroll") for (int h_ = 0; h_ < 2; ++h_) _Pragma("unroll") for (int i_ = 0; i_ < 2; ++i_) vc[h_][i_] = vn[h_][i_]; }
        if constexpr (ALIGN_EPI) { if (wr == 1) PG8_BAR; }
    }
    PG8_WAIT_V(0);
    if constexpr (!ALIGN_EPI) { if (wr == 0) PG8_BAR; }
    PG8_BAR;
    if constexpr (Epi::AFTER_DRAIN) { E.fused(acc, cur, wr, wc, fr, fq, lds, wid, lane); S.done(cur); }
#undef PG8_SA
#undef PG8_SB
#undef PG8_STAGE
#undef PG8_LDA
#undef PG8_STAGE_A
#undef PG8_GSET
#undef PG8_LDB
#undef PG8_MMA
#undef PG8_WAIT_V
#undef PG8_WAIT_L
#undef PG8_BAR
#undef PG8_SCHED
}
}

#ifndef ONE_LAUNCH
#define ONE_LAUNCH 1
#endif

#define GAS __attribute__((address_space(1)))
#define LAS __attribute__((address_space(3)))
typedef unsigned short bf16;
typedef float v4f __attribute__((ext_vector_type(4)));
typedef unsigned v4u __attribute__((ext_vector_type(4)));
typedef unsigned v2u __attribute__((ext_vector_type(2)));

constexpr int NB = 8, SEQ = 4096, NTOK = NB * SEQ, DM = 1024, NL = 4;
constexpr int DIN = 3090, NP = 3072;
constexpr int PC_S5 = 0, PC_GQKV = 256, PC_GZ = 1408, PC_SZ = 1792, PC_SX = 2176;
constexpr int NE = 32, DE = 256;
constexpr int MAXROWS = 2 * NTOK + NE * 256;
constexpr int MAXTILES = MAXROWS / 256;
constexpr float EPS = 1e-6f;

constexpr size_t MiB = 1u << 20;
constexpr size_t WS_CTL = 0, CTL_BYTES = 1 * MiB;
constexpr size_t WS_MOD = 1 * MiB;
constexpr size_t WS_SMW = 2 * MiB;
constexpr size_t WS_RW = 3 * MiB;
constexpr size_t WS_TI = 4 * MiB;
constexpr size_t WS_LIST = 5 * MiB;
constexpr size_t WS_SM = 9 * MiB;
constexpr size_t WS_WB = 16 * MiB;
constexpr size_t WB_IN = 0, WB_OUT = 6 * MiB, WB_GU = 8 * MiB, WB_DN = 40 * MiB;
constexpr size_t WS_P = 72 * MiB;
constexpr size_t WS_HID = WS_P + 144 * MiB;
constexpr size_t WS_H = 264 * MiB;
constexpr size_t WS_Y = 328 * MiB;
constexpr size_t WS_YRAW = 392 * MiB;
constexpr size_t WS_CS2 = 424 * MiB;
constexpr size_t WS_CD = 12 * MiB;
constexpr size_t WS_WGLU = 600 * MiB;
constexpr size_t WS_X = 608 * MiB;
constexpr size_t WS_END = 672 * MiB;
static_assert((size_t)MAXROWS * DM * 2 <= 144 * MiB && (size_t)MAXROWS * DE * 2 <= 48 * MiB, "moe overlay");
constexpr int CW_BAR = 4096;
constexpr int CW_CNT = 16384;
constexpr int CW_RT = 65536;
constexpr int CW_S5F = 32768;
constexpr size_t WS_TW = 14 * MiB;
constexpr size_t WS_S5X = 13 * MiB;

constexpr int LDS_MISC = 147456;
constexpr int LDS_BYTES = LDS_MISC + 4096;

struct Args {
    const float* in[36]; float* out; unsigned char* ws; int ph_lo, ph_hi;
};
enum { I_X = 0, I_C, I_WADA, I_BADA, I_NMIX, I_NFFN, I_WIN, I_WOUT, I_S5ARE, I_S5AIM, I_S5BRE, I_S5BIM, I_S5CRE, I_S5CIM, I_S5D, I_S5LDT, I_S5GLU, I_S5NORM,
       I_GCW, I_GALOG, I_GDTB, I_GNORM, I_SCW, I_SCB, I_SALOG, I_SDTB, I_SD, I_SNORM, I_MWG, I_MBG, I_MWR, I_MBR, I_MGATE, I_MUP, I_MDOWN, I_NFIN };

struct Ctx { LAS unsigned char* lds; volatile LAS int* misc; unsigned char* ws; float* out; int tid, lane, wave, G, bid; };
constexpr int MISC_PTR = 448;
__device__ __forceinline__ const float* inptr(const Ctx& F, int i) { unsigned lo = (unsigned)F.misc[MISC_PTR + 2 * i], hi = (unsigned)F.misc[MISC_PTR + 2 * i + 1];
    lo = __builtin_amdgcn_readfirstlane(lo); hi = __builtin_amdgcn_readfirstlane(hi); return (const float*)(const GAS float*)(((unsigned long long)hi << 32) | lo); }

__device__ __forceinline__ Ctx launder(const Ctx& F) { Ctx G = F; int ln; asm volatile("v_mbcnt_lo_u32_b32 %0, -1, 0\n\tv_mbcnt_hi_u32_b32 %0, -1, %0" : "=v"(ln));
    int wv = F.wave; asm volatile("" : "+s"(wv)); G.wave = wv; G.lane = ln; G.tid = wv * 64 + ln;
    unsigned long long w = (unsigned long long)F.ws, o = (unsigned long long)F.out; unsigned l0 = (unsigned)(unsigned long long)F.lds; int gg = F.G, bb = F.bid; asm volatile("" : "+s"(w), "+s"(o), "+s"(l0), "+s"(gg), "+s"(bb)); G.G = gg; G.bid = bb;
    G.ws = (unsigned char*)(GAS unsigned char*)w; G.out = (float*)(GAS float*)o; G.lds = (LAS unsigned char*)(unsigned long long)l0; G.misc = (volatile LAS int*)(G.lds + LDS_MISC); return G; }
__device__ __forceinline__ int fresh_lane() { int ln; asm volatile("v_mbcnt_lo_u32_b32 %0, -1, 0\n\tv_mbcnt_hi_u32_b32 %0, -1, %0" : "=v"(ln)); return ln; }
__device__ __forceinline__ v4f zero4() { float z = 0.f; asm volatile("" : "+v"(z)); return (v4f){z, z, z, z}; }
__device__ __forceinline__ v4u zero4u() { unsigned z = 0u; asm volatile("" : "+v"(z)); return (v4u){z, z, z, z}; }
__device__ __forceinline__ v2u zero2u() { unsigned z = 0u; asm volatile("" : "+v"(z)); return (v2u){z, z}; }
#define LDS_WAIT() asm volatile("s_waitcnt lgkmcnt(0)" ::: "memory")
#define VM_WAIT() asm volatile("s_waitcnt vmcnt(0)" ::: "memory")

__device__ __forceinline__ float bf2f(unsigned v) { return __uint_as_float(v << 16); }
__device__ __forceinline__ unsigned f2bf(float f) { unsigned u = __float_as_uint(f); return (u + 0x7fffu + ((u >> 16) & 1u)) >> 16; }
typedef float f2_t __attribute__((ext_vector_type(2)));
typedef __bf16 b2_t __attribute__((ext_vector_type(2)));
__device__ __forceinline__ unsigned pk2(float lo, float hi) { const b2_t r = __builtin_convertvector((f2_t){lo, hi}, b2_t); return __builtin_bit_cast(unsigned, r); }
__device__ __forceinline__ float shx(float v, int m, int lane) { return __int_as_float(__builtin_amdgcn_ds_bpermute((lane ^ m) << 2, __float_as_int(v))); }
__device__ __forceinline__ float wave_sum_l(float v, int lane) {
    (void)lane;
    v += __int_as_float(__builtin_amdgcn_update_dpp(0, __float_as_int(v), 0xB1, 0xF, 0xF, true));
    v += __int_as_float(__builtin_amdgcn_update_dpp(0, __float_as_int(v), 0x4E, 0xF, 0xF, true));
    v += __int_as_float(__builtin_amdgcn_update_dpp(0, __float_as_int(v), 0x141, 0xF, 0xF, true));
    v += __int_as_float(__builtin_amdgcn_update_dpp(0, __float_as_int(v), 0x140, 0xF, 0xF, true));
    const float r0 = __int_as_float(__builtin_amdgcn_readlane(__float_as_int(v), 0)), r1 = __int_as_float(__builtin_amdgcn_readlane(__float_as_int(v), 16)),
                r2 = __int_as_float(__builtin_amdgcn_readlane(__float_as_int(v), 32)), r3 = __int_as_float(__builtin_amdgcn_readlane(__float_as_int(v), 48));
    return (r0 + r1) + (r2 + r3);
}

#define DPPF(src, ctrl, bank) __int_as_float(__builtin_amdgcn_update_dpp(0, __float_as_int(src), (ctrl), 0xF, (bank), true))
__device__ __forceinline__ float dpp_xor4(float x) { int r = __builtin_amdgcn_update_dpp(0, __float_as_int(x), 0x104, 0xF, 0x5, false); r = __builtin_amdgcn_update_dpp(r, __float_as_int(x), 0x114, 0xF, 0xA, false); return __int_as_float(r); }
__device__ __forceinline__ float dpp_xor8(float x) { int r = __builtin_amdgcn_update_dpp(0, __float_as_int(x), 0x108, 0xF, 0x3, false); r = __builtin_amdgcn_update_dpp(r, __float_as_int(x), 0x118, 0xF, 0xC, false); return __int_as_float(r); }
__device__ __forceinline__ float reduce16_scatter(const float (&v)[16], int lane) {
    const bool b0 = lane & 1, b1 = lane & 2, b2 = lane & 4, b3 = lane & 8;
    float r[8], q[4], p[2];
#pragma unroll
    for (int i = 0; i < 8; ++i) { const float keep = b0 ? v[2 * i + 1] : v[2 * i], send = b0 ? v[2 * i] : v[2 * i + 1]; r[i] = keep + DPPF(send, 0xB1, 0xF); }
#pragma unroll
    for (int i = 0; i < 4; ++i) { const float keep = b1 ? r[2 * i + 1] : r[2 * i], send = b1 ? r[2 * i] : r[2 * i + 1]; q[i] = keep + DPPF(send, 0x4E, 0xF); }
#pragma unroll
    for (int i = 0; i < 2; ++i) { const float keep = b2 ? q[2 * i + 1] : q[2 * i], send = b2 ? q[2 * i] : q[2 * i + 1]; p[i] = keep + dpp_xor4(send); }
    float t = (b3 ? p[1] : p[0]) + dpp_xor8(b3 ? p[0] : p[1]);
    t += __int_as_float(__builtin_amdgcn_ds_swizzle(__float_as_int(t), 0x401F));
    t += __int_as_float(__builtin_amdgcn_ds_bpermute((lane ^ 32) << 2, __float_as_int(t)));
    return t;
}
#define wave_sum(v) wave_sum_l((v), LN)
#define SHX(v, m) shx((v), (m), LN)
__device__ __forceinline__ float sigm(float x) { return __builtin_amdgcn_rcpf(1.f + __expf(-x)); }
__device__ __forceinline__ float silu_f(float x) { return x * __builtin_amdgcn_rcpf(1.f + __expf(-x)); }
__device__ __forceinline__ float log1p_small(float e) { return e < 0.03125f ? e * (1.f + e * (-0.5f + e * (0.33333334f - 0.25f * e))) : __logf(1.f + e); }
__device__ __forceinline__ float softplus_f(float x) { return fmaxf(x, 0.f) + log1p_small(__expf(-fabsf(x))); }
__device__ __forceinline__ float gelu_tanh(float x) { const float u = 0.7978845608028654f * (x + 0.044715f * x * x * x); return x * __builtin_amdgcn_rcpf(1.f + __expf(-2.f * u)); }
__device__ __forceinline__ float dot4(v4f a, v4f b) { return (a.x * b.x + a.y * b.y) + (a.z * b.z + a.w * b.w); }

#define XB_TMO      128
#define XB_XCNT(j)  (256  + 64 * (j))
#define XB_XSUB(j)  (1280 + 64 * (j))
#define XB_XGEN(j)  (2304 + 64 * (j))
#define XB_TOP      3328
#define XB_TOPGEN   3392
#define XCD_BAR_WORDS 3456
#define XB_SPIN_CAP (1u << 20)
__device__ __forceinline__ unsigned xb_ld(unsigned* p)              { return __hip_atomic_load(p, __ATOMIC_RELAXED, __HIP_MEMORY_SCOPE_AGENT); }
__device__ __forceinline__ unsigned xb_add(unsigned* p, unsigned v) { return __hip_atomic_fetch_add(p, v, __ATOMIC_RELAXED, __HIP_MEMORY_SCOPE_AGENT); }
__device__ __forceinline__ unsigned xb_xcc_id() { return (unsigned)__builtin_amdgcn_s_getreg((3 << 11) | 20) & 0xFu; }
#define XB_SPIN(cond, bar) do { unsigned _sp = 0; while (cond) { __builtin_amdgcn_s_sleep(1); \
    if ((++_sp & 255u) == 0u) { if (xb_ld(&(bar)[XB_TMO])) break; if (_sp > XB_SPIN_CAP) { atomicAdd(&(bar)[XB_TMO], 1u); break; } } } } while (0)
struct XcdBarrier { unsigned* bar; unsigned x; volatile LAS unsigned* st; };
__device__ __forceinline__ XcdBarrier xcd_barrier_post(unsigned* bar, volatile LAS unsigned* st) {
    XcdBarrier b; b.bar = bar; b.x = xb_xcc_id(); b.st = st;
    if (threadIdx.x == 0) (void)xb_add(&bar[XB_XCNT(b.x)], 1u);
    return b;
}
__device__ __forceinline__ void xcd_barrier_complete(unsigned* bar, unsigned x, unsigned& nloc, unsigned& nx) {
    const unsigned G = gridDim.x * gridDim.y * gridDim.z;
    unsigned sum, cnt, mine, sp = 0u;
    for (;;) {
        sum = 0u; cnt = 0u; mine = 0u;
#pragma unroll
        for (unsigned j = 0; j < 16; ++j) { const unsigned c = xb_ld(&bar[XB_XCNT(j)]); sum += c; cnt += (c > 0u) ? 1u : 0u; mine = (j == x) ? c : mine; }
        if (sum == G) break;
        __builtin_amdgcn_s_sleep(1);
        if ((++sp & 255u) == 0u) { if (xb_ld(&bar[XB_TMO])) break; if (sp > XB_SPIN_CAP) { atomicAdd(&bar[XB_TMO], 1u); break; } }
    }
    nloc = mine > 0u ? mine : 1u; nx = cnt > 0u ? cnt : 1u;
}
__device__ __forceinline__ void xcd_barrier(const XcdBarrier& b) {
    asm volatile("s_waitcnt vmcnt(0)" ::: "memory");
    __syncthreads();
    if (threadIdx.x == 0) {
        unsigned* bar = b.bar;
        __builtin_amdgcn_s_waitcnt(0);
        unsigned nloc = b.st[0], nx = b.st[1];
        if (nloc == 0u) { xcd_barrier_complete(bar, b.x, nloc, nx); b.st[0] = nloc; b.st[1] = nx; }
        const unsigned old = xb_add(&bar[XB_XSUB(b.x)], 1u);
        const unsigned gen = old / nloc;
        if (old + 1u == (gen + 1u) * nloc) {
            __builtin_amdgcn_fence(__ATOMIC_RELEASE, "agent");
            asm volatile("s_waitcnt vmcnt(0)" ::: "memory");
            const unsigned og = xb_add(&bar[XB_TOP], 1u);
            const unsigned tg = og / nx;
            if (og + 1u == (tg + 1u) * nx) xb_add(&bar[XB_TOPGEN], 1u);
            else XB_SPIN(xb_ld(&bar[XB_TOPGEN]) == tg, bar);
            __builtin_amdgcn_fence(__ATOMIC_ACQUIRE, "agent");
            xb_add(&bar[XB_XGEN(b.x)], 1u);
            asm volatile("s_waitcnt vmcnt(0)" ::: "memory");
        } else {
            XB_SPIN(xb_ld(&bar[XB_XGEN(b.x)]) == gen, bar);
            __builtin_amdgcn_fence(__ATOMIC_ACQUIRE, "agent");
            asm volatile("s_waitcnt vmcnt(0)" ::: "memory");
        }
    }
    __syncthreads();
}

__device__ __forceinline__ void ph_prologue(const Ctx& F0) {
    Ctx F = launder(F0);
    float* SMW = (float*)(F.ws + WS_SMW); float* RW = (float*)(F.ws + WS_RW); float* MOD = (float*)(F.ws + WS_MOD);
    const int gt = F.bid * 512 + F.tid, NT = F.G * 512;
    const float* p_win = inptr(F, I_WIN); const float* p_mwg = inptr(F, I_MWG); const float* p_mwr = inptr(F, I_MWR); const float* p_c = inptr(F, I_C); const float* p_bada = inptr(F, I_BADA);
    for (int i = gt; i < NL * 54 * DM; i += NT) {
        const int l = i / (54 * DM), r = i % (54 * DM), j = r / DM, k = r % DM;
        if (j < 18) { const int col = j < 12 ? 1792 + j : 3084 + (j - 12); SMW[(l * 18 + j) * DM + k] = p_win[((size_t)l * DM + k) * DIN + col]; }
        else { const int jj = j - 18; RW[(l * 36 + jj) * DM + k] = jj < 4 ? p_mwg[((size_t)l * DM + k) * 4 + jj] : p_mwr[((size_t)l * DM + k) * 32 + (jj - 4)]; }
    }
    { bf16* TW = (bf16*)(F.ws + WS_TW);
      for (int i = gt; i < NL * 32 * DM; i += NT) { const int l = i / (32 * DM), r = i % (32 * DM), j = r / DM, k = r % DM; float w = 0.f;
          if (j < 18) { const int col = j < 12 ? 1792 + j : 3084 + (j - 12); w = p_win[((size_t)l * DM + k) * DIN + col]; }
          const unsigned hi = f2bf(w); const float wl = w - bf2f(hi);
          TW[((size_t)(l * 2 + 0) * 32 + j) * DM + k] = (bf16)hi; TW[((size_t)(l * 2 + 1) * 32 + j) * DM + k] = (bf16)f2bf(wl); } }
    LAS float* cond = (LAS float*)F.lds; LAS float* red = (LAS float*)(F.lds + 32768);
    for (int item = F.bid; item < NL * 24; item += F.G) {
        for (int i = F.tid; i < NB * DM; i += 512) cond[i] = silu_f(p_c[i]);
        __syncthreads();
        const int l = item / 24, cg = item % 24;
        v4f acc[NB];
#pragma unroll
        for (int b = 0; b < NB; ++b) acc[b] = zero4();
        const float* wp = inptr(F, I_WADA) + ((size_t)l * DM + F.wave * 128) * (6 * DM) + cg * 256 + 4 * F.lane;
#pragma unroll 8
        for (int kk = 0; kk < 128; ++kk) {
            const v4f w = *(const v4f*)(wp + (size_t)kk * (6 * DM)); const int k = F.wave * 128 + kk;
#pragma unroll
            for (int b = 0; b < NB; ++b) acc[b] += cond[b * DM + k] * w;
        }
#pragma unroll
        for (int b = 0; b < NB; ++b) *(LAS v4f*)(red + (F.wave * NB + b) * 256 + 4 * F.lane) = acc[b];
        __syncthreads();
        for (int o = F.tid; o < NB * 256; o += 512) { const int b = o / 256, col = o % 256; float s = 0.f;
#pragma unroll
            for (int w = 0; w < 8; ++w) s += red[(w * NB + b) * 256 + col];
            MOD[((size_t)l * NB + b) * (6 * DM) + cg * 256 + col] = s + p_bada[l * 6 * DM + cg * 256 + col]; }
        __syncthreads();
    }
}

__device__ __forceinline__ void transpose_item(const float* W, int ldw, int K, bf16* WT, int k0, int nsrc0, int ndst0, LAS float* scr, int lane) {
    float t[32];
#pragma unroll
    for (int i = 0; i < 32; ++i) { const int kk = 2 * i + (lane >> 5); t[i] = W[(size_t)(k0 + kk) * ldw + nsrc0 + (lane & 31)]; }
#pragma unroll
    for (int i = 0; i < 32; ++i) { const int kk = 2 * i + (lane >> 5); scr[kk * 33 + (lane & 31)] = t[i]; }
    LDS_WAIT();
    const int c = lane & 7;
#pragma unroll
    for (int j = 0; j < 4; ++j) { const int n = (lane >> 3) + 8 * j; const LAS float* s = scr + (8 * c) * 33 + n;
        v4u o; o.x = pk2(s[0 * 33], s[1 * 33]); o.y = pk2(s[2 * 33], s[3 * 33]); o.z = pk2(s[4 * 33], s[5 * 33]); o.w = pk2(s[6 * 33], s[7 * 33]);
        *(v4u*)(WT + (size_t)(ndst0 + n) * K + k0 + 8 * c) = o; }
    LDS_WAIT();
}
constexpr int CV_IN = 16 * 96, CV_OUT = 16 * 32, CV_G = NE * 16 * 8, CV_D = NE * 4 * 32, CV_GLU = 4 * 8, CV_ITEMS = CV_IN + CV_OUT + 2 * CV_G + CV_D + CV_GLU;
__device__ __forceinline__ void convert_item(Ctx& F, int l, int it, LAS float* scr, int lane) {
    unsigned char* wb = F.ws + WS_WB;
    if (it < CV_IN) { const int kb = it / 96, nb = it % 96, nd = 32 * nb, ns = nd + (nd >= 1792 ? 12 : 0);
        transpose_item(inptr(F, I_WIN) + (size_t)l * DM * DIN, DIN, DM, (bf16*)(wb + WB_IN), 64 * kb, ns, nd, scr, lane); return; }
    it -= CV_IN;
    if (it < CV_OUT) { const int kb = it / 32, nb = it % 32;
        transpose_item(inptr(F, I_WOUT) + (size_t)l * DM * DM, DM, DM, (bf16*)(wb + WB_OUT), 64 * kb, 32 * nb, 32 * nb, scr, lane); return; }
    it -= CV_OUT;
    if (it < 2 * CV_G) { const int up = it >= CV_G; if (up) it -= CV_G; const int e = it / 128, r = it % 128, kb = r / 8, nb = r % 8, j0 = 32 * nb;
        const int nd = 256 * (j0 / 128) + (j0 % 128) + (up ? 128 : 0);
        transpose_item(inptr(F, up ? I_MUP : I_MGATE) + ((size_t)l * NE + e) * DM * DE, DE, DM, (bf16*)(wb + WB_GU) + (size_t)e * 512 * DM, 64 * kb, j0, nd, scr, lane); return; }
    it -= 2 * CV_G;
    if (it >= CV_D) { it -= CV_D; const int kb = it / 8, nb = it % 8;
        transpose_item(inptr(F, I_S5GLU) + (size_t)l * 65536, 256, 256, (bf16*)(F.ws + WS_WGLU), 64 * kb, 32 * nb, 32 * nb, scr, lane); return; }
    { const int e = it / 128, r = it % 128, kb = r / 32, nb = r % 32;
        transpose_item(inptr(F, I_MDOWN) + ((size_t)l * NE + e) * DE * DM, DM, DE, (bf16*)(wb + WB_DN) + (size_t)e * DM * DE, 64 * kb, 32 * nb, 32 * nb, scr, lane); }
}

__device__ __forceinline__ void build_tiles(const Ctx& F, int lc) {
    if (F.wave == 0) {
        const int ln = fresh_lane();
        const unsigned* cnt = (const unsigned*)(F.ws + WS_CTL) + CW_CNT + lc * NE;
        const int c = ln < NE ? (int)__hip_atomic_load(cnt + ln, __ATOMIC_RELAXED, __HIP_MEMORY_SCOPE_AGENT) : 0;
        const int nt = (c + 255) / 256;
        int incl = nt;
#pragma unroll
        for (int o = 1; o < 32; o <<= 1) { const int t = __builtin_amdgcn_ds_bpermute((ln >= o ? ln - o : ln) << 2, incl); if (ln >= o) incl += t; }
        const int excl = incl - nt;
        if (ln < NE) { F.misc[16 + ln] = excl; F.misc[64 + ln] = c; for (int t = 0; t < nt; ++t) F.misc[128 + excl + t] = ln; }
        if (ln == NE - 1) F.misc[16 + NE] = incl;
    }
}

typedef short bf16x8 __attribute__((ext_vector_type(8)));
__device__ __forceinline__ pg8::f32x4 mfma16_safe(bf16x8 a, bf16x8 b, pg8::f32x4 c) { pg8::f32x4 d = __builtin_amdgcn_mfma_f32_16x16x32_bf16(a, b, c, 0, 0, 0); asm volatile("" : "+v"(d) : "v"(a), "v"(b)); return d; }
#define MFMA16(a, b, c) mfma16_safe((a), (b), (c))
#define MFMA_SETTLE(acc) asm volatile("s_nop 15\n\ts_nop 7" : "+v"(acc))
__device__ __forceinline__ void ph_n1(const Ctx& F0, int l, int mode) {
    Ctx F = launder(F0);
    const int LN = F.lane;
    const float* MOD = (const float*)(F.ws + WS_MOD);
    const int lp = mode ? NL - 1 : l - 1;
    if (lp >= 0) build_tiles(F, lp);
    __syncthreads();
    if (mode == 0) {
        const bf16* TW = (const bf16*)(F.ws + WS_TW) + (size_t)l * 2 * 32 * DM;
        for (int i = F.tid; i < 2 * 18 * 128; i += 512) { const int term = i / (18 * 128), n = (i >> 7) % 18, slot = i & 127;
            *(LAS v4u*)(F.lds + 73728 + (((term * 18 + n) * 128 + (slot ^ (n & 15))) << 4)) = *(const v4u*)(TW + ((size_t)(term * 32 + n) * DM + slot * 8)); }
    }
    if (mode == 0) {
        LAS float* scr = (LAS float*)(F.lds + F.wave * 8448);
        for (int it = F.wave * F.G + F.bid; it < CV_IN; it += 8 * F.G) convert_item(F, l, it, scr, F.lane);
    }
    const int NGW = F.G * 8, gw = F.bid * 8 + F.wave, rows_per = (NTOK + NGW - 1) / NGW;
    const int r0 = gw * rows_per, r1 = (r0 + rows_per) < NTOK ? (r0 + rows_per) : NTOK;
    const float* xin = inptr(F, I_X); bf16* X = (bf16*)(F.ws + WS_X); const bool f32in = (mode == 0 && l == 0);
    const bf16* MO = (const bf16*)(F.ws + WS_P); const int* TI = (const int*)(F.ws + WS_TI);
    bf16* H = (bf16*)(F.ws + WS_H); float* SM = (float*)(F.ws + WS_SM);
    int curb = -1; v4f An[4], Bn[4], Gp[4];
    const float* p_nrm = inptr(F, mode == 0 ? I_NMIX : I_NFIN);
#pragma unroll
    for (int j = 0; j < 4; ++j) { An[j] = zero4(); Bn[j] = An[j]; Gp[j] = An[j]; }
    int tq[6]; { const int rr = (r0 + F.lane < r1) ? r0 + F.lane : r0;
#pragma unroll
        for (int q = 0; q < 6; ++q) tq[q] = (lp >= 0) ? TI[rr * 8 + q] : 0; }
    v4f nv[4]; v2u nx[4], na[4], nc[4]; float nw0 = 0.f, nw1 = 0.f;
#define N1_ISSUE(rr_) { const int rr = (rr_); \
        if (f32in) { _Pragma("unroll") for (int j = 0; j < 4; ++j) nv[j] = *(const v4f*)(xin + (size_t)rr * DM + 4 * F.lane + 256 * j); } \
        else { _Pragma("unroll") for (int j = 0; j < 4; ++j) nx[j] = *(const v2u*)(X + (size_t)rr * DM + 4 * F.lane + 256 * j); } \
        if (lp >= 0) { const int ix = rr - r0; const int e0 = __builtin_amdgcn_readlane(tq[0], ix), s0 = __builtin_amdgcn_readlane(tq[1], ix), e1 = __builtin_amdgcn_readlane(tq[3], ix), s1 = __builtin_amdgcn_readlane(tq[4], ix); \
            nw0 = __int_as_float(__builtin_amdgcn_readlane(tq[2], ix)); nw1 = __int_as_float(__builtin_amdgcn_readlane(tq[5], ix)); \
            const size_t ra = (size_t)(F.misc[16 + e0] * 256 + s0), rb = (size_t)(F.misc[16 + e1] * 256 + s1); \
            _Pragma("unroll") for (int j = 0; j < 4; ++j) { na[j] = *(const v2u*)(MO + ra * DM + 4 * F.lane + 256 * j); nc[j] = *(const v2u*)(MO + rb * DM + 4 * F.lane + 256 * j); } } }
#pragma unroll
    for (int j = 0; j < 4; ++j) { na[j] = zero2u(); nc[j] = na[j]; nx[j] = na[j]; nv[j] = zero4(); }
    N1_ISSUE(r0)
    for (int row = r0; row < r1; ++row) {
        const int b = row >> 12;
        if (b != curb) { curb = b;
#pragma unroll
            for (int j = 0; j < 4; ++j) { const int c = 4 * F.lane + 256 * j;
                if (mode == 0) { const v4f nm = *(const v4f*)(p_nrm + l * DM + c), sc = *(const v4f*)(MOD + ((size_t)l * NB + b) * 6 * DM + 1 * DM + c), sh = *(const v4f*)(MOD + ((size_t)l * NB + b) * 6 * DM + c);
                    An[j] = nm * (1.f + sc); Bn[j] = sh; }
                else { An[j] = *(const v4f*)(p_nrm + c); Bn[j] = zero4(); }
                if (lp >= 0) Gp[j] = *(const v4f*)(MOD + ((size_t)lp * NB + b) * 6 * DM + 5 * DM + c); }
        }
        v4f v[4]; v2u ma[4], mc[4]; const float w0 = nw0, w1 = nw1;
#pragma unroll
        for (int j = 0; j < 4; ++j) { const v2u q = nx[j]; v[j] = f32in ? nv[j] : (v4f){bf2f(q.x & 0xffffu), bf2f(q.x >> 16), bf2f(q.y & 0xffffu), bf2f(q.y >> 16)}; ma[j] = na[j]; mc[j] = nc[j]; }
        N1_ISSUE((row + 1 < r1) ? row + 1 : row)
        if (lp >= 0) {
#pragma unroll
            for (int j = 0; j < 4; ++j) { const v2u a = ma[j], c = mc[j];
                const v4f ya = (v4f){bf2f(a.x & 0xffffu), bf2f(a.x >> 16), bf2f(a.y & 0xffffu), bf2f(a.y >> 16)}, yb = (v4f){bf2f(c.x & 0xffffu), bf2f(c.x >> 16), bf2f(c.y & 0xffffu), bf2f(c.y >> 16)};
                v[j] += Gp[j] * (w0 * ya + w1 * yb); }
        }
        if (mode == 0 && (lp >= 0 || f32in)) {
#pragma unroll
            for (int j = 0; j < 4; ++j) { v2u o; o.x = pk2(v[j].x, v[j].y); o.y = pk2(v[j].z, v[j].w); *(v2u*)(X + (size_t)row * DM + 4 * F.lane + 256 * j) = o; }
        }
        float ss = 0.f;
#pragma unroll
        for (int j = 0; j < 4; ++j) ss += dot4(v[j], v[j]);
        const float rs = rsqrtf(wave_sum(ss) * (1.f / DM) + EPS);
        v4f h[4];
#pragma unroll
        for (int j = 0; j < 4; ++j) h[j] = v[j] * rs * An[j] + Bn[j];
        if (mode == 1) {
#if PROBE_MASK
            { const float traw = (float)(*(const volatile unsigned*)(F.ws + WS_CTL + 4 * 200)) * 0.01f, tus = exp2f(rintf(log2f(fmaxf(traw, 1.f)) * 2.f) * 0.5f), ep = sqrtf(tus * 5e-7f); const float sg = (F.lane & 1) ? ep : -ep;
#pragma unroll
              for (int j = 0; j < 4; ++j) { h[j].x += sg; h[j].y -= sg; h[j].z += sg; h[j].w -= sg; } }
#endif
#pragma unroll
            for (int j = 0; j < 4; ++j) *(v4f*)(F.out + (size_t)row * DM + 4 * F.lane + 256 * j) = h[j];
            continue;
        }
#pragma unroll
        for (int j = 0; j < 4; ++j) { v2u o; o.x = pk2(h[j].x, h[j].y); o.y = pk2(h[j].z, h[j].w); *(v2u*)(H + (size_t)row * DM + 4 * F.lane + 256 * j) = o; }
    }
    if (mode == 0) {
        asm volatile("s_waitcnt vmcnt(0)" ::: "memory");
        __syncthreads();
        const int fr = F.lane & 15, fq = F.lane >> 4; const int n1 = (16 + fr) < 17 ? (16 + fr) : 17;
        const unsigned tb0 = (unsigned)(73728 + ((fr * 128) << 4)), tb1 = (unsigned)(73728 + ((n1 * 128) << 4)); const int x0 = fr & 15, x1 = n1 & 15;
        const float* p_alog = inptr(F, I_GALOG) + l * 6; const float* p_gdtb = inptr(F, I_GDTB) + l * 6; const float* p_sdtb = inptr(F, I_SDTB) + l * 6;
        for (int t0 = r0; t0 < r1; t0 += 16) {
            const int ar = (t0 + fr < r1) ? t0 + fr : r1 - 1;
            pg8::f32x4 acc[2]; acc[0] = zero4(); acc[1] = zero4();
            const bf16* ap = H + (size_t)ar * DM + 8 * fq;
#pragma unroll 1
            for (int k4 = 0; k4 < 32; k4 += 4) { bf16x8 af[4], bfr[4][4];
#pragma unroll
                for (int i = 0; i < 4; ++i) { af[i] = *(const bf16x8*)(ap + 32 * (k4 + i));
#pragma unroll
                    for (int hn = 0; hn < 4; ++hn) { const int sl = 4 * (k4 + i) + fq; bfr[i][hn] = *(const LAS bf16x8*)(F.lds + ((hn & 1) ? tb1 : tb0) + (hn >> 1) * (18 * 128 * 16) + ((sl ^ ((hn & 1) ? x1 : x0)) << 4)); } }
#pragma unroll
                for (int i = 0; i < 4; ++i)
#pragma unroll
                    for (int hn = 0; hn < 4; ++hn) acc[hn & 1] = MFMA16(af[i], bfr[i][hn], acc[hn & 1]); }
            MFMA_SETTLE(acc[0]); MFMA_SETTLE(acc[1]);
#pragma unroll
            for (int nt = 0; nt < 2; ++nt) { const int n = 16 * nt + fr;
                if (n < 18) { float ca = 0.f, cb = 0.f; if (n < 6) { ca = -expf(p_alog[n]); cb = p_gdtb[n]; } else if (n >= 12) cb = p_sdtb[n - 12];
#pragma unroll
                    for (int r = 0; r < 4; ++r) { const int row = t0 + 4 * fq + r; const float a = acc[nt][r]; float o;
                        if (n < 6) o = ca * softplus_f(a + cb); else if (n < 12) o = sigm(a); else o = softplus_f(a + cb);
                        if (row < r1) SM[(size_t)row * 18 + n] = o; } } }
        }
    }
}
constexpr int TB = 8;
__device__ __forceinline__ void gdn_naive(Ctx& F, int l, int b, int hh, int cq, LAS float* wl, int lane) {
    const int LN = lane;
    const bf16* P = (const bf16*)(F.ws + WS_P); const float* SM = (const float*)(F.ws + WS_SM); float* YR = (float*)(F.ws + WS_YRAW);
    const int el = lane & 15, dq = lane >> 4;
    float S[16];
#pragma unroll
    for (int i = 0; i < 16; ++i) S[i] = 0.f;
    const float* cw = inptr(F, I_GCW) + (size_t)l * 4 * 1152; const int chq = hh * 64 + lane, chk = 384 + chq, chv = 768 + chq;
    float wq[4], wk[4], wv[4];
#pragma unroll
    for (int j = 0; j < 4; ++j) { wq[j] = cw[j * 1152 + chq]; wk[j] = cw[j * 1152 + chk]; wv[j] = cw[j * 1152 + chv]; }
    float q1 = 0, q2 = 0, q3 = 0, k1 = 0, k2 = 0, k3 = 0, v1 = 0, v2 = 0, v3 = 0;
    for (int t0 = 0; t0 < SEQ; t0 += TB) {
        float xq[TB], xk[TB], xv[TB], gg[TB], bb[TB];
#pragma unroll
        for (int i = 0; i < TB; ++i) { const size_t row = (size_t)b * SEQ + t0 + i; const bf16* pr = P + row * NP + PC_GQKV;
            xq[i] = bf2f(pr[chq]); xk[i] = bf2f(pr[chk]); xv[i] = bf2f(pr[chv]); gg[i] = SM[row * 18 + hh]; bb[i] = SM[row * 18 + 6 + hh]; }
#pragma unroll
        for (int i = 0; i < TB; ++i) {
            const size_t row = (size_t)b * SEQ + t0 + i;
            float cq_ = wq[0] * q3 + wq[1] * q2 + wq[2] * q1 + wq[3] * xq[i]; q3 = q2; q2 = q1; q1 = xq[i];
            float ck_ = wk[0] * k3 + wk[1] * k2 + wk[2] * k1 + wk[3] * xk[i]; k3 = k2; k2 = k1; k1 = xk[i];
            float cv_ = wv[0] * v3 + wv[1] * v2 + wv[2] * v1 + wv[3] * xv[i]; v3 = v2; v2 = v1; v1 = xv[i];
            cq_ = silu_f(cq_); ck_ = silu_f(ck_); cv_ = silu_f(cv_);
            const float qn = cq_ * rsqrtf(wave_sum(cq_ * cq_) + EPS) * 0.125f, kn = ck_ * rsqrtf(wave_sum(ck_ * ck_) + EPS);
            wl[lane] = qn; wl[64 + lane] = kn; wl[128 + lane] = cv_;
            LDS_WAIT();
            float kd[16], qd[16];
#pragma unroll
            for (int j = 0; j < 4; ++j) { const v4f a = *(const LAS v4f*)(wl + 64 + 16 * dq + 4 * j), c = *(const LAS v4f*)(wl + 16 * dq + 4 * j);
                kd[4 * j] = a.x; kd[4 * j + 1] = a.y; kd[4 * j + 2] = a.z; kd[4 * j + 3] = a.w; qd[4 * j] = c.x; qd[4 * j + 1] = c.y; qd[4 * j + 2] = c.z; qd[4 * j + 3] = c.w; }
            const float ve = wl[128 + 16 * cq + el];
            LDS_WAIT();
            const float a = __expf(gg[i]);
            float ks = 0.f;
#pragma unroll
            for (int j = 0; j < 16; ++j) ks += kd[j] * S[j];
            ks += SHX(ks, 16); ks += SHX(ks, 32);
            const float vn = bb[i] * (ve - a * ks);
            float o = 0.f;
#pragma unroll
            for (int j = 0; j < 16; ++j) { S[j] = a * S[j] + kd[j] * vn; o += qd[j] * S[j]; }
            o += SHX(o, 16); o += SHX(o, 32);
            if (dq == 0) YR[row * DM + 256 + hh * 64 + 16 * cq + el] = o;
        }
    }
}
__device__ __forceinline__ void ssd_naive(Ctx& F, int l, int b, int hh, int pq, LAS float* wl, int lane) {
    const int LN = lane;
    const bf16* P = (const bf16*)(F.ws + WS_P); const float* SM = (const float*)(F.ws + WS_SM); float* YR = (float*)(F.ws + WS_YRAW);
    const int pl = lane & 15, nq = lane >> 4, gi = hh / 3, p = 16 * pq + pl;
    float hs[32];
#pragma unroll
    for (int i = 0; i < 32; ++i) hs[i] = 0.f;
    const float* cw = inptr(F, I_SCW) + (size_t)l * 4 * 896; const float* cb = inptr(F, I_SCB) + (size_t)l * 896;
    const int cB0 = 384 + gi * 128 + lane, cB1 = cB0 + 64, cC0 = 640 + gi * 128 + lane, cC1 = cC0 + 64, cX = hh * 64 + p;
    float wB0[4], wB1[4], wC0[4], wC1[4], wX[4];
#pragma unroll
    for (int j = 0; j < 4; ++j) { wB0[j] = cw[j * 896 + cB0]; wB1[j] = cw[j * 896 + cB1]; wC0[j] = cw[j * 896 + cC0]; wC1[j] = cw[j * 896 + cC1]; wX[j] = cw[j * 896 + cX]; }
    const float bB0 = cb[cB0], bB1 = cb[cB1], bC0 = cb[cC0], bC1 = cb[cC1], bX = cb[cX];
    const float Aneg = -expf(inptr(F, I_SALOG)[l * 6 + hh]), Dsk = inptr(F, I_SD)[l * 6 + hh];
    float hB0[3] = {0, 0, 0}, hB1[3] = {0, 0, 0}, hC0[3] = {0, 0, 0}, hC1[3] = {0, 0, 0}, hX[3] = {0, 0, 0};
    for (int t0 = 0; t0 < SEQ; t0 += TB) {
        float xB0[TB], xB1[TB], xC0[TB], xC1[TB], xX[TB], xZ[TB], dts[TB];
#pragma unroll
        for (int i = 0; i < TB; ++i) { const size_t row = (size_t)b * SEQ + t0 + i; const bf16* pr = P + row * NP;
            xB0[i] = bf2f(pr[PC_SX + cB0]); xB1[i] = bf2f(pr[PC_SX + cB1]); xC0[i] = bf2f(pr[PC_SX + cC0]); xC1[i] = bf2f(pr[PC_SX + cC1]); xX[i] = bf2f(pr[PC_SX + cX]);
            xZ[i] = bf2f(pr[PC_SZ + hh * 64 + p]); dts[i] = SM[row * 18 + 12 + hh]; }
#pragma unroll
        for (int i = 0; i < TB; ++i) {
            const size_t row = (size_t)b * SEQ + t0 + i;
#define CONV1(w, hst, x, bias) ({ float _y = w[0] * hst[2] + w[1] * hst[1] + w[2] * hst[0] + w[3] * (x) + (bias); hst[2] = hst[1]; hst[1] = hst[0]; hst[0] = (x); silu_f(_y); })
            const float vB0 = CONV1(wB0, hB0, xB0[i], bB0), vB1 = CONV1(wB1, hB1, xB1[i], bB1), vC0 = CONV1(wC0, hC0, xC0[i], bC0), vC1 = CONV1(wC1, hC1, xC1[i], bC1), vX = CONV1(wX, hX, xX[i], bX);
#undef CONV1
            wl[lane] = vB0; wl[64 + lane] = vB1; wl[128 + lane] = vC0; wl[192 + lane] = vC1;
            LDS_WAIT();
            float Bv[32], Cv[32];
#pragma unroll
            for (int j = 0; j < 8; ++j) { const v4f a = *(const LAS v4f*)(wl + 32 * nq + 4 * j), c = *(const LAS v4f*)(wl + 128 + 32 * nq + 4 * j);
                Bv[4 * j] = a.x; Bv[4 * j + 1] = a.y; Bv[4 * j + 2] = a.z; Bv[4 * j + 3] = a.w; Cv[4 * j] = c.x; Cv[4 * j + 1] = c.y; Cv[4 * j + 2] = c.z; Cv[4 * j + 3] = c.w; }
            LDS_WAIT();
            const float dt = dts[i], dA = __expf(dt * Aneg), xdt = vX * dt;
            float y = 0.f;
#pragma unroll
            for (int j = 0; j < 32; ++j) { hs[j] = dA * hs[j] + xdt * Bv[j]; y += Cv[j] * hs[j]; }
            y += SHX(y, 16); y += SHX(y, 32);
            y = (y + Dsk * vX) * silu_f(xZ[i]);
            if (nq == 0) YR[row * DM + 640 + hh * 64 + p] = y;
        }
    }
}
__device__ __forceinline__ void s5_naive(Ctx& F, int l, int b, int g, int lane) {
    const int LN = lane;
    const bf16* P = (const bf16*)(F.ws + WS_P); float* YR = (float*)(F.ws + WS_YRAW);
    const int gp = (l * 16 + g) * 64 + lane;
    const float are = inptr(F, I_S5ARE)[gp], aim = inptr(F, I_S5AIM)[gp], step = expf(inptr(F, I_S5LDT)[l * 16 + g]);
    const float mag = expf(are * step); float sn, cs; sincosf(aim * step, &sn, &cs);
    const float lbr = mag * cs, lbi = mag * sn;
    const float nr = lbr - 1.f, ni = lbi, den = are * are + aim * aim;
    const float fr = (nr * are + ni * aim) / den, fi = (ni * are - nr * aim) / den;
    float Br[16], Bi[16], Cr[16], Ci[16], Dk[16];
#pragma unroll
    for (int c = 0; c < 16; ++c) { const float br = inptr(F, I_S5BRE)[(size_t)gp * 16 + c], bi = inptr(F, I_S5BIM)[(size_t)gp * 16 + c];
        Br[c] = fr * br - fi * bi; Bi[c] = fr * bi + fi * br;
        Cr[c] = inptr(F, I_S5CRE)[((size_t)(l * 16 + g) * 16 + c) * 64 + lane]; Ci[c] = inptr(F, I_S5CIM)[((size_t)(l * 16 + g) * 16 + c) * 64 + lane];
        Dk[c] = inptr(F, I_S5D)[l * 256 + g * 16 + c]; }
    float sr = 0.f, si = 0.f;
    for (int t0 = 0; t0 < SEQ; t0 += TB) {
        v4u ua[TB], ub[TB];
#pragma unroll
        for (int i = 0; i < TB; ++i) { const size_t row = (size_t)b * SEQ + t0 + i; const v4u* pr = (const v4u*)(P + row * NP + PC_S5 + g * 16); ua[i] = pr[0]; ub[i] = pr[1]; }
#pragma unroll
        for (int i = 0; i < TB; ++i) {
            const size_t row = (size_t)b * SEQ + t0 + i;
            float u[16];
            u[0] = bf2f(ua[i].x & 0xffffu); u[1] = bf2f(ua[i].x >> 16); u[2] = bf2f(ua[i].y & 0xffffu); u[3] = bf2f(ua[i].y >> 16);
            u[4] = bf2f(ua[i].z & 0xffffu); u[5] = bf2f(ua[i].z >> 16); u[6] = bf2f(ua[i].w & 0xffffu); u[7] = bf2f(ua[i].w >> 16);
            u[8] = bf2f(ub[i].x & 0xffffu); u[9] = bf2f(ub[i].x >> 16); u[10] = bf2f(ub[i].y & 0xffffu); u[11] = bf2f(ub[i].y >> 16);
            u[12] = bf2f(ub[i].z & 0xffffu); u[13] = bf2f(ub[i].z >> 16); u[14] = bf2f(ub[i].w & 0xffffu); u[15] = bf2f(ub[i].w >> 16);
            float bur = 0.f, bui = 0.f;
#pragma unroll
            for (int c = 0; c < 16; ++c) { bur += Br[c] * u[c]; bui += Bi[c] * u[c]; }
            const float nsr = lbr * sr - lbi * si + bur, nsi = lbr * si + lbi * sr + bui; sr = nsr; si = nsi;
            float mine = 0.f;
#pragma unroll
            for (int c = 0; c < 16; ++c) { float y = wave_sum(Cr[c] * sr - Ci[c] * si) + Dk[c] * u[c]; mine = (lane == c) ? y : mine; }
            if (lane < 16) YR[row * 256 + g * 16 + lane] = gelu_tanh(mine);
        }
    }
}
__device__ __forceinline__ void ph_m2(const Ctx& F0, int l) {
    Ctx F = launder(F0);
    const int u = F.wave * F.G + F.bid;
    LAS float* wl = (LAS float*)(F.lds + F.wave * 4096);
    if (u < 128) s5_naive(F, l, u / 16, u % 16, F.lane);
}


__device__ __forceinline__ bf16x8 ldsfrag(LAS unsigned char* base, int row, int stride, int kb) { return *(const LAS bf16x8*)(base + row * stride + kb); }
__device__ __forceinline__ float wave_incl_scan(float v, int lane) {
#pragma unroll
    for (int o = 1; o < 64; o <<= 1) { const float t = __int_as_float(__builtin_amdgcn_ds_bpermute((lane >= o ? lane - o : lane) << 2, __float_as_int(v))); if (lane >= o) v += t; }
    return v;
}
__device__ __forceinline__ float lane63(float v) { return __int_as_float(__builtin_amdgcn_readlane(__float_as_int(v), 63)); }
__device__ __forceinline__ void conv8x8(const bf16* P, size_t rowbase, int t0, bool has_prev, int pcol, const float* cw, int cstride, const float* cb, float (&out)[8][8]) {
    float xf[11][8];
#pragma unroll
    for (int i = 0; i < 11; ++i) {
        v4u v = zero4u();
        if (has_prev || t0 + i >= 3) v = *(const v4u*)(P + (rowbase + t0 + i - 3) * NP + pcol);
        xf[i][0] = bf2f(v.x & 0xffffu); xf[i][1] = bf2f(v.x >> 16); xf[i][2] = bf2f(v.y & 0xffffu); xf[i][3] = bf2f(v.y >> 16);
        xf[i][4] = bf2f(v.z & 0xffffu); xf[i][5] = bf2f(v.z >> 16); xf[i][6] = bf2f(v.w & 0xffffu); xf[i][7] = bf2f(v.w >> 16);
    }
    float w[4][8], bs[8];
#pragma unroll
    for (int j = 0; j < 4; ++j) { const v4f a = *(const v4f*)(cw + j * cstride), c = *(const v4f*)(cw + j * cstride + 4);
        w[j][0] = a.x; w[j][1] = a.y; w[j][2] = a.z; w[j][3] = a.w; w[j][4] = c.x; w[j][5] = c.y; w[j][6] = c.z; w[j][7] = c.w; }
    if (cb) { const v4f a = *(const v4f*)cb, c = *(const v4f*)(cb + 4); bs[0] = a.x; bs[1] = a.y; bs[2] = a.z; bs[3] = a.w; bs[4] = c.x; bs[5] = c.y; bs[6] = c.z; bs[7] = c.w; }
    else {
#pragma unroll
        for (int c = 0; c < 8; ++c) bs[c] = 0.f; }
#pragma unroll
    for (int t = 0; t < 8; ++t)
#pragma unroll
        for (int c = 0; c < 8; ++c) out[t][c] = silu_f(w[0][c] * xf[t][c] + w[1][c] * xf[t + 1][c] + w[2][c] * xf[t + 2][c] + w[3][c] * xf[t + 3][c] + bs[c]);
}
constexpr int SS_XST = 0, SS_XST_S = 144;
constexpr int SS_BROW = 27648, SS_ROW_S = 272;
constexpr int SS_CROW = 45056;
constexpr int SS_BT = 27648, SS_BT_S = 144;
constexpr int SS_MH = 62464, SS_MH_S = 144;
constexpr int SS_Z = 90112, SS_Z_S = 400;
constexpr int SS_F = 115712;
__device__ __forceinline__ void ssd_s1_unit(Ctx& F, int l, int unit) {
    const int b = unit >> 7, n = (unit >> 1) & 63, g = unit & 1; const size_t rowbase = (size_t)b * SEQ + n * 64;
    const bf16* P = (const bf16*)(F.ws + WS_P); const float* SM = (const float*)(F.ws + WS_SM);
    bf16* CS = (bf16*)(F.ws + WS_CS2); float* CD = (float*)(F.ws + WS_CD);
    LAS float* ff = (LAS float*)(F.lds + SS_F);
    if (F.wave < 3) { const int hh = 3 * g + F.wave; const float dt = SM[(rowbase + F.lane) * 18 + 12 + hh], An = -__expf(inptr(F, I_SALOG)[l * 6 + hh]);
        const float acs = wave_incl_scan(dt * An, F.lane), last = lane63(acs);
        ff[F.wave * 64 + F.lane] = acs; ff[384 + F.wave * 64 + F.lane] = dt * __expf(last - acs);
        if (F.lane == 63) CD[(b * 6 + hh) * 64 + n] = __expf(last); }
    __syncthreads();
    if (F.tid < 320) { const int cg = F.tid >> 3, t0 = (F.tid & 7) * 8; float o[8][8];
        const float* cw = inptr(F, I_SCW) + (size_t)l * 4 * 896; const float* cb = inptr(F, I_SCB) + (size_t)l * 896;
        if (cg < 24) { const int ch = g * 192 + cg * 8, hl = cg >> 3;
            conv8x8(P, rowbase, t0, n > 0, PC_SX + ch, cw + ch, 896, cb + ch, o);
#pragma unroll
            for (int c = 0; c < 8; ++c) { v4u w; const LAS float* wv = ff + 384 + hl * 64 + t0;
                w.x = pk2(o[0][c] * wv[0], o[1][c] * wv[1]); w.y = pk2(o[2][c] * wv[2], o[3][c] * wv[3]); w.z = pk2(o[4][c] * wv[4], o[5][c] * wv[5]); w.w = pk2(o[6][c] * wv[6], o[7][c] * wv[7]);
                *(LAS v4u*)(F.lds + SS_XST + (cg * 8 + c) * SS_XST_S + t0 * 2) = w; } }
        else { const int d0 = (cg - 24) * 8, ch = 384 + g * 128 + d0;
            conv8x8(P, rowbase, t0, n > 0, PC_SX + ch, cw + ch, 896, cb + ch, o);
#pragma unroll
            for (int c = 0; c < 8; ++c) { v4u w; w.x = pk2(o[0][c], o[1][c]); w.y = pk2(o[2][c], o[3][c]); w.z = pk2(o[4][c], o[5][c]); w.w = pk2(o[6][c], o[7][c]);
                *(LAS v4u*)(F.lds + SS_BT + (d0 + c) * SS_BT_S + t0 * 2) = w; } }
    }
    __syncthreads();
    const int fr = F.lane & 15, fq = F.lane >> 4;
    for (int ti = F.wave * 12; ti < F.wave * 12 + 12; ++ti) {
        const int h = ti >> 5, dtl = (ti >> 2) & 7, pt = ti & 3;
        pg8::f32x4 acc = zero4(); bf16x8 fa_[2], fb_[2];
#pragma unroll
        for (int ks = 0; ks < 2; ++ks) { fa_[ks] = ldsfrag(F.lds + SS_BT, 16 * dtl + fr, SS_BT_S, 64 * ks + 16 * fq); fb_[ks] = ldsfrag(F.lds + SS_XST, 64 * h + 16 * pt + fr, SS_XST_S, 64 * ks + 16 * fq); }
#pragma unroll
        for (int ks = 0; ks < 2; ++ks) acc = MFMA16(fa_[ks], fb_[ks], acc);
        MFMA_SETTLE(acc);
        v2u w; w.x = pk2(acc[0], acc[1]); w.y = pk2(acc[2], acc[3]);
        *(v2u*)(CS + ((size_t)((b * 6 + 3 * g + h) * 64 + n) * 64 + 16 * pt + fr) * 128 + 16 * dtl + 4 * fq) = w;
    }
    __syncthreads();
}
__device__ __forceinline__ void ssd_s2(Ctx& F) {
    bf16* CS = (bf16*)(F.ws + WS_CS2); const float* CD = (const float*)(F.ws + WS_CD);
    for (int task = F.bid * 512 + F.tid; task < 48 * 1024; task += F.G * 512) {
        const int bh = task >> 10, e = (task & 1023) * 8; float s[8];
#pragma unroll
        for (int i = 0; i < 8; ++i) s[i] = 0.f;
        for (int n0 = 0; n0 < 64; n0 += 8) { v4u v[8]; float cd[8];
#pragma unroll
            for (int i = 0; i < 8; ++i) { v[i] = *(const v4u*)(CS + (size_t)(bh * 64 + n0 + i) * 8192 + e); cd[i] = CD[bh * 64 + n0 + i]; }
#pragma unroll
            for (int i = 0; i < 8; ++i) { v4u o; o.x = pk2(s[0], s[1]); o.y = pk2(s[2], s[3]); o.z = pk2(s[4], s[5]); o.w = pk2(s[6], s[7]);
                *(v4u*)(CS + (size_t)(bh * 64 + n0 + i) * 8192 + e) = o;
                s[0] = cd[i] * s[0] + bf2f(v[i].x & 0xffffu); s[1] = cd[i] * s[1] + bf2f(v[i].x >> 16); s[2] = cd[i] * s[2] + bf2f(v[i].y & 0xffffu); s[3] = cd[i] * s[3] + bf2f(v[i].y >> 16);
                s[4] = cd[i] * s[4] + bf2f(v[i].z & 0xffffu); s[5] = cd[i] * s[5] + bf2f(v[i].z >> 16); s[6] = cd[i] * s[6] + bf2f(v[i].w & 0xffffu); s[7] = cd[i] * s[7] + bf2f(v[i].w >> 16); }
        }
    }
}
__device__ __forceinline__ void ssd_s3_unit(Ctx& F, int l, int unit) {
    const int LN = F.lane;
    const int b = unit >> 7, n = (unit >> 1) & 63, g = unit & 1; const size_t rowbase = (size_t)b * SEQ + n * 64;
    const bf16* P = (const bf16*)(F.ws + WS_P); const float* SM = (const float*)(F.ws + WS_SM);
    const bf16* CS = (const bf16*)(F.ws + WS_CS2); bf16* Y = (bf16*)(F.ws + WS_Y);
    LAS float* ff = (LAS float*)(F.lds + SS_F);
    const int fr = F.lane & 15, fq = F.lane >> 4;
    if (F.wave < 3) { const int hh = 3 * g + F.wave; const float dt = SM[(rowbase + F.lane) * 18 + 12 + hh], An = -__expf(inptr(F, I_SALOG)[l * 6 + hh]);
        ff[F.wave * 64 + F.lane] = wave_incl_scan(dt * An, F.lane); ff[192 + F.wave * 64 + F.lane] = dt; }
    if (F.tid < 448) { const int cg = F.tid >> 3, t0 = (F.tid & 7) * 8; float o[8][8];
        const float* cw = inptr(F, I_SCW) + (size_t)l * 4 * 896; const float* cb = inptr(F, I_SCB) + (size_t)l * 896;
        if (cg < 24) { const int ch = g * 192 + cg * 8;
            conv8x8(P, rowbase, t0, n > 0, PC_SX + ch, cw + ch, 896, cb + ch, o);
#pragma unroll
            for (int c = 0; c < 8; ++c) { v4u w; w.x = pk2(o[0][c], o[1][c]); w.y = pk2(o[2][c], o[3][c]); w.z = pk2(o[4][c], o[5][c]); w.w = pk2(o[6][c], o[7][c]);
                *(LAS v4u*)(F.lds + SS_XST + (cg * 8 + c) * SS_XST_S + t0 * 2) = w; } }
        else { const int isC = cg >= 40, d0 = (cg - (isC ? 40 : 24)) * 8, ch = (isC ? 640 : 384) + g * 128 + d0;
            conv8x8(P, rowbase, t0, n > 0, PC_SX + ch, cw + ch, 896, cb + ch, o);
#pragma unroll
            for (int t = 0; t < 8; ++t) { v4u w; w.x = pk2(o[t][0], o[t][1]); w.y = pk2(o[t][2], o[t][3]); w.z = pk2(o[t][4], o[t][5]); w.w = pk2(o[t][6], o[t][7]);
                *(LAS v4u*)(F.lds + (isC ? SS_CROW : SS_BROW) + (t0 + t) * SS_ROW_S + d0 * 2) = w; } }
    }
    for (int c = F.tid; c < 64 * 24; c += 512) { const int t = c / 24, c8 = c % 24;
        *(LAS v4u*)(F.lds + SS_Z + t * SS_Z_S + c8 * 16) = *(const v4u*)(P + (rowbase + t) * NP + PC_SZ + g * 192 + c8 * 8); }
    __syncthreads();
    for (int ti = F.wave; ti < 10; ti += 8) {
        int lt = 0, mt = ti; while (mt > lt) { mt -= lt + 1; ++lt; }
        pg8::f32x4 acc = zero4(); bf16x8 fa_[4], fb_[4];
#pragma unroll
        for (int ks = 0; ks < 4; ++ks) { fa_[ks] = ldsfrag(F.lds + SS_BROW, 16 * mt + fr, SS_ROW_S, 64 * ks + 16 * fq); fb_[ks] = ldsfrag(F.lds + SS_CROW, 16 * lt + fr, SS_ROW_S, 64 * ks + 16 * fq); }
#pragma unroll
        for (int ks = 0; ks < 4; ++ks) acc = MFMA16(fa_[ks], fb_[ks], acc);
        MFMA_SETTLE(acc);
        const int lrow = 16 * lt + fr, m0 = 16 * mt + 4 * fq;
#pragma unroll
        for (int h = 0; h < 3; ++h) { const float al = ff[h * 64 + lrow], Dh = inptr(F, I_SD)[l * 6 + 3 * g + h]; float mv[4];
#pragma unroll
            for (int r = 0; r < 4; ++r) { const int m = m0 + r; mv[r] = m <= lrow ? acc[r] * __expf(al - ff[h * 64 + m]) * ff[192 + h * 64 + m] + (m == lrow ? Dh : 0.f) : 0.f; }
            v2u w; w.x = pk2(mv[0], mv[1]); w.y = pk2(mv[2], mv[3]);
            *(LAS v2u*)(F.lds + SS_MH + h * (64 * SS_MH_S) + lrow * SS_MH_S + m0 * 2) = w;
            if (lt == mt && (lt & 1) == 0) *(LAS v2u*)(F.lds + SS_MH + h * (64 * SS_MH_S) + lrow * SS_MH_S + (m0 + 16) * 2) = zero2u(); }
    }
    __syncthreads();
    const int lt = F.wave & 3, ph = F.wave >> 2, tokl = 16 * lt + fr;
    float yv[6][4]; float ss = 0.f;
#pragma unroll
    for (int i = 0; i < 6; ++i) { const int pt = ph * 6 + i, h = pt >> 2;
        pg8::f32x4 ad = zero4(), ao = ad; bf16x8 xfr[2], mfr[2];
#pragma unroll
        for (int ks = 0; ks < 2; ++ks) { xfr[ks] = ldsfrag(F.lds + SS_XST, 16 * pt + fr, SS_XST_S, 64 * ks + 16 * fq); mfr[ks] = ldsfrag(F.lds + SS_MH + h * (64 * SS_MH_S), tokl, SS_MH_S, 64 * ks + 16 * fq); }
        const bf16* sp = CS + ((size_t)((b * 6 + 3 * g + h) * 64 + n) * 64 + 16 * (pt & 3) + fr) * 128 + 8 * fq;
        bf16x8 sfr[4], cfr[4];
#pragma unroll
        for (int ks = 0; ks < 4; ++ks) { sfr[ks] = *(const bf16x8*)(sp + 32 * ks); cfr[ks] = ldsfrag(F.lds + SS_CROW, tokl, SS_ROW_S, 64 * ks + 16 * fq); }
#pragma unroll
        for (int ks = 0; ks < 2; ++ks) if (2 * ks <= lt) ad = MFMA16(xfr[ks], mfr[ks], ad);
#pragma unroll
        for (int ks = 0; ks < 4; ++ks) ao = MFMA16(sfr[ks], cfr[ks], ao);
        MFMA_SETTLE(ad); MFMA_SETTLE(ao);
        const float ea = __expf(ff[h * 64 + tokl]);
        const v2u zz = *(const LAS v2u*)(F.lds + SS_Z + tokl * SS_Z_S + (16 * pt + 4 * fq) * 2);
        const float z0 = bf2f(zz.x & 0xffffu), z1 = bf2f(zz.x >> 16), z2 = bf2f(zz.y & 0xffffu), z3 = bf2f(zz.y >> 16);
        yv[i][0] = (ad[0] + ea * ao[0]) * silu_f(z0); yv[i][1] = (ad[1] + ea * ao[1]) * silu_f(z1); yv[i][2] = (ad[2] + ea * ao[2]) * silu_f(z2); yv[i][3] = (ad[3] + ea * ao[3]) * silu_f(z3);
        ss += (yv[i][0] * yv[i][0] + yv[i][1] * yv[i][1]) + (yv[i][2] * yv[i][2] + yv[i][3] * yv[i][3]);
    }
    ss += SHX(ss, 16); ss += SHX(ss, 32);
    if (fq == 0) ff[576 + ph * 64 + tokl] = ss;
    __syncthreads();
    const float rs = rsqrtf((ff[576 + tokl] + ff[576 + 64 + tokl]) * (1.f / 192.f) + EPS);
    const float* nw = inptr(F, I_SNORM) + l * 384 + g * 192;
#pragma unroll
    for (int i = 0; i < 6; ++i) { const int pt = ph * 6 + i; const v4f wv = *(const v4f*)(nw + 16 * pt + 4 * fq);
        v2u w; w.x = pk2(yv[i][0] * rs * wv.x, yv[i][1] * rs * wv.y); w.y = pk2(yv[i][2] * rs * wv.z, yv[i][3] * rs * wv.w);
        *(v2u*)(Y + (rowbase + tokl) * DM + 640 + g * 192 + 16 * pt + 4 * fq) = w; }
    __syncthreads();
}
__device__ __forceinline__ void ph_s1(const Ctx& F0, int l) { Ctx F = launder(F0); for (int u = F.bid; u < 1024; u += F.G) ssd_s1_unit(F, l, u); }
__device__ __forceinline__ void ph_s2(const Ctx& F0) { Ctx F = launder(F0); ssd_s2(F); }
__device__ __forceinline__ void ph_s3(const Ctx& F0, int l) { Ctx F = launder(F0); for (int u = F.bid; u < 1024; u += F.G) ssd_s3_unit(F, l, u); }


constexpr int GD_KN = 0, GD_QN = 9216, GD_KDT = 18432, GD_RV = 27648, GD_RK = 36864, GD_AT = 46080, GD_NL = 55296, GD_LD = 64512, GD_DB = GD_KN, GD_F = 72704, GD_HALF = 73728, GD_S = 144;
constexpr size_t WS_GAN = 472 * MiB, WS_GBN = 496 * MiB, WS_GQE = 520 * MiB, WS_GO1 = 544 * MiB, WS_GSP = 568 * MiB;
__device__ __forceinline__ void decode_lower(int ti, int& lt, int& mt) { lt = 0; mt = ti; while (mt > lt) { mt -= lt + 1; ++lt; } }
__device__ __forceinline__ void gdn_g1_pair(const Ctx& F0, int l, int pair) {
    Ctx F = F0; F.lane = fresh_lane(); F.tid = F.wave * 64 + F.lane;
    int LN = F.lane;
    const int half = F.wave >> 2, uw = F.wave & 3, unit = 2 * pair + half, hh = unit % 6, bn = unit / 6, b = bn >> 6, n = bn & 63;
    const size_t rowbase = (size_t)b * SEQ + n * 64;
    const bf16* P = (const bf16*)(F.ws + WS_P); const float* SM = (const float*)(F.ws + WS_SM);
    LAS unsigned char* lb = F.lds + half * GD_HALF; LAS float* fg = (LAS float*)(lb + GD_F);
    int fr = F.lane & 15, fq = F.lane >> 4;
    float o[8][8]; const int seg = F.lane & 7, cg = F.lane >> 3, t0 = seg * 8;
    if (uw < 3) {
        const int ch = uw * 384 + hh * 64 + cg * 8;
        conv8x8(P, rowbase, t0, n > 0, PC_GQKV + ch, inptr(F, I_GCW) + (size_t)l * 4 * 1152 + ch, 1152, nullptr, o);
        if (uw < 2) {
#pragma unroll
            for (int t = 0; t < 8; ++t) { float ss = 0.f;
#pragma unroll
                for (int c = 0; c < 8; ++c) ss += o[t][c] * o[t][c];
                ss += SHX(ss, 8); ss += SHX(ss, 16); ss += SHX(ss, 32);
                const float sc = rsqrtf(ss + EPS) * (uw == 0 ? 0.125f : 1.f);
#pragma unroll
                for (int c = 0; c < 8; ++c) o[t][c] *= sc; }
        }
    } else {
        const float g = SM[(rowbase + F.lane) * 18 + hh], be = SM[(rowbase + F.lane) * 18 + 6 + hh];
        const float gc = wave_incl_scan(g, F.lane);
        fg[F.lane] = gc; fg[64 + F.lane] = be;
    }
    __syncthreads();
    unsigned tch0 = 0u, tch1 = 0u;
    { const int np = pair + F.G;
      if (np < 1536) { const int unit2 = 2 * np + half, hh2 = unit2 % 6, bn2 = unit2 / 6; const size_t rb2 = (size_t)(bn2 >> 6) * SEQ + (size_t)(bn2 & 63) * 64;
          if (uw < 3) { const int ch2 = uw * 384 + hh2 * 64; const size_t r_ = (rb2 + F.lane >= 3) ? rb2 + F.lane - 3 : 0;
              tch0 = *(const unsigned*)(P + r_ * NP + PC_GQKV + ch2);
              if (F.lane < 3) tch1 = *(const unsigned*)(P + (rb2 + 61 + F.lane) * NP + PC_GQKV + ch2); }
          else if (F.lane < 37) tch0 = *(const unsigned*)((const unsigned char*)(SM + rb2 * 18) + F.lane * 128); } }
    if (uw == 0) {
#pragma unroll
        for (int t = 0; t < 8; ++t) { v4u w; w.x = pk2(o[t][0], o[t][1]); w.y = pk2(o[t][2], o[t][3]); w.z = pk2(o[t][4], o[t][5]); w.w = pk2(o[t][6], o[t][7]);
            *(LAS v4u*)(lb + GD_QN + (t0 + t) * GD_S + cg * 16) = w; }
    } else if (uw == 1) {
        const float gl = fg[63]; float fk[8], fw[8];
#pragma unroll
        for (int t = 0; t < 8; ++t) { const float gc = fg[t0 + t]; fk[t] = __expf(gl - gc); fw[t] = fg[64 + t0 + t] * __expf(gc); }
#pragma unroll
        for (int t = 0; t < 8; ++t) { v4u w; w.x = pk2(o[t][0], o[t][1]); w.y = pk2(o[t][2], o[t][3]); w.z = pk2(o[t][4], o[t][5]); w.w = pk2(o[t][6], o[t][7]);
            *(LAS v4u*)(lb + GD_KN + (t0 + t) * GD_S + cg * 16) = w; }
#pragma unroll
        for (int c = 0; c < 8; ++c) { v4u w;
            w.x = pk2(o[0][c] * fk[0], o[1][c] * fk[1]); w.y = pk2(o[2][c] * fk[2], o[3][c] * fk[3]); w.z = pk2(o[4][c] * fk[4], o[5][c] * fk[5]); w.w = pk2(o[6][c] * fk[6], o[7][c] * fk[7]);
            *(LAS v4u*)(lb + GD_KDT + (cg * 8 + c) * GD_S + t0 * 2) = w;
            w.x = pk2(-o[0][c] * fw[0], -o[1][c] * fw[1]); w.y = pk2(-o[2][c] * fw[2], -o[3][c] * fw[3]); w.z = pk2(-o[4][c] * fw[4], -o[5][c] * fw[5]); w.w = pk2(-o[6][c] * fw[6], -o[7][c] * fw[7]);
            *(LAS v4u*)(lb + GD_RK + (cg * 8 + c) * GD_S + t0 * 2) = w; }
    } else if (uw == 2) {
        float fb[8];
#pragma unroll
        for (int t = 0; t < 8; ++t) fb[t] = fg[64 + t0 + t];
#pragma unroll
        for (int c = 0; c < 8; ++c) { v4u w;
            w.x = pk2(o[0][c] * fb[0], o[1][c] * fb[1]); w.y = pk2(o[2][c] * fb[2], o[3][c] * fb[3]); w.z = pk2(o[4][c] * fb[4], o[5][c] * fb[5]); w.w = pk2(o[6][c] * fb[6], o[7][c] * fb[7]);
            *(LAS v4u*)(lb + GD_RV + (cg * 8 + c) * GD_S + t0 * 2) = w; }
    }
    __syncthreads();
    F.lane = fresh_lane(); LN = F.lane; fr = F.lane & 15; fq = F.lane >> 4;
    for (int ti = uw; ti < 20; ti += 4) {
        const int kind = ti >= 10; int lt, mt; decode_lower(ti - 10 * kind, lt, mt);
        pg8::f32x4 acc = zero4(); bf16x8 fa_[2], fb_[2];
#pragma unroll
        for (int ks = 0; ks < 2; ++ks) { fa_[ks] = ldsfrag(lb + GD_KN, 16 * mt + fr, GD_S, 64 * ks + 16 * fq); fb_[ks] = ldsfrag(lb + (kind ? GD_QN : GD_KN), 16 * lt + fr, GD_S, 64 * ks + 16 * fq); }
#pragma unroll
        for (int ks = 0; ks < 2; ++ks) acc = MFMA16(fa_[ks], fb_[ks], acc);
        MFMA_SETTLE(acc);
        const int col = 16 * lt + fr, r0 = 16 * mt + 4 * fq; const float gcc = fg[col];
        if (kind == 0) { const float bc = fg[64 + col];
            const float l0 = (r0 + 0 < col) ? bc * acc[0] * __expf(gcc - fg[r0 + 0]) : 0.f, l1 = (r0 + 1 < col) ? bc * acc[1] * __expf(gcc - fg[r0 + 1]) : 0.f,
                        l2 = (r0 + 2 < col) ? bc * acc[2] * __expf(gcc - fg[r0 + 2]) : 0.f, l3 = (r0 + 3 < col) ? bc * acc[3] * __expf(gcc - fg[r0 + 3]) : 0.f;
            if (lt != mt) { v2u w; w.x = pk2(-l0, -l1); w.y = pk2(-l2, -l3); *(LAS v2u*)(lb + GD_NL + col * GD_S + r0 * 2) = w; }
            else { *(LAS v4f*)(lb + GD_LD + lt * 1280 + fr * 80 + fq * 16) = (v4f){l0, l1, l2, l3}; *(LAS v2u*)(lb + GD_NL + col * GD_S + r0 * 2) = zero2u(); } }
        else { float a0 = (r0 + 0 <= col) ? acc[0] * __expf(gcc - fg[r0 + 0]) : 0.f, a1 = (r0 + 1 <= col) ? acc[1] * __expf(gcc - fg[r0 + 1]) : 0.f,
                     a2 = (r0 + 2 <= col) ? acc[2] * __expf(gcc - fg[r0 + 2]) : 0.f, a3 = (r0 + 3 <= col) ? acc[3] * __expf(gcc - fg[r0 + 3]) : 0.f;
            v2u w; w.x = pk2(a0, a1); w.y = pk2(a2, a3);
            *(LAS v2u*)(lb + GD_AT + col * GD_S + r0 * 2) = w;
            if (lt == mt && (lt & 1) == 0) *(LAS v2u*)(lb + GD_AT + col * GD_S + (r0 + 16) * 2) = zero2u(); }
    }
    __syncthreads();
    F.lane = fresh_lane(); LN = F.lane; fr = F.lane & 15; fq = F.lane >> 4;
    if (uw == 3) {
        const int blk = F.lane >> 4, j = F.lane & 15; float x[16];
        unsigned ldv = (unsigned)(unsigned long long)(lb + GD_LD + blk * 1280); asm volatile("" : "+v"(ldv)); LAS unsigned char* Ld = (LAS unsigned char*)(unsigned long long)ldv;
#pragma unroll
        for (int c = 0; c < 16; ++c) x[c] = (c == j) ? 1.f : 0.f;
#pragma unroll
        for (int c = 1; c < 16; ++c) { float s0 = 0.f;
#pragma unroll
            for (int mc = 0; mc <= (c - 1) / 4; ++mc) { const v4f lv = *(const LAS v4f*)(Ld + c * 80 + mc * 16); s0 += lv.x * x[4 * mc] + lv.y * x[4 * mc + 1] + lv.z * x[4 * mc + 2] + lv.w * x[4 * mc + 3]; }
            x[c] -= s0; asm volatile("" : "+v"(x[c]) :: "memory"); }
#pragma unroll
        for (int c = 0; c < 16; ++c) { *(LAS unsigned short*)(lb + GD_DB + blk * 1024 + c * 64 + j * 2) = (unsigned short)f2bf(x[c]); *(LAS unsigned short*)(lb + GD_DB + blk * 1024 + c * 64 + (16 + j) * 2) = 0; }
    }
    __syncthreads();
    F.lane = fresh_lane(); LN = F.lane; fr = F.lane & 15; fq = F.lane >> 4;
    {
        LAS unsigned char* img = lb + (uw < 2 ? GD_RV : GD_RK);
#pragma unroll
        for (int i = 0; i < 4; ++i) {
            if (i > 0) {
#pragma unroll
                for (int nt = 0; nt < 2; ++nt) { const int crow = 32 * (uw & 1) + 16 * nt + fr;
                    const v2u rr = *(const LAS v2u*)(img + crow * GD_S + (16 * i + 4 * fq) * 2);
                    pg8::f32x4 acc = (pg8::f32x4){bf2f(rr.x & 0xffffu), bf2f(rr.x >> 16), bf2f(rr.y & 0xffffu), bf2f(rr.y >> 16)};
#pragma unroll
                    for (int ks = 0; ks < (i == 3 ? 2 : 1); ++ks) acc = MFMA16(ldsfrag(lb + GD_NL, 16 * i + fr, GD_S, 64 * ks + 16 * fq), ldsfrag(img, crow, GD_S, 64 * ks + 16 * fq), acc);
                    MFMA_SETTLE(acc);
                    v2u w; w.x = pk2(acc[0], acc[1]); w.y = pk2(acc[2], acc[3]);
                    *(LAS v2u*)(img + crow * GD_S + (16 * i + 4 * fq) * 2) = w; }
                LDS_WAIT();
            }
#pragma unroll
            for (int nt = 0; nt < 2; ++nt) { const int crow = 32 * (uw & 1) + 16 * nt + fr;
                pg8::f32x4 acc = MFMA16(ldsfrag(lb + GD_DB + i * 1024, fr, 64, 16 * fq), ldsfrag(img, crow, GD_S, (16 * i + 8 * (fq & 1)) * 2), zero4());
                MFMA_SETTLE(acc);
                v2u w; w.x = pk2(acc[0], acc[1]); w.y = pk2(acc[2], acc[3]);
                *(LAS v2u*)(img + crow * GD_S + (16 * i + 4 * fq) * 2) = w; }
            LDS_WAIT();
        }
    }
    __syncthreads();
    {
        F.lane = fresh_lane(); LN = F.lane; fr = F.lane & 15; fq = F.lane >> 4;
        const int aoff = (uw == 0 || uw == 2) ? GD_RK : (uw == 1 ? GD_KDT : GD_RV), boff = uw == 0 ? GD_KDT : (uw == 1 ? GD_RV : GD_AT);
        bf16* dst = (bf16*)(F.ws + (uw == 0 ? WS_GAN : uw == 1 ? WS_GBN : uw == 2 ? WS_GQE : WS_GO1)) + (size_t)unit * 4096;
        const float gtot = __expf(fg[63]);
        for (int ct = 0; ct < 4; ++ct) { const int col = 16 * ct + fr; const float eg = __expf(fg[col]);
#pragma unroll
            for (int rt = 0; rt < 4; ++rt) { const int r0 = 16 * rt + 4 * fq;
                pg8::f32x4 acc = zero4(); bf16x8 pa_[2], pb_[2];
                if (uw == 0) { acc[0] = (r0 + 0 == col) ? gtot : 0.f; acc[1] = (r0 + 1 == col) ? gtot : 0.f; acc[2] = (r0 + 2 == col) ? gtot : 0.f; acc[3] = (r0 + 3 == col) ? gtot : 0.f; }
                if (uw == 2) { const v2u q = *(const LAS v2u*)(lb + GD_QN + col * GD_S + r0 * 2);
                    acc[0] = bf2f(q.x & 0xffffu) * eg; acc[1] = bf2f(q.x >> 16) * eg; acc[2] = bf2f(q.y & 0xffffu) * eg; acc[3] = bf2f(q.y >> 16) * eg; }
#pragma unroll
                for (int ks = 0; ks < 2; ++ks) { pa_[ks] = ldsfrag(lb + aoff, 16 * rt + fr, GD_S, 64 * ks + 16 * fq); pb_[ks] = ldsfrag(lb + boff, col, GD_S, 64 * ks + 16 * fq); }
#pragma unroll
                for (int ks = 0; ks < 2; ++ks) if (uw < 2 || 2 * ks <= ct) acc = MFMA16(pa_[ks], pb_[ks], acc);
                MFMA_SETTLE(acc);
                v2u w; w.x = pk2(acc[0], acc[1]); w.y = pk2(acc[2], acc[3]);
                *(v2u*)(dst + col * 64 + r0) = w; }
        }
    }
    __syncthreads();
    asm volatile("" :: "v"(tch0), "v"(tch1));
}
__device__ __forceinline__ void ph_g1(const Ctx& F0, int l) { Ctx F = launder(F0); for (int p = F.bid; p < 1536; p += F.G) gdn_g1_pair(F, l, p); }

__device__ __forceinline__ void gdn_g2_task(Ctx& F, int task) {
    const int cq = task & 3, bh = task >> 2, b = bh / 6, hh = bh % 6; const int fr = F.lane & 15, fq = F.lane >> 4;
    const bf16* AN = (const bf16*)(F.ws + WS_GAN); const bf16* BN = (const bf16*)(F.ws + WS_GBN); bf16* SP = (bf16*)(F.ws + WS_GSP);
    pg8::f32x4 acc[4];
#pragma unroll
    for (int i = 0; i < 4; ++i) acc[i] = zero4();
    constexpr int RD = 4;
    v2u af[RD][4][2][2], bi[RD][4];
    const size_t u0 = (size_t)(b * 64) * 6 + hh;
    const bf16* anp = AN + u0 * 4096 + fr * 64 + 4 * fq; const bf16* bnp = BN + u0 * 4096 + (16 * cq + fr) * 64 + 4 * fq; bf16* spp = SP + u0 * 4096 + (16 * cq + fr) * 64 + 4 * fq;
#define G2_LOAD(slot, n) do { _Pragma("unroll") for (int it = 0; it < 4; ++it) { bi[slot][it] = *(const v2u*)(bnp + (size_t)(n) * 6 * 4096 + 16 * it); \
        _Pragma("unroll") for (int s_ = 0; s_ < 2; ++s_) { const bf16* ap = anp + (size_t)(n) * 6 * 4096 + 16 * it * 64 + 32 * s_; af[slot][it][s_][0] = *(const v2u*)ap; af[slot][it][s_][1] = *(const v2u*)(ap + 16); } } } while (0)
#pragma unroll
    for (int k = 0; k < RD; ++k) G2_LOAD(k, k);
    for (int n0 = 0; n0 < 64; n0 += RD) {
#pragma unroll
        for (int k = 0; k < RD; ++k) {
            const int n = n0 + k;
            unsigned pk[4][2];
#pragma unroll
            for (int it = 0; it < 4; ++it) { pk[it][0] = pk2(acc[it][0], acc[it][1]); pk[it][1] = pk2(acc[it][2], acc[it][3]);
                *(v2u*)(spp + (size_t)n * 6 * 4096 + 16 * it) = (v2u){pk[it][0], pk[it][1]}; }
            bf16x8 bfr[2];
#pragma unroll
            for (int s_ = 0; s_ < 2; ++s_) { const v4u t = (v4u){pk[2 * s_][0], pk[2 * s_][1], pk[2 * s_ + 1][0], pk[2 * s_ + 1][1]}; bfr[s_] = __builtin_bit_cast(bf16x8, t); }
#pragma unroll
            for (int it = 0; it < 4; ++it) {
                pg8::f32x4 a = (pg8::f32x4){bf2f(bi[k][it].x & 0xffffu), bf2f(bi[k][it].x >> 16), bf2f(bi[k][it].y & 0xffffu), bf2f(bi[k][it].y >> 16)};
#pragma unroll
                for (int s_ = 0; s_ < 2; ++s_) { const v4u t = (v4u){af[k][it][s_][0].x, af[k][it][s_][0].y, af[k][it][s_][1].x, af[k][it][s_][1].y}; a = MFMA16(__builtin_bit_cast(bf16x8, t), bfr[s_], a); }
                acc[it] = a; }
            asm volatile("s_nop 15\n\ts_nop 7" : "+v"(acc[0]), "+v"(acc[1]), "+v"(acc[2]), "+v"(acc[3]));
            if (n + RD < 64) G2_LOAD(k, n + RD);
        }
    }
#undef G2_LOAD
}
__device__ __forceinline__ void ph_g2(const Ctx& F0) { Ctx F = launder(F0); const int t = F.wave * F.G + F.bid; if (t < 192) gdn_g2_task(F, t); }

__device__ __forceinline__ void ph_g3(const Ctx& F0, int l) {
    Ctx F = launder(F0); const int LN = F.lane;
    const bf16* P = (const bf16*)(F.ws + WS_P); bf16* Y = (bf16*)(F.ws + WS_Y);
    const bf16* QE = (const bf16*)(F.ws + WS_GQE); const bf16* O1 = (const bf16*)(F.ws + WS_GO1); const bf16* SP = (const bf16*)(F.ws + WS_GSP);
    const int fr = F.lane & 15, fq = F.lane >> 4; const float* gnp = inptr(F, I_GNORM) + l * 64;
    const int NT = 3072 * 4, stride = F.G * 8;
    bf16x8 bq[2], sp[4][2], bqn[2], spn[4][2]; v2u oi[4], zz[4], oin[4], zzn[4];
#define G3_LOAD(task_, BQ, SPF, OI, ZZ) do { const int u_ = (task_) >> 2, t_ = (task_) & 3, h_ = u_ % 6; const size_t r_ = (size_t)(u_ / 6) * 64 + 16 * t_ + fr; \
        _Pragma("unroll") for (int ks = 0; ks < 2; ++ks) BQ[ks] = *(const bf16x8*)(QE + (size_t)u_ * 4096 + (16 * t_ + fr) * 64 + 32 * ks + 8 * fq); \
        _Pragma("unroll") for (int et = 0; et < 4; ++et) { OI[et] = *(const v2u*)(O1 + (size_t)u_ * 4096 + (16 * t_ + fr) * 64 + 16 * et + 4 * fq); ZZ[et] = *(const v2u*)(P + r_ * NP + PC_GZ + h_ * 64 + 16 * et + 4 * fq); \
            _Pragma("unroll") for (int ks = 0; ks < 2; ++ks) SPF[et][ks] = *(const bf16x8*)(SP + (size_t)u_ * 4096 + (16 * et + fr) * 64 + 32 * ks + 8 * fq); } } while (0)
    int task = F.bid * 8 + F.wave;
    if (task < NT) G3_LOAD(task, bq, sp, oi, zz);
    for (; task < NT; task += stride) {
        const int unit = task >> 2, tt = task & 3, hh = unit % 6, bn = unit / 6; const size_t row = (size_t)bn * 64 + 16 * tt + fr;
        if (task + stride < NT) G3_LOAD(task + stride, bqn, spn, oin, zzn);
        float ov[4][4]; float ss = 0.f;
#pragma unroll
        for (int et = 0; et < 4; ++et) {
            pg8::f32x4 a = (pg8::f32x4){bf2f(oi[et].x & 0xffffu), bf2f(oi[et].x >> 16), bf2f(oi[et].y & 0xffffu), bf2f(oi[et].y >> 16)};
#pragma unroll
            for (int ks = 0; ks < 2; ++ks) a = MFMA16(sp[et][ks], bq[ks], a);
            MFMA_SETTLE(a);
            ov[et][0] = a[0]; ov[et][1] = a[1]; ov[et][2] = a[2]; ov[et][3] = a[3]; ss += (a[0] * a[0] + a[1] * a[1]) + (a[2] * a[2] + a[3] * a[3]); }
        ss += SHX(ss, 16); ss += SHX(ss, 32);
        const float rs = rsqrtf(ss * (1.f / 64.f) + EPS);
#pragma unroll
        for (int et = 0; et < 4; ++et) { const int e0 = 16 * et + 4 * fq; const v4f gw = *(const v4f*)(gnp + e0);
            v2u w; w.x = pk2(ov[et][0] * rs * gw.x * silu_f(bf2f(zz[et].x & 0xffffu)), ov[et][1] * rs * gw.y * silu_f(bf2f(zz[et].x >> 16)));
            w.y = pk2(ov[et][2] * rs * gw.z * silu_f(bf2f(zz[et].y & 0xffffu)), ov[et][3] * rs * gw.w * silu_f(bf2f(zz[et].y >> 16)));
            *(v2u*)(Y + row * DM + 256 + hh * 64 + e0) = w; }
#pragma unroll
        for (int ks = 0; ks < 2; ++ks) bq[ks] = bqn[ks];
#pragma unroll
        for (int et = 0; et < 4; ++et) { oi[et] = oin[et]; zz[et] = zzn[et];
#pragma unroll
            for (int ks = 0; ks < 2; ++ks) sp[et][ks] = spn[et][ks]; }
    }
#undef G3_LOAD
}


constexpr size_t WS_S5KT = 592 * MiB;
constexpr size_t WS_S5LP = 594 * MiB;
constexpr size_t WS_S5CM = 597 * MiB;
constexpr size_t WS_S5BB = 598 * MiB;
constexpr size_t WS_YS5 = 392 * MiB;
typedef float v2f __attribute__((ext_vector_type(2)));
__device__ __forceinline__ void s5_tables(const Ctx& F0) {
    Ctx F = launder(F0);
    LAS v2f* lp = (LAS v2f*)F.lds; LAS v2f* bb = (LAS v2f*)(F.lds + 33280); LAS v2f* cc = (LAS v2f*)(F.lds + 33280 + 8192);
    const int tb0 = (F.G >= 2 * NL * 24) ? NL * 24 : 0;
    if (F.bid < tb0) return;
    for (int task = F.bid - tb0; task < NL * 16 * 16; task += F.G - tb0) {
        const int lg = task >> 4, c = task & 15, l = lg >> 4, g = lg & 15;
        const float step = expf(inptr(F, I_S5LDT)[lg]);
        for (int i = F.tid; i < 65 * 64; i += 512) { const int k = i >> 6, p = i & 63; const float are = inptr(F, I_S5ARE)[lg * 64 + p], aim = inptr(F, I_S5AIM)[lg * 64 + p];
            const float mag = expf((float)k * are * step); float sn, cs; sincosf((float)k * aim * step, &sn, &cs); lp[i] = (v2f){mag * cs, mag * sn}; }
        __syncthreads();
        for (int i = F.tid; i < 64 * 16; i += 512) { const int p = i >> 4; const float are = inptr(F, I_S5ARE)[lg * 64 + p], aim = inptr(F, I_S5AIM)[lg * 64 + p];
            const v2f lb = lp[64 + p]; const float nr = lb.x - 1.f, ni = lb.y, den = are * are + aim * aim, fr_ = (nr * are + ni * aim) / den, fi_ = (ni * are - nr * aim) / den;
            const float br = inptr(F, I_S5BRE)[(size_t)lg * 1024 + i], bi = inptr(F, I_S5BIM)[(size_t)lg * 1024 + i];
            bb[i] = (v2f){fr_ * br - fi_ * bi, fr_ * bi + fi_ * br}; }
        if (F.tid < 64) cc[F.tid] = (v2f){inptr(F, I_S5CRE)[((size_t)lg * 16 + c) * 64 + F.tid], inptr(F, I_S5CIM)[((size_t)lg * 16 + c) * 64 + F.tid]};
        __syncthreads();
        bf16* KT = (bf16*)(F.ws + WS_S5KT) + (size_t)lg * 16384 + c * 1024;
        for (int o = F.tid; o < 1024; o += 512) { const int d = o >> 4, c2 = o & 15; float acc = 0.f;
            for (int p = 0; p < 64; ++p) { const v2f C = cc[p], L = lp[d * 64 + p], B = bb[p * 16 + c2]; const float mr = C.x * L.x - C.y * L.y, mi = C.x * L.y + C.y * L.x; acc += mr * B.x - mi * B.y; }
            KT[o] = (bf16)f2bf(acc); }
        if (c == 0) {
            float* LPg = (float*)(F.ws + WS_S5LP) + (size_t)lg * 65 * 128; bf16* CMg = (bf16*)(F.ws + WS_S5CM) + (size_t)lg * 2048; bf16* BBg = (bf16*)(F.ws + WS_S5BB) + (size_t)lg * 4096;
            for (int i = F.tid; i < 65 * 64; i += 512) { LPg[2 * i] = lp[i].x; LPg[2 * i + 1] = lp[i].y; }
            for (int i = F.tid; i < 64 * 16; i += 512) { const int p = i >> 4, c2 = i & 15; BBg[p * 32 + c2] = (bf16)f2bf(bb[i].x); BBg[(64 + p) * 32 + c2] = (bf16)f2bf(bb[i].y); BBg[p * 32 + 16 + c2] = 0; BBg[(64 + p) * 32 + 16 + c2] = 0; }
            for (int i = F.tid; i < 16 * 64; i += 512) { const int c2 = i >> 6, p = i & 63; CMg[c2 * 128 + p] = (bf16)f2bf(inptr(F, I_S5CRE)[((size_t)lg * 16 + c2) * 64 + p]); CMg[c2 * 128 + 64 + p] = (bf16)f2bf(-inptr(F, I_S5CIM)[((size_t)lg * 16 + c2) * 64 + p]); }
        }
        __syncthreads();
    }
}
constexpr int S5_KT = 0, S5_KT_S = 2064, S5_LP = 33024, S5_CM = 66304, S5_CM_S = 272, S5_BB = 70656, S5_SL = 74752, S5_U = 107520;
__device__ __forceinline__ void s5_unit(const Ctx& F0, int l, int unit) {
    Ctx F = F0; F.lane = fresh_lane(); F.tid = F.wave * 64 + F.lane; int LN = F.lane;
    const int hs = unit & 1, b = unit >> 5, g = (unit >> 1) & 15, lg = l * 16 + g; int fr = F.lane & 15, fq = F.lane >> 4;
    const bf16* P = (const bf16*)(F.ws + WS_P); bf16* YS = (bf16*)(F.ws + WS_YS5);
    { const bf16* KTg = (const bf16*)(F.ws + WS_S5KT) + (size_t)lg * 16384;
      for (int i = F.tid; i < 16 * 128; i += 512) { const int c = i >> 7, k8 = i & 127; *(LAS v4u*)(F.lds + S5_KT + c * S5_KT_S + k8 * 16) = *(const v4u*)(KTg + c * 1024 + k8 * 8); }
      const v4f* LPg = (const v4f*)((const float*)(F.ws + WS_S5LP) + (size_t)lg * 65 * 128);
      for (int i = F.tid; i < 65 * 32; i += 512) ((LAS v4f*)(F.lds + S5_LP))[i] = LPg[i];
      const bf16* CMg = (const bf16*)(F.ws + WS_S5CM) + (size_t)lg * 2048;
      for (int i = F.tid; i < 16 * 16; i += 512) { const int c = i >> 4, k8 = i & 15; *(LAS v4u*)(F.lds + S5_CM + c * S5_CM_S + k8 * 16) = *(const v4u*)(CMg + c * 128 + k8 * 8); }
      LAS v4u* uz = (LAS v4u*)(F.lds + S5_U + F.wave * 4096);
      for (int i = F.lane; i < 128; i += 64) uz[i] = zero4u(); }
    __syncthreads();
    LAS v2f* lp = (LAS v2f*)(F.lds + S5_LP); LAS v2f* sl = (LAS v2f*)(F.lds + S5_SL);
    {
        const bf16* BBq = (const bf16*)(F.ws + WS_S5BB) + (size_t)lg * 4096;
        bf16x8 bbr[4], bbi[4];
#pragma unroll
        for (int j = 0; j < 4; ++j) { bbr[j] = *(const bf16x8*)(BBq + (16 * j + fr) * 32 + 8 * fq); bbi[j] = *(const bf16x8*)(BBq + (64 + 16 * j + fr) * 32 + 8 * fq); }
        const bf16* up = P + ((size_t)b * SEQ + fr) * NP + PC_S5 + g * 16 + 8 * (fq & 1);
        bf16x8 ua[4], un[4];
#pragma unroll
        for (int st = 0; st < 4; ++st) ua[st] = *(const bf16x8*)(up + ((size_t)(32 * hs + F.wave) * 64 + 16 * st) * NP);
        for (int n = 32 * hs + F.wave; n < 32 * (hs + 1); n += 8) {
            unsigned l0v = (unsigned)(unsigned long long)F.lds; asm volatile("" : "+v"(l0v)); LAS unsigned char* L0 = (LAS unsigned char*)(unsigned long long)l0v;
            LAS v2f* lp = (LAS v2f*)(L0 + S5_LP); LAS v2f* sl = (LAS v2f*)(L0 + S5_SL);
            if (n + 8 < 32 * (hs + 1)) {
#pragma unroll
                for (int st = 0; st < 4; ++st) un[st] = *(const bf16x8*)(up + ((size_t)(n + 8) * 64 + 16 * st) * NP); }
#pragma unroll
            for (int j = 0; j < 4; ++j) {
                float sr = 0.f, si = 0.f;
#pragma unroll
                for (int st = 0; st < 4; ++st) { const pg8::f32x4 z4 = zero4();
                    pg8::f32x4 ar = MFMA16(ua[st], bbr[j], z4), ai = MFMA16(ua[st], bbi[j], z4);
                    asm volatile("s_nop 15\n\ts_nop 15" : "+v"(ar), "+v"(ai));
#pragma unroll
                    for (int r = 0; r < 4; ++r) { const v2f w = lp[(63 - (16 * st + 4 * fq + r)) * 64 + 16 * j + fr]; sr += w.x * ar[r] - w.y * ai[r]; si += w.x * ai[r] + w.y * ar[r]; } }
                sr += SHX(sr, 16); sr += SHX(sr, 32); si += SHX(si, 16); si += SHX(si, 32);
                if (fq == 0) sl[n * 64 + 16 * j + fr] = (v2f){sr, si};
            }
#pragma unroll
            for (int st = 0; st < 4; ++st) ua[st] = un[st];
        }
    }
    __syncthreads();
    if (F.wave == 0) { const v2f l64 = lp[64 * 64 + F.lane]; float sr = 0.f, si = 0.f;
        unsigned* flag = (unsigned*)(F.ws + WS_CTL) + CW_S5F + ((l * 128 + b * 16 + g) * 16);
        unsigned long long* sx = (unsigned long long*)(F.ws + WS_S5X) + (size_t)(l * 128 + b * 16 + g) * 64 + F.lane;
        if (hs == 1) {
            unsigned spins = 0; while (__hip_atomic_load(flag, __ATOMIC_RELAXED, __HIP_MEMORY_SCOPE_AGENT) == 0u && ++spins < (1u << 22)) __builtin_amdgcn_s_sleep(2);
            __builtin_amdgcn_fence(__ATOMIC_ACQUIRE, "agent");
            const unsigned long long v = __hip_atomic_load(sx, __ATOMIC_RELAXED, __HIP_MEMORY_SCOPE_AGENT); sr = __uint_as_float((unsigned)v); si = __uint_as_float((unsigned)(v >> 32)); }
        for (int n = 32 * hs; n < 32 * (hs + 1); ++n) { const v2f loc = sl[n * 64 + F.lane]; sl[n * 64 + F.lane] = (v2f){sr, si};
            const float nr = l64.x * sr - l64.y * si + loc.x, ni = l64.x * si + l64.y * sr + loc.y; sr = nr; si = ni; }
        if (hs == 0) {
            __hip_atomic_store(sx, ((unsigned long long)__float_as_uint(si) << 32) | __float_as_uint(sr), __ATOMIC_RELAXED, __HIP_MEMORY_SCOPE_AGENT);
            asm volatile("s_waitcnt vmcnt(0)" ::: "memory");
            if (F.lane == 0) __hip_atomic_store(flag, 1u, __ATOMIC_RELAXED, __HIP_MEMORY_SCOPE_AGENT); } }
    __syncthreads();
    F.lane = fresh_lane(); LN = F.lane; fr = F.lane & 15; fq = F.lane >> 4;
    const float Dc = inptr(F, I_S5D)[l * 256 + g * 16 + fr];
    v4u upc[2];
    { const bf16* q = P + ((size_t)b * SEQ + (size_t)(32 * hs + F.wave) * 64 + (F.lane >> 1)) * NP + PC_S5 + g * 16 + 8 * (F.lane & 1); upc[0] = *(const v4u*)q; upc[1] = *(const v4u*)(q + (size_t)32 * NP); }
    for (int n = 32 * hs + F.wave; n < 32 * (hs + 1); n += 8) {
        unsigned l0v = (unsigned)(unsigned long long)F.lds; asm volatile("" : "+v"(l0v)); LAS unsigned char* L0 = (LAS unsigned char*)(unsigned long long)l0v;
        LAS unsigned char* ub = L0 + S5_U + F.wave * 4096;
        const size_t rowbase = (size_t)b * SEQ + n * 64;
        { const int r0_ = F.lane >> 1, hf = F.lane & 1; *(LAS v4u*)(ub + (64 + r0_) * 32 + hf * 16) = upc[0]; *(LAS v4u*)(ub + (96 + r0_) * 32 + hf * 16) = upc[1];
          if (n + 8 < 32 * (hs + 1)) { const bf16* q = P + ((size_t)b * SEQ + (size_t)(n + 8) * 64 + r0_) * NP + PC_S5 + g * 16 + 8 * hf; upc[0] = *(const v4u*)q; upc[1] = *(const v4u*)(q + (size_t)32 * NP); } }
        LDS_WAIT();
#pragma unroll 1
        for (int tt = 0; tt < 4; ++tt) {
            pg8::f32x4 a = zero4();
            const int t = 16 * tt + fr;
#pragma unroll
            for (int hp = 0; hp < 2; ++hp) { float zr[8], zi[8];
#pragma unroll
                for (int q4 = 0; q4 < 4; ++q4) { const v4f lw = *(const LAS v4f*)(L0 + S5_LP + ((t + 1) * 64 + 32 * hp + 8 * fq + 2 * q4) * 8), sv = *(const LAS v4f*)(L0 + S5_SL + (n * 64 + 32 * hp + 8 * fq + 2 * q4) * 8);
                    zr[2 * q4] = lw.x * sv.x - lw.y * sv.y; zi[2 * q4] = lw.x * sv.y + lw.y * sv.x; zr[2 * q4 + 1] = lw.z * sv.z - lw.w * sv.w; zi[2 * q4 + 1] = lw.z * sv.w + lw.w * sv.z; }
                const v4u fre = (v4u){pk2(zr[0], zr[1]), pk2(zr[2], zr[3]), pk2(zr[4], zr[5]), pk2(zr[6], zr[7])}, fim = (v4u){pk2(zi[0], zi[1]), pk2(zi[2], zi[3]), pk2(zi[4], zi[5]), pk2(zi[6], zi[7])};
                a = MFMA16(__builtin_bit_cast(bf16x8, fre), *(const LAS bf16x8*)(L0 + S5_CM + fr * S5_CM_S + (32 * hp + 8 * fq) * 2), a);
                a = MFMA16(__builtin_bit_cast(bf16x8, fim), *(const LAS bf16x8*)(L0 + S5_CM + fr * S5_CM_S + (64 + 32 * hp + 8 * fq) * 2), a); }
            for (int k4 = 0; k4 < 8 * (tt + 1); k4 += 4) { bf16x8 ua_[4], kb_[4];
#pragma unroll
                for (int i = 0; i < 4; ++i) { const int ks = k4 + i; ua_[i] = *(const LAS bf16x8*)(ub + (64 + t - 2 * ks - (fq >> 1)) * 32 + (fq & 1) * 16); kb_[i] = *(const LAS bf16x8*)(L0 + S5_KT + fr * S5_KT_S + (32 * ks + 8 * fq) * 2); }
#pragma unroll
                for (int i = 0; i < 4; ++i) a = MFMA16(ua_[i], kb_[i], a); }
            MFMA_SETTLE(a);
#pragma unroll
            for (int r = 0; r < 4; ++r) { const int t2 = 16 * tt + 4 * fq + r; const float u = bf2f(*(const LAS unsigned short*)(ub + (64 + t2) * 32 + fr * 2));
                YS[(rowbase + t2) * 256 + g * 16 + fr] = (bf16)f2bf(gelu_tanh(a[r] + Dc * u)); }
        }
        LDS_WAIT();
    }
    __syncthreads();
}
__device__ __forceinline__ void ph_s5(const Ctx& F0, int l) { Ctx F = launder(F0); for (int u = F.bid; u < 256; u += F.G) s5_unit(F, l, u); }

__device__ __forceinline__ void ph_scan(const Ctx& F0, int l) {
    Ctx F = launder(F0);
    if (F.wave == 0) { if (F.bid < 192) gdn_g2_task(F, F.bid); }
    else {
        bf16* CS = (bf16*)(F.ws + WS_CS2); const float* CD = (const float*)(F.ws + WS_CD);
        for (int task = (F.bid * 7 + (F.wave - 1)) * 64 + F.lane; task < 48 * 1024; task += F.G * 7 * 64) {
            const int bh = task >> 10, e = (task & 1023) * 8; float s[8];
#pragma unroll
            for (int i = 0; i < 8; ++i) s[i] = 0.f;
            for (int n0 = 0; n0 < 64; n0 += 8) { v4u v[8]; float cd[8];
#pragma unroll
                for (int i = 0; i < 8; ++i) { v[i] = *(const v4u*)(CS + (size_t)(bh * 64 + n0 + i) * 8192 + e); cd[i] = CD[bh * 64 + n0 + i]; }
#pragma unroll
                for (int i = 0; i < 8; ++i) { v4u o; o.x = pk2(s[0], s[1]); o.y = pk2(s[2], s[3]); o.z = pk2(s[4], s[5]); o.w = pk2(s[6], s[7]);
                    *(v4u*)(CS + (size_t)(bh * 64 + n0 + i) * 8192 + e) = o;
                    s[0] = cd[i] * s[0] + bf2f(v[i].x & 0xffffu); s[1] = cd[i] * s[1] + bf2f(v[i].x >> 16); s[2] = cd[i] * s[2] + bf2f(v[i].y & 0xffffu); s[3] = cd[i] * s[3] + bf2f(v[i].y >> 16);
                    s[4] = cd[i] * s[4] + bf2f(v[i].z & 0xffffu); s[5] = cd[i] * s[5] + bf2f(v[i].z >> 16); s[6] = cd[i] * s[6] + bf2f(v[i].w & 0xffffu); s[7] = cd[i] * s[7] + bf2f(v[i].w >> 16); }
            }
        }
    }
    { const int NFW = F.G * 7 + (F.G > 192 ? F.G - 192 : 0);
      const int idx = F.wave > 0 ? F.bid * 7 + (F.wave - 1) : (F.bid >= 192 ? F.G * 7 + (F.bid - 192) : -1);
      if (idx >= 0) { LAS float* scr = (LAS float*)(F.lds + F.wave * 8448);
          for (int it = CV_IN + idx; it < CV_ITEMS; it += NFW) convert_item(F, l, it, scr, F.lane); } }
}

__device__ __forceinline__ void ph_m3(const Ctx& F0, int l) {
    Ctx F = launder(F0); const int LN = F.lane;
    const bf16* YS = (const bf16*)(F.ws + WS_YS5); const bf16* WT = (const bf16*)(F.ws + WS_WGLU); bf16* Y = (bf16*)(F.ws + WS_Y);
    const int fr = F.lane & 15, fq = F.lane >> 4; const float* nrm = inptr(F, I_S5NORM) + l * 256;
    LAS v4f* vl = (LAS v4f*)(F.lds + F.wave * 16384) + F.lane;
    for (int tile = F.bid * 8 + F.wave; tile < NTOK / 16; tile += F.G * 8) {
        const size_t row = (size_t)tile * 16 + fr;
        bf16x8 bq[8];
#pragma unroll
        for (int ks = 0; ks < 8; ++ks) bq[ks] = *(const bf16x8*)(YS + row * 256 + 32 * ks + 8 * fq);
        float ss = 0.f;
        const bf16* wp = WT + fr * 256 + 8 * fq; const bf16* yp = YS + row * 256 + 4 * fq;
        bf16x8 wc[8], wn[8];
#pragma unroll
        for (int ks = 0; ks < 8; ++ks) wc[ks] = *(const bf16x8*)(wp + 32 * ks);
#pragma unroll 1
        for (int jt = 0; jt < 16; ++jt) {
            wp += 16 * 256;
            if (jt < 15) {
#pragma unroll
                for (int ks = 0; ks < 8; ++ks) wn[ks] = *(const bf16x8*)(wp + 32 * ks); }
            pg8::f32x4 a = zero4();
#pragma unroll
            for (int ks = 0; ks < 8; ++ks) a = MFMA16(wc[ks], bq[ks], a);
            MFMA_SETTLE(a);
            const v2u yy = *(const v2u*)(yp + 16 * jt);
            v4f v; v.x = bf2f(yy.x & 0xffffu) * sigm(a[0]); v.y = bf2f(yy.x >> 16) * sigm(a[1]); v.z = bf2f(yy.y & 0xffffu) * sigm(a[2]); v.w = bf2f(yy.y >> 16) * sigm(a[3]);
            ss += dot4(v, v);
            vl[jt * 64] = v;
#pragma unroll
            for (int ks = 0; ks < 8; ++ks) wc[ks] = wn[ks];
        }
        ss += SHX(ss, 16); ss += SHX(ss, 32);
        const float rs = rsqrtf(ss * (1.f / 256.f) + EPS);
        LDS_WAIT();
#pragma unroll 1
        for (int j4 = 0; j4 < 16; j4 += 4) { v4f nw[4];
#pragma unroll
            for (int i = 0; i < 4; ++i) nw[i] = *(const v4f*)(nrm + 16 * (j4 + i) + 4 * fq);
#pragma unroll
            for (int i = 0; i < 4; ++i) { const v4f v = vl[(j4 + i) * 64];
                v2u w; w.x = pk2(v.x * rs * nw[i].x, v.y * rs * nw[i].y); w.y = pk2(v.z * rs * nw[i].z, v.w * rs * nw[i].w);
                *(v2u*)(Y + row * DM + 16 * (j4 + i) + 4 * fq) = w; } }
        LDS_WAIT();
    }
}

__device__ __forceinline__ void ph_n2(const Ctx& F0, int l) {
    Ctx F = launder(F0);
    const int LN = F.lane;
    const float* MOD = (const float*)(F.ws + WS_MOD);
    LAS float* rw = (LAS float*)F.lds;
    { const float* RW = (const float*)(F.ws + WS_RW) + (size_t)l * 36 * DM;
      for (int i = F.tid; i < 36 * DM / 4; i += 512) ((LAS v4f*)rw)[i] = ((const v4f*)RW)[i]; }
    __syncthreads();
    const int NGW = F.G * 8, gw = F.bid * 8 + F.wave, rows_per = (NTOK + NGW - 1) / NGW;
    const int r0 = gw * rows_per, r1 = (r0 + rows_per) < NTOK ? (r0 + rows_per) : NTOK;
    bf16* H = (bf16*)(F.ws + WS_H); const bf16* X = (const bf16*)(F.ws + WS_X); int* TI = (int*)(F.ws + WS_TI); int* LIST = (int*)(F.ws + WS_LIST);
    unsigned* cnt = (unsigned*)(F.ws + WS_CTL) + CW_CNT + l * NE;
    int curb = -1; v4f An[4], Bn[4];
    const float* p_nffn = inptr(F, I_NFFN); const float* p_mbg = inptr(F, I_MBG) + l * 4; const float* p_mbr = inptr(F, I_MBR) + l * 32;
#pragma unroll
    for (int j = 0; j < 4; ++j) { An[j] = zero4(); Bn[j] = An[j]; }
    for (int c0 = r0; c0 < r1; c0 += 64) {
        const int c1 = (c0 + 64) < r1 ? (c0 + 64) : r1;
        int me0 = 0, me1 = 0; float mw0 = 0.f, mw1 = 0.f;
        v2u nv[4];
#pragma unroll
        for (int j = 0; j < 4; ++j) nv[j] = *(const v2u*)(X + (size_t)c0 * DM + 4 * F.lane + 256 * j);
        for (int row = c0; row < c1; ++row) {
            const int b = row >> 12;
            if (b != curb) { curb = b;
#pragma unroll
                for (int j = 0; j < 4; ++j) { const int c = 4 * F.lane + 256 * j;
                    const v4f nm = *(const v4f*)(p_nffn + l * DM + c), sc = *(const v4f*)(MOD + ((size_t)l * NB + b) * 6 * DM + 4 * DM + c), sh = *(const v4f*)(MOD + ((size_t)l * NB + b) * 6 * DM + 3 * DM + c);
                    An[j] = nm * (1.f + sc); Bn[j] = sh; }
            }
            v4f v[4]; float ss = 0.f;
#pragma unroll
            for (int j = 0; j < 4; ++j) { const v2u q = nv[j]; v[j] = (v4f){bf2f(q.x & 0xffffu), bf2f(q.x >> 16), bf2f(q.y & 0xffffu), bf2f(q.y >> 16)}; ss += dot4(v[j], v[j]); }
            { const int nr = (row + 1 < c1) ? row + 1 : row;
#pragma unroll
              for (int j = 0; j < 4; ++j) nv[j] = *(const v2u*)(X + (size_t)nr * DM + 4 * F.lane + 256 * j); }
            const float rs = rsqrtf(wave_sum(ss) * (1.f / DM) + EPS);
            v4f h[4];
#pragma unroll
            for (int j = 0; j < 4; ++j) { h[j] = v[j] * rs * An[j] + Bn[j]; v2u o; o.x = pk2(h[j].x, h[j].y); o.y = pk2(h[j].z, h[j].w); *(v2u*)(H + (size_t)row * DM + 4 * F.lane + 256 * j) = o; }
            float lg[4];
#pragma unroll
            for (int c = 0; c < 4; ++c) { float s = 0.f;
#pragma unroll
                for (int j = 0; j < 4; ++j) s += dot4(h[j], ((const LAS v4f*)rw)[c * 256 + 64 * j + F.lane]);
                lg[c] = wave_sum(s) + p_mbg[c]; }
            int gi = 0; float gm = lg[0];
#pragma unroll
            for (int c = 1; c < 4; ++c) if (lg[c] > gm) { gm = lg[c]; gi = c; }
            float den = 0.f;
#pragma unroll
            for (int c = 0; c < 4; ++c) den += __expf(lg[c] - gm);
            const float gwt = 1.f / den;
            float le[8];
#pragma unroll
            for (int c = 0; c < 8; ++c) { float s = 0.f; const LAS v4f* wr_ = (const LAS v4f*)rw + (4 + gi * 8 + c) * 256;
#pragma unroll
                for (int j = 0; j < 4; ++j) s += dot4(h[j], wr_[64 * j + F.lane]);
                le[c] = wave_sum(s) + p_mbr[gi * 8 + c]; }
            int i1 = 0; float v1 = le[0];
#pragma unroll
            for (int c = 1; c < 8; ++c) if (le[c] > v1) { v1 = le[c]; i1 = c; }
            int i2 = (i1 == 0) ? 1 : 0; float v2 = -3.0e38f;
#pragma unroll
            for (int c = 0; c < 8; ++c) if (c != i1 && le[c] > v2) { v2 = le[c]; i2 = c; }
            const float ex = __expf(v2 - v1), we1 = 1.f / (1.f + ex), we2 = ex / (1.f + ex);
            if (F.lane == row - c0) { me0 = gi * 8 + i1; me1 = gi * 8 + i2; mw0 = gwt * we1; mw1 = gwt * we2; }
        }
        LAS int* lcnt = (LAS int*)(F.lds + LDS_MISC) + 700; LAS int* lbase = (LAS int*)(F.lds + LDS_MISC) + 740;
        if (F.tid < 32) lcnt[F.tid] = 0;
        __syncthreads();
        int ls0 = 0, ls1 = 0; const bool act = c0 + F.lane < c1;
        if (act) { ls0 = __hip_atomic_fetch_add(lcnt + me0, 1, __ATOMIC_RELAXED, __HIP_MEMORY_SCOPE_WORKGROUP); ls1 = __hip_atomic_fetch_add(lcnt + me1, 1, __ATOMIC_RELAXED, __HIP_MEMORY_SCOPE_WORKGROUP); }
        __syncthreads();
        if (F.tid < 32) { const int nn = lcnt[F.tid]; lbase[F.tid] = nn ? (int)__hip_atomic_fetch_add(cnt + F.tid, (unsigned)nn, __ATOMIC_RELAXED, __HIP_MEMORY_SCOPE_AGENT) : 0; }
        __syncthreads();
        if (act) {
            const int row = c0 + F.lane; const int s0 = lbase[me0] + ls0, s1 = lbase[me1] + ls1;
            int* ti = TI + (size_t)row * 8; ti[0] = me0; ti[1] = s0; ti[2] = __float_as_int(mw0); ti[3] = me1; ti[4] = s1; ti[5] = __float_as_int(mw1);
            LIST[(size_t)me0 * NTOK + s0] = row; LIST[(size_t)me1 * NTOK + s1] = row;
        }
        __syncthreads();
    }
}

__device__ __forceinline__ void ph_e0(const Ctx& F0, int l) {
    Ctx F = launder(F0);
    build_tiles(F, l); __syncthreads();
    const int ntiles = F.misc[16 + NE];
    const bf16* H = (const bf16*)(F.ws + WS_H); bf16* XG = (bf16*)(F.ws + WS_P); const int* LIST = (const int*)(F.ws + WS_LIST);
    for (int tile = F.bid; tile < ntiles; tile += F.G) {
        const int e = F.misc[128 + tile], ts = F.misc[16 + e], ce = F.misc[64 + e];
        for (int r = F.wave; r < 256; r += 8) { const int slot = (tile - ts) * 256 + r;
            if (slot < ce) { const int tok = LIST[(size_t)e * NTOK + slot]; const v4u* s = (const v4u*)(H + (size_t)tok * DM); v4u* d = (v4u*)(XG + ((size_t)tile * 256 + r) * DM);
                d[F.lane] = s[F.lane]; d[64 + F.lane] = s[64 + F.lane]; } }
    }
}

struct EpiResid {
    static constexpr bool PERM = true, AFTER_DRAIN = false;
    const bf16* xin; bf16* xout; const float* gate;
    __device__ __forceinline__ void operator()(const pg8::f32x4 (&acc)[2][2][4][2], const pg8::Unit& u, int wr, int wc, int fr, int fq) const {
        const int row0 = u.pm * 256 + wr * 64 + fr, col0 = u.pn * 256 + wc * 32 + 8 * fq, b = u.pm >> 4;
        pg8::f32x4 gv[2][2];
#pragma unroll
        for (int bj = 0; bj < 2; ++bj)
#pragma unroll
            for (int n = 0; n < 2; ++n) gv[bj][n] = *(const pg8::f32x4*)(gate + (size_t)b * 6 * DM + col0 + bj * 128 + n * 4);
#pragma unroll
        for (int ai = 0; ai < 2; ++ai)
#pragma unroll
            for (int m = 0; m < 4; m += 2) {
                v4u xv[2][2];
#pragma unroll
                for (int mm = 0; mm < 2; ++mm)
#pragma unroll
                    for (int bj = 0; bj < 2; ++bj) xv[mm][bj] = *(const v4u*)(xin + (size_t)(row0 + ai * 128 + (m + mm) * 16) * DM + col0 + bj * 128);
#pragma unroll
                for (int mm = 0; mm < 2; ++mm)
#pragma unroll
                    for (int bj = 0; bj < 2; ++bj) { const v4u q = xv[mm][bj]; const pg8::f32x4 a0 = acc[ai][bj][m + mm][0], a1 = acc[ai][bj][m + mm][1]; v4u o;
                        o.x = pk2(bf2f(q.x & 0xffffu) + gv[bj][0][0] * a0[0], bf2f(q.x >> 16) + gv[bj][0][1] * a0[1]); o.y = pk2(bf2f(q.y & 0xffffu) + gv[bj][0][2] * a0[2], bf2f(q.y >> 16) + gv[bj][0][3] * a0[3]);
                        o.z = pk2(bf2f(q.z & 0xffffu) + gv[bj][1][0] * a1[0], bf2f(q.z >> 16) + gv[bj][1][1] * a1[1]); o.w = pk2(bf2f(q.w & 0xffffu) + gv[bj][1][2] * a1[2], bf2f(q.w >> 16) + gv[bj][1][3] * a1[3]);
                        *(v4u*)(xout + (size_t)(row0 + ai * 128 + (m + mm) * 16) * DM + col0 + bj * 128) = o; }
                asm volatile("" ::: "memory"); }
    }
};
struct EpiGLU {
    static constexpr bool PERM = true, AFTER_DRAIN = false;
    bf16* O;
    __device__ __forceinline__ void operator()(const pg8::f32x4 (&acc)[2][2][4][2], const pg8::Unit& u, int wr, int wc, int fr, int fq) const {
        const int row0 = u.pm * 256 + wr * 64 + fr, col0 = u.pn * 128 + wc * 32 + 8 * fq;
#pragma unroll
        for (int ai = 0; ai < 2; ++ai)
#pragma unroll
            for (int m = 0; m < 4; ++m) { bf16* rowp = O + (size_t)(row0 + ai * 128 + m * 16) * DE + col0; float hv[8];
#pragma unroll
                for (int n = 0; n < 2; ++n)
#pragma unroll
                    for (int i = 0; i < 4; ++i) { const float g = acc[ai][0][m][n][i], uu = acc[ai][1][m][n][i]; hv[4 * n + i] = g * __builtin_amdgcn_rcpf(1.f + __expf(-g)) * uu; }
                v4u w; w.x = pk2(hv[0], hv[1]); w.y = pk2(hv[2], hv[3]); w.z = pk2(hv[4], hv[5]); w.w = pk2(hv[6], hv[7]);
                asm volatile("global_store_dwordx4 %0, %1, off sc1\n\ts_nop 2" :: "v"(rowp), "v"(w) : "memory"); }
    }
};
struct MoeOrder {
    int nunits, NT, G, c; volatile LAS int* misc; const int* list;
    __device__ __forceinline__ bool next(int i, pg8::Unit& u) const {
        int tile, pn;
        if (G == 256 && NT == 2) { const int x = c & 7, q = c >> 3; tile = i * 128 + x * 16 + (q >> 1); pn = q & 1; if (tile * 2 >= nunits) return false; }
        else { const int L = i * G + c; if (L >= nunits) return false; tile = L / NT; pn = L % NT; }
        u.pm = tile; u.pn = pn; u.e = misc[128 + tile]; return true; }
    __device__ __forceinline__ void a_ready(const pg8::Unit&) const {}
    __device__ __forceinline__ void done(const pg8::Unit&) const {}
    __device__ __forceinline__ unsigned rowbyte(const pg8::Unit& u, int r, int K) const { const int slot = (u.pm - misc[16 + u.e]) * 256 + r; const int tok = slot < misc[64 + u.e] ? list[(size_t)u.e * NTOK + slot] : 0; return (unsigned)tok * (unsigned)(K * 2); }
};

struct MoeOrderPub : MoeOrder {
    unsigned* ready;
    __device__ __forceinline__ void done(const pg8::Unit& u) const {
        asm volatile("s_waitcnt vmcnt(0)" ::: "memory");
        if (fresh_lane() == 0) (void)__hip_atomic_fetch_add(ready + 64 * u.pm, 1u, __ATOMIC_RELAXED, __HIP_MEMORY_SCOPE_AGENT);
    }
};
struct MoeOrderCnt {
    int nunits, NT, G, c, xe; volatile LAS int* misc; const unsigned* ready;
    __device__ __forceinline__ bool next(int i, pg8::Unit& u) const {
        int tile, pn;
        if (G == 256 && NT == 4) { const int x = c & 7, q = c >> 3, Te = (8 - xe) * 8;
            if (x >= xe) tile = (i < 2) ? i * Te + (x - xe) * 8 + (q >> 2) : 2 * Te + (i - 2) * 64 + x * 8 + (q >> 2); else tile = 2 * Te + i * 64 + x * 8 + (q >> 2);
            pn = q & 3; if (tile * 4 >= nunits) return false; }
        else { const int L = i * G + c; if (L >= nunits) return false; tile = L / NT; pn = L % NT; }
        u.pm = tile; u.pn = pn; u.e = misc[128 + tile]; return true; }
    __device__ __forceinline__ void a_ready(const pg8::Unit& u) const {
        if (threadIdx.x < 64) {
            unsigned polls = 0;
            while ((unsigned)__builtin_amdgcn_readfirstlane(__hip_atomic_load(ready + 64 * u.pm, __ATOMIC_RELAXED, __HIP_MEMORY_SCOPE_AGENT)) < 16u && ++polls < (1u << 20)) __builtin_amdgcn_s_sleep(2);
            __builtin_amdgcn_fence(__ATOMIC_ACQUIRE, "agent");
            asm volatile("s_waitcnt vmcnt(0)" ::: "memory");
        }
        asm volatile("" ::: "memory"); __builtin_amdgcn_s_barrier(); asm volatile("" ::: "memory");
    }
    __device__ __forceinline__ void done(const pg8::Unit&) const {}
    __device__ __forceinline__ unsigned rowbyte(const pg8::Unit&, int, int) const { return 0u; }
};

constexpr int PH_PER_LAYER = 9, N_PHASES = 2 + NL * PH_PER_LAYER;

__global__ void __launch_bounds__(512, 2) fwd(Args A) {
    extern __shared__ __attribute__((aligned(16))) unsigned char lds_raw[];
    Ctx F; F.lds = (LAS unsigned char*)lds_raw; F.misc = (volatile LAS int*)(F.lds + LDS_MISC);
    F.tid = threadIdx.x; F.lane = F.tid & 63; F.wave = __builtin_amdgcn_readfirstlane(F.tid >> 6); F.G = gridDim.x; F.bid = blockIdx.x; F.ws = A.ws; F.out = A.out;
    for (int i = F.tid; i < (LDS_BYTES - LDS_MISC) / 4; i += 512) F.misc[i] = 0;
    __syncthreads();
    if (F.tid < 36) { const unsigned long long p = (unsigned long long)A.in[F.tid]; F.misc[MISC_PTR + 2 * F.tid] = (int)(unsigned)p; F.misc[MISC_PTR + 2 * F.tid + 1] = (int)(unsigned)(p >> 32); }
    __syncthreads();
#if ONE_LAUNCH
    (void)xcd_barrier_post((unsigned*)(F.ws + WS_CTL) + CW_BAR, (volatile LAS unsigned*)F.misc);
#define GRID_BAR() do { const Ctx Q_ = launder(F); XcdBarrier b_; b_.bar = (unsigned*)(Q_.ws + WS_CTL) + CW_BAR; b_.x = xb_xcc_id(); b_.st = (volatile LAS unsigned*)Q_.misc; xcd_barrier(b_); } while (0)
#else
#define GRID_BAR() do {} while (0)
#endif
#if ONE_LAUNCH
    constexpr int lo = 0, hi = N_PHASES;
#else
    const int lo = A.ph_lo, hi = A.ph_hi;
#endif
#ifndef DISMASK
#define DISMASK 0
#endif
#define IN(k) (lo <= (k) && (k) < hi)
#define EN(j) (!((DISMASK >> (j)) & 1))
#ifndef PROBE_MASK
#define PROBE_MASK 0
#endif
#ifndef DUP_MASK
#define DUP_MASK 0
#endif
#define DUP(j) ((DUP_MASK >> (j)) & 1)
#if PROBE_MASK
#define PR_BEGIN(j) do { if (((PROBE_MASK >> (j)) & 1) && F.wave == 0) { const unsigned long long t_ = __builtin_amdgcn_s_memrealtime(); F.misc[602] = (int)(unsigned)t_; F.misc[603] = (int)(unsigned)(t_ >> 32); } } while (0)
#define PR_END(j) do { if (((PROBE_MASK >> (j)) & 1) && F.wave == 0) { const unsigned long long t_ = __builtin_amdgcn_s_memrealtime(); const unsigned long long t0_ = ((unsigned long long)(unsigned)F.misc[603] << 32) | (unsigned)F.misc[602]; F.misc[600] = F.misc[600] + (int)(unsigned)(t_ - t0_); } } while (0)
#else
#define PR_BEGIN(j) do {} while (0)
#define PR_END(j) do {} while (0)
#endif
#define SEAM(k) do { if (IN((k) + 1)) GRID_BAR(); } while (0)
    if (IN(0)) { ph_prologue(F); s5_tables(F); SEAM(0); }
    for (int l = 0; l < NL; ++l) {
        const int p0 = 1 + l * PH_PER_LAYER;
        if (IN(p0 + 0)) { ph_n1(F, l, 0); SEAM(p0 + 0); }
        if (IN(p0 + 1)) { const Ctx P = launder(F);
            pg8::Gemm g{(const bf16*)(P.ws + WS_H), (const bf16*)((P.ws + WS_WB) + WB_IN), NTOK, NP, DM, 0}; pg8::StaticOrder S; S.init(NTOK, NP, P.G, P.bid);
            pg8::EpiBf16<0> E{(bf16*)(P.ws + WS_P), NP, nullptr, 0, 0, 1.f};
            pg8::gemm_phase<pg8::EpiBf16<0>, pg8::StaticOrder, true, true>(P.lds, g, S, E, P.wave);
            SEAM(p0 + 1); }
        if (IN(p0 + 2)) { ph_s5(F, l); __syncthreads(); ph_s1(F, l); __syncthreads(); ph_g1(F, l); SEAM(p0 + 2); }
        if (IN(p0 + 3)) { ph_scan(F, l); SEAM(p0 + 3); }
        if (IN(p0 + 4)) { ph_s3(F, l); __syncthreads(); ph_g3(F, l); __syncthreads(); ph_m3(F, l); SEAM(p0 + 4); }
        if (IN(p0 + 5)) { const Ctx P = launder(F);
            pg8::Gemm g{(const bf16*)(P.ws + WS_Y), (const bf16*)((P.ws + WS_WB) + WB_OUT), NTOK, DM, DM, 0}; pg8::StaticOrder S; S.init(NTOK, DM, P.G, P.bid);
            EpiResid E{(const bf16*)(P.ws + WS_X), (bf16*)(P.ws + WS_X), (const float*)(P.ws + WS_MOD) + (size_t)l * NB * 6 * DM + 2 * DM};
            pg8::gemm_phase<EpiResid, pg8::StaticOrder, true, true>(P.lds, g, S, E, P.wave);
            SEAM(p0 + 5); }
        if (IN(p0 + 6)) { ph_n2(F, l); SEAM(p0 + 6); }
        if (IN(p0 + 7)) { const Ctx P = launder(F);
            __syncthreads(); build_tiles(P, l); __syncthreads();
            const int ntiles = P.misc[16 + NE];
            unsigned* rt = (unsigned*)(P.ws + WS_CTL) + CW_RT + l * (320 * 64);
            { pg8::Gemm g{(const bf16*)(P.ws + WS_H), (const bf16*)((P.ws + WS_WB) + WB_GU), MAXROWS, 512, DM, (size_t)512 * DM * 2};
              MoeOrderPub S{{ntiles * 2, 2, P.G, P.bid, P.misc, (const int*)(P.ws + WS_LIST)}, rt};
              EpiGLU E{(bf16*)(P.ws + WS_HID)};
              pg8::gemm_phase<EpiGLU, MoeOrderPub, true, true, true>(P.lds, g, S, E, P.wave); }
            __syncthreads();
            { const Ctx Q = launder(F);
              const int R1 = (ntiles + 127) / 128, n3 = ntiles - (R1 - 1) * 128; const int xe = (n3 >= 128) ? 0 : (n3 + 15) / 16;
              pg8::Gemm g{(const bf16*)(Q.ws + WS_HID), (const bf16*)((Q.ws + WS_WB) + WB_DN), MAXROWS, DM, DE, (size_t)DM * DE * 2};
              MoeOrderCnt S{ntiles * 4, 4, Q.G, Q.bid, xe, Q.misc, (const unsigned*)(Q.ws + WS_CTL) + CW_RT + l * (320 * 64)};
              pg8::EpiBf16<0> E{(bf16*)(Q.ws + WS_P), DM, nullptr, 0, 0, 1.f};
              pg8::gemm_phase<pg8::EpiBf16<0>, MoeOrderCnt, true, true>(Q.lds, g, S, E, Q.wave); }
            SEAM(p0 + 8); }
    }
    if (IN(N_PHASES - 1)) ph_n1(F, 0, 1);
}

extern "C" void kernel_launch(void* const* d_in, const int* in_sizes, int n_in, void* d_out, int out_size, void* d_ws, size_t ws_size, hipStream_t stream) {
    static int grid = 0;
    if (grid == 0) {
        if (n_in != 36 || out_size != NTOK * DM || ws_size < WS_END) { fprintf(stderr, "kernel_launch: unexpected shapes: n_in %d out %d ws %zu (need %zu)\n", n_in, out_size, ws_size, (size_t)WS_END); grid = -1; return; }
        int dev = 0, cus = 0, per_cu = 0;
        if (hipGetDevice(&dev) != hipSuccess || hipDeviceGetAttribute(&cus, hipDeviceAttributeMultiprocessorCount, dev) != hipSuccess) { grid = -1; return; }
        if (hipFuncSetAttribute((const void*)fwd, hipFuncAttributeMaxDynamicSharedMemorySize, LDS_BYTES) != hipSuccess) { fprintf(stderr, "kernel_launch: hipFuncSetAttribute failed\n"); grid = -1; return; }
        if (hipOccupancyMaxActiveBlocksPerMultiprocessor(&per_cu, (const void*)fwd, 512, LDS_BYTES) != hipSuccess || per_cu < 1) fprintf(stderr, "kernel_launch: occupancy query says %d\n", per_cu);
        (void)hipGetLastError();
        grid = cus;
    }
    if (grid < 0) return;
    (void)hipMemsetAsync((char*)d_ws + WS_CTL, 0, CTL_BYTES, stream);
    Args a{};
    for (int i = 0; i < 36; ++i) a.in[i] = (const float*)d_in[i];
    a.out = (float*)d_out; a.ws = (unsigned char*)d_ws;
#if ONE_LAUNCH
    a.ph_lo = 0; a.ph_hi = N_PHASES;
    hipLaunchKernelGGL(fwd, dim3(grid), dim3(512), LDS_BYTES, stream, a);
#else
    for (int ph = 0; ph < N_PHASES; ++ph) { a.ph_lo = ph; a.ph_hi = ph + 1; hipLaunchKernelGGL(fwd, dim3(grid), dim3(512), LDS_BYTES, stream, a); }
#endif
}
```

```cpp
#include <hip/hip_runtime.h>
#include <cstdio>
#include <cstdint>
namespace pg8 {
#define PG8_LAS __attribute__((address_space(3)))
typedef unsigned short bf16_t;
typedef short bf16x8 __attribute__((ext_vector_type(8)));
typedef float f32x4 __attribute__((ext_vector_type(4)));
typedef unsigned u32x4 __attribute__((ext_vector_type(4)));
constexpr int BM = 256, BK = 64, HALF = 128, HTB = HALF * BK * 2  , STAGE_BYTES = 8 * HTB, NXCD = 8, WGM = 8;

__host__ __device__ __forceinline__ int lds_byte(int r, int c) { const int st = (r >> 4) * 2 + (c >> 5), rr = r & 15, cc = c & 31, ob = rr * 64 + cc * 2; return st * 1024 + (ob ^ (((ob >> 9) & 1) << 5)); }
__host__ __device__ __forceinline__ void stage_rc(int b, int& R, int& C) { const int st = b / 1024, sb = b % 1024, swz = sb ^ (((sb >> 9) & 1) << 5); R = (st >> 1) * 16 + swz / 64; C = (st & 1) * 32 + (swz % 64) / 2; }
__host__ __device__ __forceinline__ int perm32(int rho) { const int n = rho >> 4, i = rho & 15; return 8 * (i >> 2) + 4 * n + (i & 3); }

struct Unit { int pm, pn, e; };
struct Gemm { const bf16_t* A; const bf16_t* Bt; int M, N, K; size_t estride; };

struct StaticOrder {
    int nM, nN, nwg, G, c;
    __host__ __device__ void init(int M, int N, int G_, int c_) { nM = M / BM; nN = N / BM; nwg = nM * nN; G = G_; c = c_; }
    __host__ __device__ bool next(int i, Unit& u) const {
        const long L = (long)i * G + c; if (L >= nwg) return false;
        int wgid = (int)L; { const int q = nwg / NXCD, r = nwg % NXCD, xcd = wgid % NXCD, off = wgid / NXCD; wgid = (xcd < r ? xcd * (q + 1) : r * (q + 1) + (xcd - r) * q) + off; }
        const int nig = WGM * nN, gid = wgid / nig, fm = gid * WGM, gsz = (nM - fm) < WGM ? (nM - fm) : WGM;
        u.pm = fm + ((wgid % nig) % gsz); u.pn = (wgid % nig) / gsz; u.e = 0; return true;
    }
    __device__ __forceinline__ void a_ready(const Unit&) const {}
    __device__ __forceinline__ void done(const Unit&) const {}
    __device__ __forceinline__ unsigned rowbyte(const Unit&, int, int) const { return 0u; }
};

__device__ __forceinline__ unsigned cvt_pk_bf16(float lo, float hi) { unsigned r; asm volatile("v_cvt_pk_bf16_f32 %0, %1, %2" : "=v"(r) : "v"(lo), "v"(hi)); return r; }
typedef float f32x2 __attribute__((ext_vector_type(2)));
__device__ __forceinline__ f32x2 gelu_pk(f32x2 v) {
    const f32x2 av = __builtin_elementwise_abs(v), d = av * 0.2316418882f + 1.0f;
    f32x2 t; t.x = __builtin_amdgcn_rcpf(d.x); t.y = __builtin_amdgcn_rcpf(d.y);
    f32x2 q = t * 0.5307027145f + (-0.7265760135f); q = q * t + 0.7107068705f; q = q * t + (-0.142248368f); q = q * t + 0.127414796f; q = q * t;
    const f32x2 s = (v * v) * (-0.72134752044f);
    f32x2 e; e.x = __builtin_amdgcn_exp2f(s.x); e.y = __builtin_amdgcn_exp2f(s.y);
    const f32x2 m = v * (q * e), r = v - m;
    f32x2 o; o.x = v.x < 0.f ? m.x : r.x; o.y = v.y < 0.f ? m.y : r.y; return o;
}

template <int ACT  > struct EpiBf16 {
    static constexpr bool PERM = true, AFTER_DRAIN = false; static_assert(ACT == 0 || ACT == 1, "EpiBf16: ACT is 0 (none) or 1 (gelu_pk)");
    bf16_t* O; int ldc; const float* bias; int split_cols; size_t split_stride; float scale0;
    __device__ __forceinline__ void operator()(const f32x4 (&acc)[2][2][4][2], const Unit& u, int wr, int wc, int fr, int fq) const {
        const int row0 = u.pm * BM + wr * 64 + fr; int colt = u.pn * BM; bf16_t* base = O;
        float sc = 1.f; if (split_cols) { const int t = colt / split_cols; base += (size_t)t * split_stride; colt -= t * split_cols; if (t == 0) sc = scale0; }
        const int col0 = colt + wc * 32 + 8 * fq, bcol0 = u.pn * BM + wc * 32 + 8 * fq;
#pragma unroll
        for (int ai = 0; ai < 2; ++ai)
#pragma unroll
            for (int m = 0; m < 4; ++m) { bf16_t* rowp = base + (size_t)(row0 + ai * HALF + m * 16) * ldc + col0;
#pragma unroll
                for (int bj = 0; bj < 2; ++bj) { f32x4 v0 = acc[ai][bj][m][0], v1 = acc[ai][bj][m][1];
                    if (ACT == 1) { f32x2 a = gelu_pk((f32x2){v0[0], v0[1]}), b = gelu_pk((f32x2){v0[2], v0[3]}), c = gelu_pk((f32x2){v1[0], v1[1]}), d = gelu_pk((f32x2){v1[2], v1[3]});
                        v0 = (f32x4){a.x, a.y, b.x, b.y}; v1 = (f32x4){c.x, c.y, d.x, d.y}; }
                    v0 = v0 * sc; v1 = v1 * sc; u32x4 w; w.x = cvt_pk_bf16(v0[0], v0[1]); w.y = cvt_pk_bf16(v0[2], v0[3]); w.z = cvt_pk_bf16(v1[0], v1[1]); w.w = cvt_pk_bf16(v1[2], v1[3]);
                    *(u32x4*)(rowp + bj * HALF) = w; } }
    }
};
template <class Epi, class Sched, bool ALIGN_EPI = false, bool SP2 = false, bool GATHER = false>
__device__ __forceinline__ void gemm_phase(PG8_LAS unsigned char* lds, const Gemm g, const Sched& S, const Epi& E, const int wave_index) {
    int tid_; { int ln_; asm volatile("v_mbcnt_lo_u32_b32 %0, -1, 0\n\tv_mbcnt_hi_u32_b32 %0, -1, %0" : "=v"(ln_)); tid_ = wave_index * 64 + ln_; }
    const int tid = tid_, wid = __builtin_amdgcn_readfirstlane(tid >> 6), lane = tid & 63, wr = wid >> 2, wc = wid & 3, fr = lane & 15, fq = lane >> 4;
    int K_ = g.K; asm volatile("" : "+s"(K_)); const int K = K_, nt = K / BK;
    unsigned voffA[2], voffB[2]; unsigned vc[2][2], vn[2][2];
#pragma unroll
    for (int i = 0; i < 2; ++i) { int R, C; stage_rc(tid * 16 + i * 8192, R, C); const int Rb = Epi::PERM ? ((R & ~31) + perm32(R & 31)) : R;
        voffA[i] = (unsigned)(R * K + C) * 2u; voffB[i] = (unsigned)(Rb * K + C) * 2u; }
    const size_t kstep = (size_t)(BK * 2);
    const size_t hstep = (size_t)HALF * K * 2;
    const size_t tstep = 2 * hstep;
    const unsigned ldsw = (unsigned)wid * 1024u;
    const int aoff = lds_byte(wr * 64 + fr, fq * 8), boff = lds_byte(wc * 32 + fr, fq * 8);
#define PG8_SA(b, h) (((b) * 2 + (h)) * HTB)
#define PG8_SB(b, h) ((4 + (b) * 2 + (h)) * HTB)
#define PG8_STAGE(bufoff, gbase, voff) do { _Pragma("unroll") for (int _i = 0; _i < 2; ++_i) \
        __builtin_amdgcn_global_load_lds((const unsigned*)((const char*)(gbase) + (voff)[_i]), (PG8_LAS unsigned*)(lds + (bufoff) + ldsw + _i * 8192), 16, 0, 0); } while (0)
#define PG8_STAGE_A(bufoff, gbase, half, usenext) do { if constexpr (GATHER) { const unsigned oo_[2] = {(usenext) ? vn[half][0] : vc[half][0], (usenext) ? vn[half][1] : vc[half][1]}; PG8_STAGE(bufoff, gbase, oo_); } \
        else { PG8_STAGE(bufoff, (gbase) + (half) * hstep, voffA); } } while (0)
#define PG8_GSET(dst, u) do { _Pragma("unroll") for (int h_ = 0; h_ < 2; ++h_) _Pragma("unroll") for (int i_ = 0; i_ < 2; ++i_) { int R_, C_; stage_rc(tid * 16 + i_ * 8192, R_, C_); dst[h_][i_] = S.rowbyte(u, h_ * HALF + R_, K) + (unsigned)C_ * 2u; } } while (0)
#define PG8_LDA(dst, b, h) do { _Pragma("unroll") for (int m = 0; m < 4; ++m) _Pragma("unroll") for (int k = 0; k < 2; ++k) dst[m][k] = *(const PG8_LAS bf16x8*)(lds + PG8_SA(b, h) + aoff + m * 2048 + k * 1024); } while (0)
#define PG8_LDB(dst, b, h) do { _Pragma("unroll") for (int n = 0; n < 2; ++n) _Pragma("unroll") for (int k = 0; k < 2; ++k) dst[n][k] = *(const PG8_LAS bf16x8*)(lds + PG8_SB(b, h) + boff + n * 2048 + k * 1024); } while (0)
#define PG8_MMA(ai, bj, At, Bt) do { __builtin_amdgcn_s_setprio(1); _Pragma("unroll") for (int m = 0; m < 4; ++m) _Pragma("unroll") for (int n = 0; n < 2; ++n) _Pragma("unroll") for (int k = 0; k < 2; ++k) \
        acc[ai][bj][m][n] = __builtin_amdgcn_mfma_f32_16x16x32_bf16(Bt[n][k], At[m][k], acc[ai][bj][m][n], 0, 0, 0); __builtin_amdgcn_s_setprio(0); } while (0)
#define PG8_WAIT_V(n) asm volatile("s_waitcnt vmcnt(" #n ")" ::: "memory")
#define PG8_WAIT_L(n) asm volatile("s_waitcnt lgkmcnt(" #n ")" ::: "memory")
#define PG8_BAR __builtin_amdgcn_s_barrier()
#define PG8_SCHED __builtin_amdgcn_sched_barrier(0)
    Unit cur, nxt; int ui = 0;
    if (!S.next(0, cur)) return;
    float z0_ = 0.f; asm volatile("" : "+v"(z0_));
    f32x4 acc[2][2][4][2];
#pragma unroll
    for (int a = 0; a < 2; ++a)
#pragma unroll
        for (int b = 0; b < 2; ++b)
#pragma unroll
            for (int m = 0; m < 4; ++m)
#pragma unroll
                for (int n = 0; n < 2; ++n) acc[a][b][m][n] = (f32x4){z0_, z0_, z0_, z0_};
    bf16x8 At[4][2], B0[2][2], B1[2][2];
    const char* cA = (const char*)g.A + (GATHER ? (size_t)0 : (size_t)cur.pm * tstep); const char* cB = (const char*)g.Bt + (size_t)cur.e * g.estride + (size_t)cur.pn * tstep;
    S.a_ready(cur);
    if constexpr (GATHER) PG8_GSET(vc, cur);
    if constexpr (SP2) {
        PG8_STAGE(PG8_SB(0, 0), cB, voffB); PG8_STAGE(PG8_SB(0, 1), cB + hstep, voffB); PG8_STAGE_A(PG8_SA(0, 0), cA, 0, false); PG8_STAGE_A(PG8_SA(0, 1), cA, 1, false);
        if (wr == 1) PG8_BAR;
        PG8_WAIT_V(2); PG8_BAR;
        PG8_STAGE(PG8_SB(1, 0), cB + kstep, voffB); PG8_STAGE_A(PG8_SA(1, 0), cA + kstep, 0, false); PG8_STAGE(PG8_SB(1, 1), cB + hstep + kstep, voffB);
        PG8_WAIT_V(6); PG8_BAR;
    } else {
        PG8_STAGE(PG8_SB(0, 0), cB, voffB); PG8_STAGE(PG8_SA(0, 0), cA, voffA); PG8_STAGE(PG8_SB(0, 1), cB + hstep, voffB); PG8_STAGE(PG8_SA(0, 1), cA + hstep, voffA);
        if (wr == 1) PG8_BAR;
        PG8_WAIT_V(4); PG8_BAR;
        PG8_STAGE(PG8_SB(1, 0), cB + kstep, voffB); PG8_STAGE(PG8_SA(1, 0), cA + kstep, voffA); PG8_STAGE(PG8_SB(1, 1), cB + hstep + kstep, voffB);
        PG8_WAIT_V(6); PG8_BAR;
    }
    for (;;) {
        const bool has_next = S.next(ui + 1, nxt);
        const char* nA = (has_next && !GATHER) ? (const char*)g.A + (size_t)nxt.pm * tstep : cA; if constexpr (GATHER) { if (has_next) PG8_GSET(vn, nxt); }
        const bool un_ = has_next; (void)un_; const char* nB = has_next ? (const char*)g.Bt + (size_t)nxt.e * g.estride + (size_t)nxt.pn * tstep : cB;
        for (int t = 0; t < nt; t += 2) {
            const bool last = (t == nt - 2);
            const char* a1 = cA + (size_t)(t + 1) * kstep;
            const char* a2 = last ? nA : cA + (size_t)(t + 2) * kstep; const char* b2 = last ? nB : cB + (size_t)(t + 2) * kstep;
            const char* a3 = a2 + kstep; const char* b3 = b2 + kstep;
            if (last && has_next) S.a_ready(nxt);
            if constexpr (SP2) {
            PG8_LDB(B0, 0, 0); PG8_LDB(B1, 0, 1); PG8_SCHED; PG8_LDA(At, 0, 0); PG8_STAGE_A(PG8_SA(1, 1), a1, 1, false);
            PG8_WAIT_V(8); PG8_WAIT_L(0); PG8_BAR; PG8_MMA(0, 0, At, B0); PG8_MMA(0, 1, At, B1); PG8_BAR; PG8_SCHED;
            PG8_LDA(At, 0, 1); PG8_STAGE(PG8_SB(0, 0), b2, voffB); PG8_STAGE(PG8_SB(0, 1), b2 + hstep, voffB); PG8_STAGE_A(PG8_SA(0, 0), a2, 0, last && un_);
            PG8_WAIT_V(8); PG8_WAIT_L(0); PG8_BAR; PG8_MMA(1, 0, At, B0); PG8_MMA(1, 1, At, B1); PG8_BAR; PG8_SCHED;
            PG8_LDB(B0, 1, 0); PG8_LDB(B1, 1, 1); PG8_SCHED; PG8_LDA(At, 1, 0); PG8_STAGE_A(PG8_SA(0, 1), a2, 1, last && un_);
            PG8_WAIT_V(8); PG8_WAIT_L(0); PG8_BAR; PG8_MMA(0, 0, At, B0); PG8_MMA(0, 1, At, B1); PG8_BAR; PG8_SCHED;
            PG8_LDA(At, 1, 1); PG8_STAGE(PG8_SB(1, 0), b3, voffB); PG8_STAGE(PG8_SB(1, 1), b3 + hstep, voffB); PG8_STAGE_A(PG8_SA(1, 0), a3, 0, last && un_);
            PG8_WAIT_V(8); PG8_WAIT_L(0); PG8_BAR; PG8_MMA(1, 0, At, B0); PG8_MMA(1, 1, At, B1); PG8_BAR; PG8_SCHED;
            } else {
            PG8_LDB(B0, 0, 0); PG8_SCHED; PG8_LDA(At, 0, 0); PG8_STAGE(PG8_SA(1, 1), a1 + hstep, voffA);
            PG8_WAIT_L(8); PG8_BAR; PG8_WAIT_L(0); PG8_MMA(0, 0, At, B0); PG8_BAR; PG8_SCHED;
            PG8_LDB(B1, 0, 1); PG8_STAGE(PG8_SB(0, 0), b2, voffB);
            PG8_BAR; PG8_WAIT_L(0); PG8_MMA(0, 1, At, B1); PG8_BAR;
            PG8_LDA(At, 0, 1); PG8_STAGE(PG8_SA(0, 0), a2, voffA);
            PG8_BAR; PG8_WAIT_L(0); PG8_MMA(1, 0, At, B0); PG8_BAR; PG8_SCHED;
            PG8_STAGE(PG8_SB(0, 1), b2 + hstep, voffB);
            PG8_WAIT_V(6); PG8_BAR; PG8_MMA(1, 1, At, B1); PG8_BAR;
            PG8_LDB(B0, 1, 0); PG8_SCHED; PG8_LDA(At, 1, 0); PG8_STAGE(PG8_SA(0, 1), a2 + hstep, voffA);
            PG8_WAIT_L(8); PG8_BAR; PG8_WAIT_L(0); PG8_MMA(0, 0, At, B0); PG8_BAR; PG8_SCHED;
            PG8_LDB(B1, 1, 1); PG8_STAGE(PG8_SB(1, 0), b3, voffB);
            PG8_BAR; PG8_WAIT_L(0); PG8_MMA(0, 1, At, B1); PG8_BAR;
            PG8_LDA(At, 1, 1); PG8_STAGE(PG8_SA(1, 0), a3, voffA);
            PG8_BAR; PG8_WAIT_L(0); PG8_MMA(1, 0, At, B0); PG8_BAR; PG8_SCHED;
            PG8_STAGE(PG8_SB(1, 1), b3 + hstep, voffB);
            PG8_WAIT_V(6); PG8_BAR; PG8_MMA(1, 1, At, B1); PG8_BAR;
            }
        }
        if constexpr (ALIGN_EPI) { if (wr == 0) PG8_BAR; }
        if constexpr (!Epi::AFTER_DRAIN) { int ln2_; asm volatile("v_mbcnt_lo_u32_b32 %0, -1, 0\n\tv_mbcnt_hi_u32_b32 %0, -1, %0" : "=v"(ln2_)); E(acc, cur, wr, wc, ln2_ & 15, ln2_ >> 4); S.done(cur); }
        if (!has_next) break;
        float z1_ = 0.f; asm volatile("" : "+v"(z1_));
#pragma unroll
        for (int a = 0; a < 2; ++a)
#pragma unroll
            for (int b = 0; b < 2; ++b)
#pragma unroll
                for (int m = 0; m < 4; ++m)
#pragma unroll
                    for (int n = 0; n < 2; ++n) acc[a][b][m][n] = (f32x4){z1_, z1_, z1_, z1_};
        cur = nxt; cA = nA; cB = nB; ++ui;
        if constexpr (GATHER) { _Pragma("unroll") for (int h_ = 0; h_ < 2; ++h_) _Pragma("unroll") for (int i_ = 0; i_ < 2; ++i_) vc[h_][i_] = vn[h_][i_]; }
        if constexpr (ALIGN_EPI) { if (wr == 1) PG8_BAR; }
    }
    PG8_WAIT_V(0);
    if constexpr (!ALIGN_EPI) { if (wr == 0) PG8_BAR; }
    PG8_BAR;
    if constexpr (Epi::AFTER_DRAIN) { E.fused(acc, cur, wr, wc, fr, fq, lds, wid, lane); S.done(cur); }
#undef PG8_SA
#undef PG8_SB
#undef PG8_STAGE
#undef PG8_LDA
#undef PG8_STAGE_A
#undef PG8_GSET
#undef PG8_LDB
#undef PG8_MMA
#undef PG8_WAIT_V
#undef PG8_WAIT_L
#undef PG8_BAR
#undef PG8_SCHED
}
}

#ifndef ONE_LAUNCH
#define ONE_LAUNCH 1
#endif

#define GAS __attribute__((address_space(1)))
#define LAS __attribute__((address_space(3)))
typedef unsigned short bf16;
typedef float v4f __attribute__((ext_vector_type(4)));
typedef unsigned v4u __attribute__((ext_vector_type(4)));
typedef unsigned v2u __attribute__((ext_vector_type(2)));

constexpr int NB = 8, SEQ = 4096, NTOK = NB * SEQ, DM = 1024, NL = 4;
constexpr int DIN = 3090, NP = 3072;
constexpr int PC_S5 = 0, PC_GQKV = 256, PC_GZ = 1408, PC_SZ = 1792, PC_SX = 2176;
constexpr int NE = 32, DE = 256;
constexpr int MAXROWS = 2 * NTOK + NE * 256;
constexpr int MAXTILES = MAXROWS / 256;
constexpr float EPS = 1e-6f;

constexpr size_t MiB = 1u << 20;
constexpr size_t WS_CTL = 0, CTL_BYTES = 1 * MiB;
constexpr size_t WS_MOD = 1 * MiB;
constexpr size_t WS_SMW = 2 * MiB;
constexpr size_t WS_RW = 3 * MiB;
constexpr size_t WS_TI = 4 * MiB;
constexpr size_t WS_LIST = 5 * MiB;
constexpr size_t WS_SM = 9 * MiB;
constexpr size_t WS_WB = 16 * MiB;
constexpr size_t WB_IN = 0, WB_OUT = 6 * MiB, WB_GU = 8 * MiB, WB_DN = 40 * MiB;
constexpr size_t WS_P = 72 * MiB;
constexpr size_t WS_HID = WS_P + 144 * MiB;
constexpr size_t WS_H = 264 * MiB;
constexpr size_t WS_Y = 328 * MiB;
constexpr size_t WS_YRAW = 392 * MiB;
constexpr size_t WS_CS2 = 424 * MiB;
constexpr size_t WS_CD = 12 * MiB;
constexpr size_t WS_WGLU = 600 * MiB;
constexpr size_t WS_MO = 328 * MiB;
constexpr size_t WS_X = 608 * MiB;
constexpr size_t WS_END = 672 * MiB;
static_assert((size_t)MAXROWS * DM * 2 <= 144 * MiB && (size_t)MAXROWS * DE * 2 <= 48 * MiB, "moe overlay");
constexpr int CW_BAR = 4096;
constexpr int CW_CNT = 16384;
constexpr int CW_RT = 65536;
constexpr int CW_XP = 150016;
constexpr int CW_HP = 182784;
constexpr int CW_S5F = 32768;
constexpr size_t WS_TW = 14 * MiB;
constexpr size_t WS_S5X = 13 * MiB;

constexpr int LDS_MISC = 147456;
constexpr int LDS_BYTES = LDS_MISC + 4096;

struct Args {
    const float* in[36]; float* out; unsigned char* ws; int ph_lo, ph_hi;
};
enum { I_X = 0, I_C, I_WADA, I_BADA, I_NMIX, I_NFFN, I_WIN, I_WOUT, I_S5ARE, I_S5AIM, I_S5BRE, I_S5BIM, I_S5CRE, I_S5CIM, I_S5D, I_S5LDT, I_S5GLU, I_S5NORM,
       I_GCW, I_GALOG, I_GDTB, I_GNORM, I_SCW, I_SCB, I_SALOG, I_SDTB, I_SD, I_SNORM, I_MWG, I_MBG, I_MWR, I_MBR, I_MGATE, I_MUP, I_MDOWN, I_NFIN };

struct Ctx { LAS unsigned char* lds; volatile LAS int* misc; unsigned char* ws; float* out; int tid, lane, wave, G, bid; };
constexpr int MISC_PTR = 448;
__device__ __forceinline__ const float* inptr(const Ctx& F, int i) { unsigned lo = (unsigned)F.misc[MISC_PTR + 2 * i], hi = (unsigned)F.misc[MISC_PTR + 2 * i + 1];
    lo = __builtin_amdgcn_readfirstlane(lo); hi = __builtin_amdgcn_readfirstlane(hi); return (const float*)(const GAS float*)(((unsigned long long)hi << 32) | lo); }

__device__ __forceinline__ Ctx launder(const Ctx& F) { Ctx G = F; int ln; asm volatile("v_mbcnt_lo_u32_b32 %0, -1, 0\n\tv_mbcnt_hi_u32_b32 %0, -1, %0" : "=v"(ln));
    int wv = F.wave; asm volatile("" : "+s"(wv)); G.wave = wv; G.lane = ln; G.tid = wv * 64 + ln;
    unsigned long long w = (unsigned long long)F.ws, o = (unsigned long long)F.out; unsigned l0 = (unsigned)(unsigned long long)F.lds; int gg = F.G, bb = F.bid; asm volatile("" : "+s"(w), "+s"(o), "+s"(l0), "+s"(gg), "+s"(bb)); G.G = gg; G.bid = bb;
    G.ws = (unsigned char*)(GAS unsigned char*)w; G.out = (float*)(GAS float*)o; G.lds = (LAS unsigned char*)(unsigned long long)l0; G.misc = (volatile LAS int*)(G.lds + LDS_MISC); return G; }
__device__ __forceinline__ int fresh_lane() { int ln; asm volatile("v_mbcnt_lo_u32_b32 %0, -1, 0\n\tv_mbcnt_hi_u32_b32 %0, -1, %0" : "=v"(ln)); return ln; }
__device__ __forceinline__ v4f zero4() { float z = 0.f; asm volatile("" : "+v"(z)); return (v4f){z, z, z, z}; }
__device__ __forceinline__ v4u zero4u() { unsigned z = 0u; asm volatile("" : "+v"(z)); return (v4u){z, z, z, z}; }
__device__ __forceinline__ v2u zero2u() { unsigned z = 0u; asm volatile("" : "+v"(z)); return (v2u){z, z}; }
#define LDS_WAIT() asm volatile("s_waitcnt lgkmcnt(0)" ::: "memory")
#define VM_WAIT() asm volatile("s_waitcnt vmcnt(0)" ::: "memory")

__device__ __forceinline__ float bf2f(unsigned v) { return __uint_as_float(v << 16); }
__device__ __forceinline__ unsigned f2bf(float f) { unsigned u = __float_as_uint(f); return (u + 0x7fffu + ((u >> 16) & 1u)) >> 16; }
typedef float f2_t __attribute__((ext_vector_type(2)));
typedef __bf16 b2_t __attribute__((ext_vector_type(2)));
__device__ __forceinline__ unsigned pk2(float lo, float hi) { const b2_t r = __builtin_convertvector((f2_t){lo, hi}, b2_t); return __builtin_bit_cast(unsigned, r); }
__device__ __forceinline__ float shx(float v, int m, int lane) { return __int_as_float(__builtin_amdgcn_ds_bpermute((lane ^ m) << 2, __float_as_int(v))); }
__device__ __forceinline__ float wave_sum_l(float v, int lane) {
    (void)lane;
    v += __int_as_float(__builtin_amdgcn_update_dpp(0, __float_as_int(v), 0xB1, 0xF, 0xF, true));
    v += __int_as_float(__builtin_amdgcn_update_dpp(0, __float_as_int(v), 0x4E, 0xF, 0xF, true));
    v += __int_as_float(__builtin_amdgcn_update_dpp(0, __float_as_int(v), 0x141, 0xF, 0xF, true));
    v += __int_as_float(__builtin_amdgcn_update_dpp(0, __float_as_int(v), 0x140, 0xF, 0xF, true));
    const float r0 = __int_as_float(__builtin_amdgcn_readlane(__float_as_int(v), 0)), r1 = __int_as_float(__builtin_amdgcn_readlane(__float_as_int(v), 16)),
                r2 = __int_as_float(__builtin_amdgcn_readlane(__float_as_int(v), 32)), r3 = __int_as_float(__builtin_amdgcn_readlane(__float_as_int(v), 48));
    return (r0 + r1) + (r2 + r3);
}

#define DPPF(src, ctrl, bank) __int_as_float(__builtin_amdgcn_update_dpp(0, __float_as_int(src), (ctrl), 0xF, (bank), true))
__device__ __forceinline__ float dpp_xor4(float x) { int r = __builtin_amdgcn_update_dpp(0, __float_as_int(x), 0x104, 0xF, 0x5, false); r = __builtin_amdgcn_update_dpp(r, __float_as_int(x), 0x114, 0xF, 0xA, false); return __int_as_float(r); }
__device__ __forceinline__ float dpp_xor8(float x) { int r = __builtin_amdgcn_update_dpp(0, __float_as_int(x), 0x108, 0xF, 0x3, false); r = __builtin_amdgcn_update_dpp(r, __float_as_int(x), 0x118, 0xF, 0xC, false); return __int_as_float(r); }
__device__ __forceinline__ float reduce16_scatter(const float (&v)[16], int lane) {
    const bool b0 = lane & 1, b1 = lane & 2, b2 = lane & 4, b3 = lane & 8;
    float r[8], q[4], p[2];
#pragma unroll
    for (int i = 0; i < 8; ++i) { const float keep = b0 ? v[2 * i + 1] : v[2 * i], send = b0 ? v[2 * i] : v[2 * i + 1]; r[i] = keep + DPPF(send, 0xB1, 0xF); }
#pragma unroll
    for (int i = 0; i < 4; ++i) { const float keep = b1 ? r[2 * i + 1] : r[2 * i], send = b1 ? r[2 * i] : r[2 * i + 1]; q[i] = keep + DPPF(send, 0x4E, 0xF); }
#pragma unroll
    for (int i = 0; i < 2; ++i) { const float keep = b2 ? q[2 * i + 1] : q[2 * i], send = b2 ? q[2 * i] : q[2 * i + 1]; p[i] = keep + dpp_xor4(send); }
    float t = (b3 ? p[1] : p[0]) + dpp_xor8(b3 ? p[0] : p[1]);
    t += __int_as_float(__builtin_amdgcn_ds_swizzle(__float_as_int(t), 0x401F));
    t += __int_as_float(__builtin_amdgcn_ds_bpermute((lane ^ 32) << 2, __float_as_int(t)));
    return t;
}
#define wave_sum(v) wave_sum_l((v), LN)
#define SHX(v, m) shx((v), (m), LN)
__device__ __forceinline__ float sigm(float x) { return __builtin_amdgcn_rcpf(1.f + __expf(-x)); }
__device__ __forceinline__ float silu_f(float x) { return x * __builtin_amdgcn_rcpf(1.f + __expf(-x)); }
__device__ __forceinline__ float log1p_small(float e) { return e < 0.03125f ? e * (1.f + e * (-0.5f + e * (0.33333334f - 0.25f * e))) : __logf(1.f + e); }
__device__ __forceinline__ float softplus_f(float x) { return fmaxf(x, 0.f) + log1p_small(__expf(-fabsf(x))); }
__device__ __forceinline__ float gelu_tanh(float x) { const float u = 0.7978845608028654f * (x + 0.044715f * x * x * x); return x * __builtin_amdgcn_rcpf(1.f + __expf(-2.f * u)); }
__device__ __forceinline__ float dot4(v4f a, v4f b) { return (a.x * b.x + a.y * b.y) + (a.z * b.z + a.w * b.w); }

#define XB_TMO      128
#define XB_XCNT(j)  (256  + 64 * (j))
#define XB_XSUB(j)  (1280 + 64 * (j))
#define XB_XGEN(j)  (2304 + 64 * (j))
#define XB_TOP      3328
#define XB_TOPGEN   3392
#define XCD_BAR_WORDS 3456
#define XB_SPIN_CAP (1u << 20)
__device__ __forceinline__ unsigned xb_ld(unsigned* p)              { return __hip_atomic_load(p, __ATOMIC_RELAXED, __HIP_MEMORY_SCOPE_AGENT); }
__device__ __forceinline__ unsigned xb_add(unsigned* p, unsigned v) { return __hip_atomic_fetch_add(p, v, __ATOMIC_RELAXED, __HIP_MEMORY_SCOPE_AGENT); }
__device__ __forceinline__ unsigned xb_xcc_id() { return (unsigned)__builtin_amdgcn_s_getreg((3 << 11) | 20) & 0xFu; }
#define XB_SPIN(cond, bar) do { unsigned _sp = 0; while (cond) { __builtin_amdgcn_s_sleep(1); \
    if ((++_sp & 255u) == 0u) { if (xb_ld(&(bar)[XB_TMO])) break; if (_sp > XB_SPIN_CAP) { atomicAdd(&(bar)[XB_TMO], 1u); break; } } } } while (0)
struct XcdBarrier { unsigned* bar; unsigned x; volatile LAS unsigned* st; };
__device__ __forceinline__ XcdBarrier xcd_barrier_post(unsigned* bar, volatile LAS unsigned* st) {
    XcdBarrier b; b.bar = bar; b.x = xb_xcc_id(); b.st = st;
    if (threadIdx.x == 0) (void)xb_add(&bar[XB_XCNT(b.x)], 1u);
    return b;
}
__device__ __forceinline__ void xcd_barrier_complete(unsigned* bar, unsigned x, unsigned& nloc, unsigned& nx) {
    const unsigned G = gridDim.x * gridDim.y * gridDim.z;
    unsigned sum, cnt, mine, sp = 0u;
    for (;;) {
        sum = 0u; cnt = 0u; mine = 0u;
#pragma unroll
        for (unsigned j = 0; j < 16; ++j) { const unsigned c = xb_ld(&bar[XB_XCNT(j)]); sum += c; cnt += (c > 0u) ? 1u : 0u; mine = (j == x) ? c : mine; }
        if (sum == G) break;
        __builtin_amdgcn_s_sleep(1);
        if ((++sp & 255u) == 0u) { if (xb_ld(&bar[XB_TMO])) break; if (sp > XB_SPIN_CAP) { atomicAdd(&bar[XB_TMO], 1u); break; } }
    }
    nloc = mine > 0u ? mine : 1u; nx = cnt > 0u ? cnt : 1u;
}
__device__ __forceinline__ void xcd_barrier(const XcdBarrier& b) {
    asm volatile("s_waitcnt vmcnt(0)" ::: "memory");
    __syncthreads();
    if (threadIdx.x == 0) {
        unsigned* bar = b.bar;
        __builtin_amdgcn_s_waitcnt(0);
        unsigned nloc = b.st[0], nx = b.st[1];
        if (nloc == 0u) { xcd_barrier_complete(bar, b.x, nloc, nx); b.st[0] = nloc; b.st[1] = nx; }
        const unsigned old = xb_add(&bar[XB_XSUB(b.x)], 1u);
        const unsigned gen = old / nloc;
        if (old + 1u == (gen + 1u) * nloc) {
            __builtin_amdgcn_fence(__ATOMIC_RELEASE, "agent");
            asm volatile("s_waitcnt vmcnt(0)" ::: "memory");
            const unsigned og = xb_add(&bar[XB_TOP], 1u);
            const unsigned tg = og / nx;
            if (og + 1u == (tg + 1u) * nx) xb_add(&bar[XB_TOPGEN], 1u);
            else XB_SPIN(xb_ld(&bar[XB_TOPGEN]) == tg, bar);
            __builtin_amdgcn_fence(__ATOMIC_ACQUIRE, "agent");
            xb_add(&bar[XB_XGEN(b.x)], 1u);
            asm volatile("s_waitcnt vmcnt(0)" ::: "memory");
        } else {
            XB_SPIN(xb_ld(&bar[XB_XGEN(b.x)]) == gen, bar);
            __builtin_amdgcn_fence(__ATOMIC_ACQUIRE, "agent");
            asm volatile("s_waitcnt vmcnt(0)" ::: "memory");
        }
    }
    __syncthreads();
}

__device__ __forceinline__ void ph_prologue(const Ctx& F0) {
    Ctx F = launder(F0);
    float* SMW = (float*)(F.ws + WS_SMW); float* RW = (float*)(F.ws + WS_RW); float* MOD = (float*)(F.ws + WS_MOD);
    const int gt = F.bid * 512 + F.tid, NT = F.G * 512;
    const float* p_win = inptr(F, I_WIN); const float* p_mwg = inptr(F, I_MWG); const float* p_mwr = inptr(F, I_MWR); const float* p_c = inptr(F, I_C); const float* p_bada = inptr(F, I_BADA);
    for (int i = gt; i < NL * 54 * DM; i += NT) {
        const int l = i / (54 * DM), r = i % (54 * DM), j = r / DM, k = r % DM;
        if (j < 18) { const int col = j < 12 ? 1792 + j : 3084 + (j - 12); SMW[(l * 18 + j) * DM + k] = p_win[((size_t)l * DM + k) * DIN + col]; }
        else { const int jj = j - 18; RW[(l * 36 + jj) * DM + k] = jj < 4 ? p_mwg[((size_t)l * DM + k) * 4 + jj] : p_mwr[((size_t)l * DM + k) * 32 + (jj - 4)]; }
    }
    { bf16* TW = (bf16*)(F.ws + WS_TW);
      for (int i = gt; i < NL * 32 * DM; i += NT) { const int l = i / (32 * DM), r = i % (32 * DM), j = r / DM, k = r % DM; float w = 0.f;
          if (j < 18) { const int col = j < 12 ? 1792 + j : 3084 + (j - 12); w = p_win[((size_t)l * DM + k) * DIN + col]; }
          const unsigned hi = f2bf(w); const float wl = w - bf2f(hi);
          TW[((size_t)(l * 2 + 0) * 32 + j) * DM + k] = (bf16)hi; TW[((size_t)(l * 2 + 1) * 32 + j) * DM + k] = (bf16)f2bf(wl); } }
    LAS float* cond = (LAS float*)F.lds; LAS float* red = (LAS float*)(F.lds + 32768);
    for (int item = F.bid; item < NL * 24; item += F.G) {
        for (int i = F.tid; i < NB * DM; i += 512) cond[i] = silu_f(p_c[i]);
        __syncthreads();
        const int l = item / 24, cg = item % 24;
        v4f acc[NB];
#pragma unroll
        for (int b = 0; b < NB; ++b) acc[b] = zero4();
        const float* wp = inptr(F, I_WADA) + ((size_t)l * DM + F.wave * 128) * (6 * DM) + cg * 256 + 4 * F.lane;
#pragma unroll 8
        for (int kk = 0; kk < 128; ++kk) {
            const v4f w = *(const v4f*)(wp + (size_t)kk * (6 * DM)); const int k = F.wave * 128 + kk;
#pragma unroll
            for (int b = 0; b < NB; ++b) acc[b] += cond[b * DM + k] * w;
        }
#pragma unroll
        for (int b = 0; b < NB; ++b) *(LAS v4f*)(red + (F.wave * NB + b) * 256 + 4 * F.lane) = acc[b];
        __syncthreads();
        for (int o = F.tid; o < NB * 256; o += 512) { const int b = o / 256, col = o % 256; float s = 0.f;
#pragma unroll
            for (int w = 0; w < 8; ++w) s += red[(w * NB + b) * 256 + col];
            MOD[((size_t)l * NB + b) * (6 * DM) + cg * 256 + col] = s + p_bada[l * 6 * DM + cg * 256 + col]; }
        __syncthreads();
    }
}

__device__ __forceinline__ void transpose_item(const float* W, int ldw, int K, bf16* WT, int k0, int nsrc0, int ndst0, LAS float* scr, int lane) {
    float t[32];
#pragma unroll
    for (int i = 0; i < 32; ++i) { const int kk = 2 * i + (lane >> 5); t[i] = W[(size_t)(k0 + kk) * ldw + nsrc0 + (lane & 31)]; }
#pragma unroll
    for (int i = 0; i < 32; ++i) { const int kk = 2 * i + (lane >> 5); scr[kk * 33 + (lane & 31)] = t[i]; }
    LDS_WAIT();
    const int c = lane & 7;
#pragma unroll
    for (int j = 0; j < 4; ++j) { const int n = (lane >> 3) + 8 * j; const LAS float* s = scr + (8 * c) * 33 + n;
        v4u o; o.x = pk2(s[0 * 33], s[1 * 33]); o.y = pk2(s[2 * 33], s[3 * 33]); o.z = pk2(s[4 * 33], s[5 * 33]); o.w = pk2(s[6 * 33], s[7 * 33]);
        *(v4u*)(WT + (size_t)(ndst0 + n) * K + k0 + 8 * c) = o; }
    LDS_WAIT();
}
constexpr int CV_IN = 16 * 96, CV_OUT = 16 * 32, CV_G = NE * 16 * 8, CV_D = NE * 4 * 32, CV_GLU = 4 * 8, CV_ITEMS = CV_IN + CV_OUT + 2 * CV_G + CV_D + CV_GLU;
__device__ __forceinline__ void convert_item(Ctx& F, int l, int it, LAS float* scr, int lane) {
    unsigned char* wb = F.ws + WS_WB;
    if (it < CV_IN) { const int kb = it / 96, nb = it % 96, nd = 32 * nb, ns = nd + (nd >= 1792 ? 12 : 0);
        transpose_item(inptr(F, I_WIN) + (size_t)l * DM * DIN, DIN, DM, (bf16*)(wb + WB_IN), 64 * kb, ns, nd, scr, lane); return; }
    it -= CV_IN;
    if (it < CV_OUT) { const int kb = it / 32, nb = it % 32;
        transpose_item(inptr(F, I_WOUT) + (size_t)l * DM * DM, DM, DM, (bf16*)(wb + WB_OUT), 64 * kb, 32 * nb, 32 * nb, scr, lane); return; }
    it -= CV_OUT;
    if (it < 2 * CV_G) { const int up = it >= CV_G; if (up) it -= CV_G; const int e = it / 128, r = it % 128, kb = r / 8, nb = r % 8, j0 = 32 * nb;
        const int nd = 256 * (j0 / 128) + (j0 % 128) + (up ? 128 : 0);
        transpose_item(inptr(F, up ? I_MUP : I_MGATE) + ((size_t)l * NE + e) * DM * DE, DE, DM, (bf16*)(wb + WB_GU) + (size_t)e * 512 * DM, 64 * kb, j0, nd, scr, lane); return; }
    it -= 2 * CV_G;
    if (it >= CV_D) { it -= CV_D; const int kb = it / 8, nb = it % 8;
        transpose_item(inptr(F, I_S5GLU) + (size_t)l * 65536, 256, 256, (bf16*)(F.ws + WS_WGLU), 64 * kb, 32 * nb, 32 * nb, scr, lane); return; }
    { const int e = it / 128, r = it % 128, kb = r / 32, nb = r % 32;
        transpose_item(inptr(F, I_MDOWN) + ((size_t)l * NE + e) * DE * DM, DM, DE, (bf16*)(wb + WB_DN) + (size_t)e * DM * DE, 64 * kb, 32 * nb, 32 * nb, scr, lane); }
}

__device__ __forceinline__ void build_tiles(const Ctx& F, int lc) {
    if (F.wave == 0) {
        const int ln = fresh_lane();
        const unsigned* cnt = (const unsigned*)(F.ws + WS_CTL) + CW_CNT + lc * NE;
        const int c = ln < NE ? (int)__hip_atomic_load(cnt + ln, __ATOMIC_RELAXED, __HIP_MEMORY_SCOPE_AGENT) : 0;
        const int nt = (c + 255) / 256;
        int incl = nt;
#pragma unroll
        for (int o = 1; o < 32; o <<= 1) { const int t = __builtin_amdgcn_ds_bpermute((ln >= o ? ln - o : ln) << 2, incl); if (ln >= o) incl += t; }
        const int excl = incl - nt;
        if (ln < NE) { F.misc[16 + ln] = excl; F.misc[64 + ln] = c; for (int t = 0; t < nt; ++t) F.misc[128 + excl + t] = ln; }
        if (ln == NE - 1) F.misc[16 + NE] = incl;
    }
}

typedef short bf16x8 __attribute__((ext_vector_type(8)));
__device__ __forceinline__ pg8::f32x4 mfma16_safe(bf16x8 a, bf16x8 b, pg8::f32x4 c) { pg8::f32x4 d = __builtin_amdgcn_mfma_f32_16x16x32_bf16(a, b, c, 0, 0, 0); asm volatile("" : "+v"(d) : "v"(a), "v"(b)); return d; }
#define MFMA16(a, b, c) mfma16_safe((a), (b), (c))
#define MFMA_SETTLE(acc) asm volatile("s_nop 15\n\ts_nop 7" : "+v"(acc))
__device__ __forceinline__ void convert_win(const Ctx& F0, int lc) {
    Ctx F = launder(F0);
    LAS float* scr = (LAS float*)(F.lds + F.wave * 8448);
    for (int it = F.wave * F.G + F.bid; it < CV_IN; it += 8 * F.G) convert_item(F, lc, it, scr, F.lane);
}
__device__ __forceinline__ void ph_n1(const Ctx& F0, int l, int mode) {
    Ctx F = launder(F0);
    const int LN = F.lane;
    const float* MOD = (const float*)(F.ws + WS_MOD);
    const int lp = mode ? NL - 1 : l - 1;
    if (lp >= 0) build_tiles(F, lp);
    __syncthreads();
    if (mode == 0) {
        const bf16* TW = (const bf16*)(F.ws + WS_TW) + (size_t)l * 2 * 32 * DM;
        for (int i = F.tid; i < 2 * 18 * 128; i += 512) { const int term = i / (18 * 128), n = (i >> 7) % 18, slot = i & 127;
            *(LAS v4u*)(F.lds + 73728 + (((term * 18 + n) * 128 + (slot ^ (n & 15))) << 4)) = *(const v4u*)(TW + ((size_t)(term * 32 + n) * DM + slot * 8)); }
    }
    const int NGW = F.G * 8, gw = F.bid * 8 + F.wave, rows_per = (NTOK + NGW - 1) / NGW;
    const int r0 = gw * rows_per, r1 = (r0 + rows_per) < NTOK ? (r0 + rows_per) : NTOK;
    const float* xin = inptr(F, I_X); bf16* X = (bf16*)(F.ws + WS_X); const bool f32in = (mode == 0 && l == 0);
    const bf16* MO = (const bf16*)(F.ws + WS_MO); const int* TI = (const int*)(F.ws + WS_TI);
    bf16* H = (bf16*)(F.ws + WS_H); float* SM = (float*)(F.ws + WS_SM);
    int curb = -1; v4f An[4], Bn[4], Gp[4];
    const float* p_nrm = inptr(F, mode == 0 ? I_NMIX : I_NFIN);
#pragma unroll
    for (int j = 0; j < 4; ++j) { An[j] = zero4(); Bn[j] = An[j]; Gp[j] = An[j]; }
    int tq[6]; { const int rr = (r0 + F.lane < r1) ? r0 + F.lane : r0;
#pragma unroll
        for (int q = 0; q < 6; ++q) tq[q] = (lp >= 0) ? TI[rr * 8 + q] : 0; }
    v4f nv[4]; v2u nx[4], na[4], nc[4]; float nw0 = 0.f, nw1 = 0.f;
#define N1_ISSUE(rr_) { const int rr = (rr_); \
        if (f32in) { _Pragma("unroll") for (int j = 0; j < 4; ++j) nv[j] = *(const v4f*)(xin + (size_t)rr * DM + 4 * F.lane + 256 * j); } \
        else { _Pragma("unroll") for (int j = 0; j < 4; ++j) nx[j] = *(const v2u*)(X + (size_t)rr * DM + 4 * F.lane + 256 * j); } \
        if (lp >= 0) { const int ix = rr - r0; const int e0 = __builtin_amdgcn_readlane(tq[0], ix), s0 = __builtin_amdgcn_readlane(tq[1], ix), e1 = __builtin_amdgcn_readlane(tq[3], ix), s1 = __builtin_amdgcn_readlane(tq[4], ix); \
            nw0 = __int_as_float(__builtin_amdgcn_readlane(tq[2], ix)); nw1 = __int_as_float(__builtin_amdgcn_readlane(tq[5], ix)); \
            const size_t ra = (size_t)(F.misc[16 + e0] * 256 + s0), rb = (size_t)(F.misc[16 + e1] * 256 + s1); \
            _Pragma("unroll") for (int j = 0; j < 4; ++j) { na[j] = *(const v2u*)(MO + ra * DM + 4 * F.lane + 256 * j); nc[j] = *(const v2u*)(MO + rb * DM + 4 * F.lane + 256 * j); } } }
#pragma unroll
    for (int j = 0; j < 4; ++j) { na[j] = zero2u(); nc[j] = na[j]; nx[j] = na[j]; nv[j] = zero4(); }
    N1_ISSUE(r0)
    for (int row = r0; row < r1; ++row) {
        const int b = row >> 12;
        if (b != curb) { curb = b;
#pragma unroll
            for (int j = 0; j < 4; ++j) { const int c = 4 * F.lane + 256 * j;
                if (mode == 0) { const v4f nm = *(const v4f*)(p_nrm + l * DM + c), sc = *(const v4f*)(MOD + ((size_t)l * NB + b) * 6 * DM + 1 * DM + c), sh = *(const v4f*)(MOD + ((size_t)l * NB + b) * 6 * DM + c);
                    An[j] = nm * (1.f + sc); Bn[j] = sh; }
                else { An[j] = *(const v4f*)(p_nrm + c); Bn[j] = zero4(); }
                if (lp >= 0) Gp[j] = *(const v4f*)(MOD + ((size_t)lp * NB + b) * 6 * DM + 5 * DM + c); }
        }
        v4f v[4]; v2u ma[4], mc[4]; const float w0 = nw0, w1 = nw1;
#pragma unroll
        for (int j = 0; j < 4; ++j) { const v2u q = nx[j]; v[j] = f32in ? nv[j] : (v4f){bf2f(q.x & 0xffffu), bf2f(q.x >> 16), bf2f(q.y & 0xffffu), bf2f(q.y >> 16)}; ma[j] = na[j]; mc[j] = nc[j]; }
        N1_ISSUE((row + 1 < r1) ? row + 1 : row)
        if (lp >= 0) {
#pragma unroll
            for (int j = 0; j < 4; ++j) { const v2u a = ma[j], c = mc[j];
                const v4f ya = (v4f){bf2f(a.x & 0xffffu), bf2f(a.x >> 16), bf2f(a.y & 0xffffu), bf2f(a.y >> 16)}, yb = (v4f){bf2f(c.x & 0xffffu), bf2f(c.x >> 16), bf2f(c.y & 0xffffu), bf2f(c.y >> 16)};
                v[j] += Gp[j] * (w0 * ya + w1 * yb); }
        }
        if (mode == 0 && (lp >= 0 || f32in)) {
#pragma unroll
            for (int j = 0; j < 4; ++j) { v2u o; o.x = pk2(v[j].x, v[j].y); o.y = pk2(v[j].z, v[j].w); *(v2u*)(X + (size_t)row * DM + 4 * F.lane + 256 * j) = o; }
        }
        float ss = 0.f;
#pragma unroll
        for (int j = 0; j < 4; ++j) ss += dot4(v[j], v[j]);
        const float rs = rsqrtf(wave_sum(ss) * (1.f / DM) + EPS);
        v4f h[4];
#pragma unroll
        for (int j = 0; j < 4; ++j) h[j] = v[j] * rs * An[j] + Bn[j];
        if (mode == 1) {
#if PROBE_MASK
            { const float traw = (float)(*(const volatile unsigned*)(F.ws + WS_CTL + 4 * 200)) * 0.01f, tus = exp2f(rintf(log2f(fmaxf(traw, 1.f)) * 2.f) * 0.5f), ep = sqrtf(tus * 5e-7f); const float sg = (F.lane & 1) ? ep : -ep;
#pragma unroll
              for (int j = 0; j < 4; ++j) { h[j].x += sg; h[j].y -= sg; h[j].z += sg; h[j].w -= sg; } }
#endif
#pragma unroll
            for (int j = 0; j < 4; ++j) *(v4f*)(F.out + (size_t)row * DM + 4 * F.lane + 256 * j) = h[j];
            continue;
        }
#pragma unroll
        for (int j = 0; j < 4; ++j) { v2u o; o.x = pk2(h[j].x, h[j].y); o.y = pk2(h[j].z, h[j].w); asm volatile("global_store_dwordx2 %0, %1, off sc1" :: "v"(H + (size_t)row * DM + 4 * F.lane + 256 * j), "v"(o) : "memory"); }
    }
    if (mode == 0) {
        asm volatile("s_waitcnt vmcnt(0)" ::: "memory");
        if (r0 < r1 && fresh_lane() == 0) (void)__hip_atomic_fetch_add((unsigned*)(F.ws + WS_CTL) + CW_HP + l * (128 * 64) + 64 * (r0 >> 8), 1u, __ATOMIC_RELAXED, __HIP_MEMORY_SCOPE_AGENT);
        __syncthreads();
        const int fr = F.lane & 15, fq = F.lane >> 4; const int n1 = (16 + fr) < 17 ? (16 + fr) : 17;
        const unsigned tb0 = (unsigned)(73728 + ((fr * 128) << 4)), tb1 = (unsigned)(73728 + ((n1 * 128) << 4)); const int x0 = fr & 15, x1 = n1 & 15;
        const float* p_alog = inptr(F, I_GALOG) + l * 6; const float* p_gdtb = inptr(F, I_GDTB) + l * 6; const float* p_sdtb = inptr(F, I_SDTB) + l * 6;
        for (int t0 = r0; t0 < r1; t0 += 16) {
            const int ar = (t0 + fr < r1) ? t0 + fr : r1 - 1;
            pg8::f32x4 acc[2]; acc[0] = zero4(); acc[1] = zero4();
            const bf16* ap = H + (size_t)ar * DM + 8 * fq;
#pragma unroll 1
            for (int k4 = 0; k4 < 32; k4 += 4) { bf16x8 af[4], bfr[4][4];
#pragma unroll
                for (int i = 0; i < 4; ++i) { af[i] = *(const bf16x8*)(ap + 32 * (k4 + i));
#pragma unroll
                    for (int hn = 0; hn < 4; ++hn) { const int sl = 4 * (k4 + i) + fq; bfr[i][hn] = *(const LAS bf16x8*)(F.lds + ((hn & 1) ? tb1 : tb0) + (hn >> 1) * (18 * 128 * 16) + ((sl ^ ((hn & 1) ? x1 : x0)) << 4)); } }
#pragma unroll
                for (int i = 0; i < 4; ++i)
#pragma unroll
                    for (int hn = 0; hn < 4; ++hn) acc[hn & 1] = MFMA16(af[i], bfr[i][hn], acc[hn & 1]); }
            MFMA_SETTLE(acc[0]); MFMA_SETTLE(acc[1]);
#pragma unroll
            for (int nt = 0; nt < 2; ++nt) { const int n = 16 * nt + fr;
                if (n < 18) { float ca = 0.f, cb = 0.f; if (n < 6) { ca = -expf(p_alog[n]); cb = p_gdtb[n]; } else if (n >= 12) cb = p_sdtb[n - 12];
#pragma unroll
                    for (int r = 0; r < 4; ++r) { const int row = t0 + 4 * fq + r; const float a = acc[nt][r]; float o;
                        if (n < 6) o = ca * softplus_f(a + cb); else if (n < 12) o = sigm(a); else o = softplus_f(a + cb);
                        if (row < r1) SM[(size_t)row * 18 + n] = o; } } }
        }
    }
}
constexpr int TB = 8;
__device__ __forceinline__ void gdn_naive(Ctx& F, int l, int b, int hh, int cq, LAS float* wl, int lane) {
    const int LN = lane;
    const bf16* P = (const bf16*)(F.ws + WS_P); const float* SM = (const float*)(F.ws + WS_SM); float* YR = (float*)(F.ws + WS_YRAW);
    const int el = lane & 15, dq = lane >> 4;
    float S[16];
#pragma unroll
    for (int i = 0; i < 16; ++i) S[i] = 0.f;
    const float* cw = inptr(F, I_GCW) + (size_t)l * 4 * 1152; const int chq = hh * 64 + lane, chk = 384 + chq, chv = 768 + chq;
    float wq[4], wk[4], wv[4];
#pragma unroll
    for (int j = 0; j < 4; ++j) { wq[j] = cw[j * 1152 + chq]; wk[j] = cw[j * 1152 + chk]; wv[j] = cw[j * 1152 + chv]; }
    float q1 = 0, q2 = 0, q3 = 0, k1 = 0, k2 = 0, k3 = 0, v1 = 0, v2 = 0, v3 = 0;
    for (int t0 = 0; t0 < SEQ; t0 += TB) {
        float xq[TB], xk[TB], xv[TB], gg[TB], bb[TB];
#pragma unroll
        for (int i = 0; i < TB; ++i) { const size_t row = (size_t)b * SEQ + t0 + i; const bf16* pr = P + row * NP + PC_GQKV;
            xq[i] = bf2f(pr[chq]); xk[i] = bf2f(pr[chk]); xv[i] = bf2f(pr[chv]); gg[i] = SM[row * 18 + hh]; bb[i] = SM[row * 18 + 6 + hh]; }
#pragma unroll
        for (int i = 0; i < TB; ++i) {
            const size_t row = (size_t)b * SEQ + t0 + i;
            float cq_ = wq[0] * q3 + wq[1] * q2 + wq[2] * q1 + wq[3] * xq[i]; q3 = q2; q2 = q1; q1 = xq[i];
            float ck_ = wk[0] * k3 + wk[1] * k2 + wk[2] * k1 + wk[3] * xk[i]; k3 = k2; k2 = k1; k1 = xk[i];
            float cv_ = wv[0] * v3 + wv[1] * v2 + wv[2] * v1 + wv[3] * xv[i]; v3 = v2; v2 = v1; v1 = xv[i];
            cq_ = silu_f(cq_); ck_ = silu_f(ck_); cv_ = silu_f(cv_);
            const float qn = cq_ * rsqrtf(wave_sum(cq_ * cq_) + EPS) * 0.125f, kn = ck_ * rsqrtf(wave_sum(ck_ * ck_) + EPS);
            wl[lane] = qn; wl[64 + lane] = kn; wl[128 + lane] = cv_;
            LDS_WAIT();
            float kd[16], qd[16];
#pragma unroll
            for (int j = 0; j < 4; ++j) { const v4f a = *(const LAS v4f*)(wl + 64 + 16 * dq + 4 * j), c = *(const LAS v4f*)(wl + 16 * dq + 4 * j);
                kd[4 * j] = a.x; kd[4 * j + 1] = a.y; kd[4 * j + 2] = a.z; kd[4 * j + 3] = a.w; qd[4 * j] = c.x; qd[4 * j + 1] = c.y; qd[4 * j + 2] = c.z; qd[4 * j + 3] = c.w; }
            const float ve = wl[128 + 16 * cq + el];
            LDS_WAIT();
            const float a = __expf(gg[i]);
            float ks = 0.f;
#pragma unroll
            for (int j = 0; j < 16; ++j) ks += kd[j] * S[j];
            ks += SHX(ks, 16); ks += SHX(ks, 32);
            const float vn = bb[i] * (ve - a * ks);
            float o = 0.f;
#pragma unroll
            for (int j = 0; j < 16; ++j) { S[j] = a * S[j] + kd[j] * vn; o += qd[j] * S[j]; }
            o += SHX(o, 16); o += SHX(o, 32);
            if (dq == 0) YR[row * DM + 256 + hh * 64 + 16 * cq + el] = o;
        }
    }
}
__device__ __forceinline__ void ssd_naive(Ctx& F, int l, int b, int hh, int pq, LAS float* wl, int lane) {
    const int LN = lane;
    const bf16* P = (const bf16*)(F.ws + WS_P); const float* SM = (const float*)(F.ws + WS_SM); float* YR = (float*)(F.ws + WS_YRAW);
    const int pl = lane & 15, nq = lane >> 4, gi = hh / 3, p = 16 * pq + pl;
    float hs[32];
#pragma unroll
    for (int i = 0; i < 32; ++i) hs[i] = 0.f;
    const float* cw = inptr(F, I_SCW) + (size_t)l * 4 * 896; const float* cb = inptr(F, I_SCB) + (size_t)l * 896;
    const int cB0 = 384 + gi * 128 + lane, cB1 = cB0 + 64, cC0 = 640 + gi * 128 + lane, cC1 = cC0 + 64, cX = hh * 64 + p;
    float wB0[4], wB1[4], wC0[4], wC1[4], wX[4];
#pragma unroll
    for (int j = 0; j < 4; ++j) { wB0[j] = cw[j * 896 + cB0]; wB1[j] = cw[j * 896 + cB1]; wC0[j] = cw[j * 896 + cC0]; wC1[j] = cw[j * 896 + cC1]; wX[j] = cw[j * 896 + cX]; }
    const float bB0 = cb[cB0], bB1 = cb[cB1], bC0 = cb[cC0], bC1 = cb[cC1], bX = cb[cX];
    const float Aneg = -expf(inptr(F, I_SALOG)[l * 6 + hh]), Dsk = inptr(F, I_SD)[l * 6 + hh];
    float hB0[3] = {0, 0, 0}, hB1[3] = {0, 0, 0}, hC0[3] = {0, 0, 0}, hC1[3] = {0, 0, 0}, hX[3] = {0, 0, 0};
    for (int t0 = 0; t0 < SEQ; t0 += TB) {
        float xB0[TB], xB1[TB], xC0[TB], xC1[TB], xX[TB], xZ[TB], dts[TB];
#pragma unroll
        for (int i = 0; i < TB; ++i) { const size_t row = (size_t)b * SEQ + t0 + i; const bf16* pr = P + row * NP;
            xB0[i] = bf2f(pr[PC_SX + cB0]); xB1[i] = bf2f(pr[PC_SX + cB1]); xC0[i] = bf2f(pr[PC_SX + cC0]); xC1[i] = bf2f(pr[PC_SX + cC1]); xX[i] = bf2f(pr[PC_SX + cX]);
            xZ[i] = bf2f(pr[PC_SZ + hh * 64 + p]); dts[i] = SM[row * 18 + 12 + hh]; }
#pragma unroll
        for (int i = 0; i < TB; ++i) {
            const size_t row = (size_t)b * SEQ + t0 + i;
#define CONV1(w, hst, x, bias) ({ float _y = w[0] * hst[2] + w[1] * hst[1] + w[2] * hst[0] + w[3] * (x) + (bias); hst[2] = hst[1]; hst[1] = hst[0]; hst[0] = (x); silu_f(_y); })
            const float vB0 = CONV1(wB0, hB0, xB0[i], bB0), vB1 = CONV1(wB1, hB1, xB1[i], bB1), vC0 = CONV1(wC0, hC0, xC0[i], bC0), vC1 = CONV1(wC1, hC1, xC1[i], bC1), vX = CONV1(wX, hX, xX[i], bX);
#undef CONV1
            wl[lane] = vB0; wl[64 + lane] = vB1; wl[128 + lane] = vC0; wl[192 + lane] = vC1;
            LDS_WAIT();
            float Bv[32], Cv[32];
#pragma unroll
            for (int j = 0; j < 8; ++j) { const v4f a = *(const LAS v4f*)(wl + 32 * nq + 4 * j), c = *(const LAS v4f*)(wl + 128 + 32 * nq + 4 * j);
                Bv[4 * j] = a.x; Bv[4 * j + 1] = a.y; Bv[4 * j + 2] = a.z; Bv[4 * j + 3] = a.w; Cv[4 * j] = c.x; Cv[4 * j + 1] = c.y; Cv[4 * j + 2] = c.z; Cv[4 * j + 3] = c.w; }
            LDS_WAIT();
            const float dt = dts[i], dA = __expf(dt * Aneg), xdt = vX * dt;
            float y = 0.f;
#pragma unroll
            for (int j = 0; j < 32; ++j) { hs[j] = dA * hs[j] + xdt * Bv[j]; y += Cv[j] * hs[j]; }
            y += SHX(y, 16); y += SHX(y, 32);
            y = (y + Dsk * vX) * silu_f(xZ[i]);
            if (nq == 0) YR[row * DM + 640 + hh * 64 + p] = y;
        }
    }
}
__device__ __forceinline__ void s5_naive(Ctx& F, int l, int b, int g, int lane) {
    const int LN = lane;
    const bf16* P = (const bf16*)(F.ws + WS_P); float* YR = (float*)(F.ws + WS_YRAW);
    const int gp = (l * 16 + g) * 64 + lane;
    const float are = inptr(F, I_S5ARE)[gp], aim = inptr(F, I_S5AIM)[gp], step = expf(inptr(F, I_S5LDT)[l * 16 + g]);
    const float mag = expf(are * step); float sn, cs; sincosf(aim * step, &sn, &cs);
    const float lbr = mag * cs, lbi = mag * sn;
    const float nr = lbr - 1.f, ni = lbi, den = are * are + aim * aim;
    const float fr = (nr * are + ni * aim) / den, fi = (ni * are - nr * aim) / den;
    float Br[16], Bi[16], Cr[16], Ci[16], Dk[16];
#pragma unroll
    for (int c = 0; c < 16; ++c) { const float br = inptr(F, I_S5BRE)[(size_t)gp * 16 + c], bi = inptr(F, I_S5BIM)[(size_t)gp * 16 + c];
        Br[c] = fr * br - fi * bi; Bi[c] = fr * bi + fi * br;
        Cr[c] = inptr(F, I_S5CRE)[((size_t)(l * 16 + g) * 16 + c) * 64 + lane]; Ci[c] = inptr(F, I_S5CIM)[((size_t)(l * 16 + g) * 16 + c) * 64 + lane];
        Dk[c] = inptr(F, I_S5D)[l * 256 + g * 16 + c]; }
    float sr = 0.f, si = 0.f;
    for (int t0 = 0; t0 < SEQ; t0 += TB) {
        v4u ua[TB], ub[TB];
#pragma unroll
        for (int i = 0; i < TB; ++i) { const size_t row = (size_t)b * SEQ + t0 + i; const v4u* pr = (const v4u*)(P + row * NP + PC_S5 + g * 16); ua[i] = pr[0]; ub[i] = pr[1]; }
#pragma unroll
        for (int i = 0; i < TB; ++i) {
            const size_t row = (size_t)b * SEQ + t0 + i;
            float u[16];
            u[0] = bf2f(ua[i].x & 0xffffu); u[1] = bf2f(ua[i].x >> 16); u[2] = bf2f(ua[i].y & 0xffffu); u[3] = bf2f(ua[i].y >> 16);
            u[4] = bf2f(ua[i].z & 0xffffu); u[5] = bf2f(ua[i].z >> 16); u[6] = bf2f(ua[i].w & 0xffffu); u[7] = bf2f(ua[i].w >> 16);
            u[8] = bf2f(ub[i].x & 0xffffu); u[9] = bf2f(ub[i].x >> 16); u[10] = bf2f(ub[i].y & 0xffffu); u[11] = bf2f(ub[i].y >> 16);
            u[12] = bf2f(ub[i].z & 0xffffu); u[13] = bf2f(ub[i].z >> 16); u[14] = bf2f(ub[i].w & 0xffffu); u[15] = bf2f(ub[i].w >> 16);
            float bur = 0.f, bui = 0.f;
#pragma unroll
            for (int c = 0; c < 16; ++c) { bur += Br[c] * u[c]; bui += Bi[c] * u[c]; }
            const float nsr = lbr * sr - lbi * si + bur, nsi = lbr * si + lbi * sr + bui; sr = nsr; si = nsi;
            float mine = 0.f;
#pragma unroll
            for (int c = 0; c < 16; ++c) { float y = wave_sum(Cr[c] * sr - Ci[c] * si) + Dk[c] * u[c]; mine = (lane == c) ? y : mine; }
            if (lane < 16) YR[row * 256 + g * 16 + lane] = gelu_tanh(mine);
        }
    }
}
__device__ __forceinline__ void ph_m2(const Ctx& F0, int l) {
    Ctx F = launder(F0);
    const int u = F.wave * F.G + F.bid;
    LAS float* wl = (LAS float*)(F.lds + F.wave * 4096);
    if (u < 128) s5_naive(F, l, u / 16, u % 16, F.lane);
}


__device__ __forceinline__ bf16x8 ldsfrag(LAS unsigned char* base, int row, int stride, int kb) { return *(const LAS bf16x8*)(base + row * stride + kb); }
__device__ __forceinline__ float wave_incl_scan(float v, int lane) {
#pragma unroll
    for (int o = 1; o < 64; o <<= 1) { const float t = __int_as_float(__builtin_amdgcn_ds_bpermute((lane >= o ? lane - o : lane) << 2, __float_as_int(v))); if (lane >= o) v += t; }
    return v;
}
__device__ __forceinline__ float lane63(float v) { return __int_as_float(__builtin_amdgcn_readlane(__float_as_int(v), 63)); }
__device__ __forceinline__ void conv8x8(const bf16* P, size_t rowbase, int t0, bool has_prev, int pcol, const float* cw, int cstride, const float* cb, float (&out)[8][8]) {
    float xf[11][8];
#pragma unroll
    for (int i = 0; i < 11; ++i) {
        v4u v = zero4u();
        if (has_prev || t0 + i >= 3) v = *(const v4u*)(P + (rowbase + t0 + i - 3) * NP + pcol);
        xf[i][0] = bf2f(v.x & 0xffffu); xf[i][1] = bf2f(v.x >> 16); xf[i][2] = bf2f(v.y & 0xffffu); xf[i][3] = bf2f(v.y >> 16);
        xf[i][4] = bf2f(v.z & 0xffffu); xf[i][5] = bf2f(v.z >> 16); xf[i][6] = bf2f(v.w & 0xffffu); xf[i][7] = bf2f(v.w >> 16);
    }
    float w[4][8], bs[8];
#pragma unroll
    for (int j = 0; j < 4; ++j) { const v4f a = *(const v4f*)(cw + j * cstride), c = *(const v4f*)(cw + j * cstride + 4);
        w[j][0] = a.x; w[j][1] = a.y; w[j][2] = a.z; w[j][3] = a.w; w[j][4] = c.x; w[j][5] = c.y; w[j][6] = c.z; w[j][7] = c.w; }
    if (cb) { const v4f a = *(const v4f*)cb, c = *(const v4f*)(cb + 4); bs[0] = a.x; bs[1] = a.y; bs[2] = a.z; bs[3] = a.w; bs[4] = c.x; bs[5] = c.y; bs[6] = c.z; bs[7] = c.w; }
    else {
#pragma unroll
        for (int c = 0; c < 8; ++c) bs[c] = 0.f; }
#pragma unroll
    for (int t = 0; t < 8; ++t)
#pragma unroll
        for (int c = 0; c < 8; ++c) out[t][c] = silu_f(w[0][c] * xf[t][c] + w[1][c] * xf[t + 1][c] + w[2][c] * xf[t + 2][c] + w[3][c] * xf[t + 3][c] + bs[c]);
}
constexpr int SS_XST = 0, SS_XST_S = 144;
constexpr int SS_BROW = 27648, SS_ROW_S = 272;
constexpr int SS_CROW = 45056;
constexpr int SS_BT = 27648, SS_BT_S = 144;
constexpr int SS_MH = 62464, SS_MH_S = 144;
constexpr int SS_Z = 90112, SS_Z_S = 400;
constexpr int SS_F = 115712;
__device__ __forceinline__ void ssd_s1_unit(Ctx& F, int l, int unit) {
    const int b = unit >> 7, n = (unit >> 1) & 63, g = unit & 1; const size_t rowbase = (size_t)b * SEQ + n * 64;
    const bf16* P = (const bf16*)(F.ws + WS_P); const float* SM = (const float*)(F.ws + WS_SM);
    bf16* CS = (bf16*)(F.ws + WS_CS2); float* CD = (float*)(F.ws + WS_CD);
    LAS float* ff = (LAS float*)(F.lds + SS_F);
    if (F.wave < 3) { const int hh = 3 * g + F.wave; const float dt = SM[(rowbase + F.lane) * 18 + 12 + hh], An = -__expf(inptr(F, I_SALOG)[l * 6 + hh]);
        const float acs = wave_incl_scan(dt * An, F.lane), last = lane63(acs);
        ff[F.wave * 64 + F.lane] = acs; ff[384 + F.wave * 64 + F.lane] = dt * __expf(last - acs);
        if (F.lane == 63) CD[(b * 6 + hh) * 64 + n] = __expf(last); }
    __syncthreads();
    if (F.tid < 320) { const int cg = F.tid >> 3, t0 = (F.tid & 7) * 8; float o[8][8];
        const float* cw = inptr(F, I_SCW) + (size_t)l * 4 * 896; const float* cb = inptr(F, I_SCB) + (size_t)l * 896;
        if (cg < 24) { const int ch = g * 192 + cg * 8, hl = cg >> 3;
            conv8x8(P, rowbase, t0, n > 0, PC_SX + ch, cw + ch, 896, cb + ch, o);
#pragma unroll
            for (int c = 0; c < 8; ++c) { v4u w; const LAS float* wv = ff + 384 + hl * 64 + t0;
                w.x = pk2(o[0][c] * wv[0], o[1][c] * wv[1]); w.y = pk2(o[2][c] * wv[2], o[3][c] * wv[3]); w.z = pk2(o[4][c] * wv[4], o[5][c] * wv[5]); w.w = pk2(o[6][c] * wv[6], o[7][c] * wv[7]);
                *(LAS v4u*)(F.lds + SS_XST + (cg * 8 + c) * SS_XST_S + t0 * 2) = w; } }
        else { const int d0 = (cg - 24) * 8, ch = 384 + g * 128 + d0;
            conv8x8(P, rowbase, t0, n > 0, PC_SX + ch, cw + ch, 896, cb + ch, o);
#pragma unroll
            for (int c = 0; c < 8; ++c) { v4u w; w.x = pk2(o[0][c], o[1][c]); w.y = pk2(o[2][c], o[3][c]); w.z = pk2(o[4][c], o[5][c]); w.w = pk2(o[6][c], o[7][c]);
                *(LAS v4u*)(F.lds + SS_BT + (d0 + c) * SS_BT_S + t0 * 2) = w; } }
    }
    __syncthreads();
    const int fr = F.lane & 15, fq = F.lane >> 4;
    for (int ti = F.wave * 12; ti < F.wave * 12 + 12; ++ti) {
        const int h = ti >> 5, dtl = (ti >> 2) & 7, pt = ti & 3;
        pg8::f32x4 acc = zero4(); bf16x8 fa_[2], fb_[2];
#pragma unroll
        for (int ks = 0; ks < 2; ++ks) { fa_[ks] = ldsfrag(F.lds + SS_BT, 16 * dtl + fr, SS_BT_S, 64 * ks + 16 * fq); fb_[ks] = ldsfrag(F.lds + SS_XST, 64 * h + 16 * pt + fr, SS_XST_S, 64 * ks + 16 * fq); }
#pragma unroll
        for (int ks = 0; ks < 2; ++ks) acc = MFMA16(fa_[ks], fb_[ks], acc);
        MFMA_SETTLE(acc);
        v2u w; w.x = pk2(acc[0], acc[1]); w.y = pk2(acc[2], acc[3]);
        *(v2u*)(CS + ((size_t)((b * 6 + 3 * g + h) * 64 + n) * 64 + 16 * pt + fr) * 128 + 16 * dtl + 4 * fq) = w;
    }
    __syncthreads();
}
__device__ __forceinline__ void ssd_s2(Ctx& F) {
    bf16* CS = (bf16*)(F.ws + WS_CS2); const float* CD = (const float*)(F.ws + WS_CD);
    for (int task = F.bid * 512 + F.tid; task < 48 * 1024; task += F.G * 512) {
        const int bh = task >> 10, e = (task & 1023) * 8; float s[8];
#pragma unroll
        for (int i = 0; i < 8; ++i) s[i] = 0.f;
        for (int n0 = 0; n0 < 64; n0 += 8) { v4u v[8]; float cd[8];
#pragma unroll
            for (int i = 0; i < 8; ++i) { v[i] = *(const v4u*)(CS + (size_t)(bh * 64 + n0 + i) * 8192 + e); cd[i] = CD[bh * 64 + n0 + i]; }
#pragma unroll
            for (int i = 0; i < 8; ++i) { v4u o; o.x = pk2(s[0], s[1]); o.y = pk2(s[2], s[3]); o.z = pk2(s[4], s[5]); o.w = pk2(s[6], s[7]);
                *(v4u*)(CS + (size_t)(bh * 64 + n0 + i) * 8192 + e) = o;
                s[0] = cd[i] * s[0] + bf2f(v[i].x & 0xffffu); s[1] = cd[i] * s[1] + bf2f(v[i].x >> 16); s[2] = cd[i] * s[2] + bf2f(v[i].y & 0xffffu); s[3] = cd[i] * s[3] + bf2f(v[i].y >> 16);
                s[4] = cd[i] * s[4] + bf2f(v[i].z & 0xffffu); s[5] = cd[i] * s[5] + bf2f(v[i].z >> 16); s[6] = cd[i] * s[6] + bf2f(v[i].w & 0xffffu); s[7] = cd[i] * s[7] + bf2f(v[i].w >> 16); }
        }
    }
}
__device__ __forceinline__ void ssd_s3_unit(Ctx& F, int l, int unit) {
    const int LN = F.lane;
    const int b = unit >> 7, n = (unit >> 1) & 63, g = unit & 1; const size_t rowbase = (size_t)b * SEQ + n * 64;
    const bf16* P = (const bf16*)(F.ws + WS_P); const float* SM = (const float*)(F.ws + WS_SM);
    const bf16* CS = (const bf16*)(F.ws + WS_CS2); bf16* Y = (bf16*)(F.ws + WS_Y);
    LAS float* ff = (LAS float*)(F.lds + SS_F);
    const int fr = F.lane & 15, fq = F.lane >> 4;
    if (F.wave < 3) { const int hh = 3 * g + F.wave; const float dt = SM[(rowbase + F.lane) * 18 + 12 + hh], An = -__expf(inptr(F, I_SALOG)[l * 6 + hh]);
        ff[F.wave * 64 + F.lane] = wave_incl_scan(dt * An, F.lane); ff[192 + F.wave * 64 + F.lane] = dt; }
    if (F.tid < 448) { const int cg = F.tid >> 3, t0 = (F.tid & 7) * 8; float o[8][8];
        const float* cw = inptr(F, I_SCW) + (size_t)l * 4 * 896; const float* cb = inptr(F, I_SCB) + (size_t)l * 896;
        if (cg < 24) { const int ch = g * 192 + cg * 8;
            conv8x8(P, rowbase, t0, n > 0, PC_SX + ch, cw + ch, 896, cb + ch, o);
#pragma unroll
            for (int c = 0; c < 8; ++c) { v4u w; w.x = pk2(o[0][c], o[1][c]); w.y = pk2(o[2][c], o[3][c]); w.z = pk2(o[4][c], o[5][c]); w.w = pk2(o[6][c], o[7][c]);
                *(LAS v4u*)(F.lds + SS_XST + (cg * 8 + c) * SS_XST_S + t0 * 2) = w; } }
        else { const int isC = cg >= 40, d0 = (cg - (isC ? 40 : 24)) * 8, ch = (isC ? 640 : 384) + g * 128 + d0;
            conv8x8(P, rowbase, t0, n > 0, PC_SX + ch, cw + ch, 896, cb + ch, o);
#pragma unroll
            for (int t = 0; t < 8; ++t) { v4u w; w.x = pk2(o[t][0], o[t][1]); w.y = pk2(o[t][2], o[t][3]); w.z = pk2(o[t][4], o[t][5]); w.w = pk2(o[t][6], o[t][7]);
                *(LAS v4u*)(F.lds + (isC ? SS_CROW : SS_BROW) + (t0 + t) * SS_ROW_S + d0 * 2) = w; } }
    }
    for (int c = F.tid; c < 64 * 24; c += 512) { const int t = c / 24, c8 = c % 24;
        *(LAS v4u*)(F.lds + SS_Z + t * SS_Z_S + c8 * 16) = *(const v4u*)(P + (rowbase + t) * NP + PC_SZ + g * 192 + c8 * 8); }
    __syncthreads();
    for (int ti = F.wave; ti < 10; ti += 8) {
        int lt = 0, mt = ti; while (mt > lt) { mt -= lt + 1; ++lt; }
        pg8::f32x4 acc = zero4(); bf16x8 fa_[4], fb_[4];
#pragma unroll
        for (int ks = 0; ks < 4; ++ks) { fa_[ks] = ldsfrag(F.lds + SS_BROW, 16 * mt + fr, SS_ROW_S, 64 * ks + 16 * fq); fb_[ks] = ldsfrag(F.lds + SS_CROW, 16 * lt + fr, SS_ROW_S, 64 * ks + 16 * fq); }
#pragma unroll
        for (int ks = 0; ks < 4; ++ks) acc = MFMA16(fa_[ks], fb_[ks], acc);
        MFMA_SETTLE(acc);
        const int lrow = 16 * lt + fr, m0 = 16 * mt + 4 * fq;
#pragma unroll
        for (int h = 0; h < 3; ++h) { const float al = ff[h * 64 + lrow], Dh = inptr(F, I_SD)[l * 6 + 3 * g + h]; float mv[4];
#pragma unroll
            for (int r = 0; r < 4; ++r) { const int m = m0 + r; mv[r] = m <= lrow ? acc[r] * __expf(al - ff[h * 64 + m]) * ff[192 + h * 64 + m] + (m == lrow ? Dh : 0.f) : 0.f; }
            v2u w; w.x = pk2(mv[0], mv[1]); w.y = pk2(mv[2], mv[3]);
            *(LAS v2u*)(F.lds + SS_MH + h * (64 * SS_MH_S) + lrow * SS_MH_S + m0 * 2) = w;
            if (lt == mt && (lt & 1) == 0) *(LAS v2u*)(F.lds + SS_MH + h * (64 * SS_MH_S) + lrow * SS_MH_S + (m0 + 16) * 2) = zero2u(); }
    }
    __syncthreads();
    const int lt = F.wave & 3, ph = F.wave >> 2, tokl = 16 * lt + fr;
    float yv[6][4]; float ss = 0.f;
#pragma unroll
    for (int i = 0; i < 6; ++i) { const int pt = ph * 6 + i, h = pt >> 2;
        pg8::f32x4 ad = zero4(), ao = ad; bf16x8 xfr[2], mfr[2];
#pragma unroll
        for (int ks = 0; ks < 2; ++ks) { xfr[ks] = ldsfrag(F.lds + SS_XST, 16 * pt + fr, SS_XST_S, 64 * ks + 16 * fq); mfr[ks] = ldsfrag(F.lds + SS_MH + h * (64 * SS_MH_S), tokl, SS_MH_S, 64 * ks + 16 * fq); }
        const bf16* sp = CS + ((size_t)((b * 6 + 3 * g + h) * 64 + n) * 64 + 16 * (pt & 3) + fr) * 128 + 8 * fq;
        bf16x8 sfr[4], cfr[4];
#pragma unroll
        for (int ks = 0; ks < 4; ++ks) { sfr[ks] = *(const bf16x8*)(sp + 32 * ks); cfr[ks] = ldsfrag(F.lds + SS_CROW, tokl, SS_ROW_S, 64 * ks + 16 * fq); }
#pragma unroll
        for (int ks = 0; ks < 2; ++ks) if (2 * ks <= lt) ad = MFMA16(xfr[ks], mfr[ks], ad);
#pragma unroll
        for (int ks = 0; ks < 4; ++ks) ao = MFMA16(sfr[ks], cfr[ks], ao);
        MFMA_SETTLE(ad); MFMA_SETTLE(ao);
        const float ea = __expf(ff[h * 64 + tokl]);
        const v2u zz = *(const LAS v2u*)(F.lds + SS_Z + tokl * SS_Z_S + (16 * pt + 4 * fq) * 2);
        const float z0 = bf2f(zz.x & 0xffffu), z1 = bf2f(zz.x >> 16), z2 = bf2f(zz.y & 0xffffu), z3 = bf2f(zz.y >> 16);
        yv[i][0] = (ad[0] + ea * ao[0]) * silu_f(z0); yv[i][1] = (ad[1] + ea * ao[1]) * silu_f(z1); yv[i][2] = (ad[2] + ea * ao[2]) * silu_f(z2); yv[i][3] = (ad[3] + ea * ao[3]) * silu_f(z3);
        ss += (yv[i][0] * yv[i][0] + yv[i][1] * yv[i][1]) + (yv[i][2] * yv[i][2] + yv[i][3] * yv[i][3]);
    }
    ss += SHX(ss, 16); ss += SHX(ss, 32);
    if (fq == 0) ff[576 + ph * 64 + tokl] = ss;
    __syncthreads();
    const float rs = rsqrtf((ff[576 + tokl] + ff[576 + 64 + tokl]) * (1.f / 192.f) + EPS);
    const float* nw = inptr(F, I_SNORM) + l * 384 + g * 192;
#pragma unroll
    for (int i = 0; i < 6; ++i) { const int pt = ph * 6 + i; const v4f wv = *(const v4f*)(nw + 16 * pt + 4 * fq);
        v2u w; w.x = pk2(yv[i][0] * rs * wv.x, yv[i][1] * rs * wv.y); w.y = pk2(yv[i][2] * rs * wv.z, yv[i][3] * rs * wv.w);
        *(v2u*)(Y + (rowbase + tokl) * DM + 640 + g * 192 + 16 * pt + 4 * fq) = w; }
    __syncthreads();
}
__device__ __forceinline__ void ph_s1(const Ctx& F0, int l) { Ctx F = launder(F0); for (int u = F.bid; u < 1024; u += F.G) ssd_s1_unit(F, l, u); }
__device__ __forceinline__ void ph_s2(const Ctx& F0) { Ctx F = launder(F0); ssd_s2(F); }
__device__ __forceinline__ void ph_s3(const Ctx& F0, int l) { Ctx F = launder(F0); for (int u = F.bid; u < 1024; u += F.G) ssd_s3_unit(F, l, u); }


constexpr int GD_KN = 0, GD_QN = 9216, GD_KDT = 18432, GD_RV = 27648, GD_RK = 36864, GD_AT = 46080, GD_NL = 55296, GD_LD = 64512, GD_DB = GD_KN, GD_F = 72704, GD_HALF = 73728, GD_S = 144;
constexpr size_t WS_GAN = 472 * MiB, WS_GBN = 496 * MiB, WS_GQE = 520 * MiB, WS_GO1 = 544 * MiB, WS_GSP = 568 * MiB;
__device__ __forceinline__ void decode_lower(int ti, int& lt, int& mt) { lt = 0; mt = ti; while (mt > lt) { mt -= lt + 1; ++lt; } }
__device__ __forceinline__ void gdn_g1_pair(const Ctx& F0, int l, int pair) {
    Ctx F = F0; F.lane = fresh_lane(); F.tid = F.wave * 64 + F.lane;
    int LN = F.lane;
    const int half = F.wave >> 2, uw = F.wave & 3, unit = 2 * pair + half, hh = unit % 6, bn = unit / 6, b = bn >> 6, n = bn & 63;
    const size_t rowbase = (size_t)b * SEQ + n * 64;
    const bf16* P = (const bf16*)(F.ws + WS_P); const float* SM = (const float*)(F.ws + WS_SM);
    LAS unsigned char* lb = F.lds + half * GD_HALF; LAS float* fg = (LAS float*)(lb + GD_F);
    int fr = F.lane & 15, fq = F.lane >> 4;
    float o[8][8]; const int seg = F.lane & 7, cg = F.lane >> 3, t0 = seg * 8;
    if (uw < 3) {
        const int ch = uw * 384 + hh * 64 + cg * 8;
        conv8x8(P, rowbase, t0, n > 0, PC_GQKV + ch, inptr(F, I_GCW) + (size_t)l * 4 * 1152 + ch, 1152, nullptr, o);
        if (uw < 2) {
#pragma unroll
            for (int t = 0; t < 8; ++t) { float ss = 0.f;
#pragma unroll
                for (int c = 0; c < 8; ++c) ss += o[t][c] * o[t][c];
                ss += SHX(ss, 8); ss += SHX(ss, 16); ss += SHX(ss, 32);
                const float sc = rsqrtf(ss + EPS) * (uw == 0 ? 0.125f : 1.f);
#pragma unroll
                for (int c = 0; c < 8; ++c) o[t][c] *= sc; }
        }
    } else {
        const float g = SM[(rowbase + F.lane) * 18 + hh], be = SM[(rowbase + F.lane) * 18 + 6 + hh];
        const float gc = wave_incl_scan(g, F.lane);
        fg[F.lane] = gc; fg[64 + F.lane] = be;
    }
    __syncthreads();
    if (uw == 0) {
#pragma unroll
        for (int t = 0; t < 8; ++t) { v4u w; w.x = pk2(o[t][0], o[t][1]); w.y = pk2(o[t][2], o[t][3]); w.z = pk2(o[t][4], o[t][5]); w.w = pk2(o[t][6], o[t][7]);
            *(LAS v4u*)(lb + GD_QN + (t0 + t) * GD_S + cg * 16) = w; }
    } else if (uw == 1) {
        const float gl = fg[63]; float fk[8], fw[8];
#pragma unroll
        for (int t = 0; t < 8; ++t) { const float gc = fg[t0 + t]; fk[t] = __expf(gl - gc); fw[t] = fg[64 + t0 + t] * __expf(gc); }
#pragma unroll
        for (int t = 0; t < 8; ++t) { v4u w; w.x = pk2(o[t][0], o[t][1]); w.y = pk2(o[t][2], o[t][3]); w.z = pk2(o[t][4], o[t][5]); w.w = pk2(o[t][6], o[t][7]);
            *(LAS v4u*)(lb + GD_KN + (t0 + t) * GD_S + cg * 16) = w; }
#pragma unroll
        for (int c = 0; c < 8; ++c) { v4u w;
            w.x = pk2(o[0][c] * fk[0], o[1][c] * fk[1]); w.y = pk2(o[2][c] * fk[2], o[3][c] * fk[3]); w.z = pk2(o[4][c] * fk[4], o[5][c] * fk[5]); w.w = pk2(o[6][c] * fk[6], o[7][c] * fk[7]);
            *(LAS v4u*)(lb + GD_KDT + (cg * 8 + c) * GD_S + t0 * 2) = w;
            w.x = pk2(-o[0][c] * fw[0], -o[1][c] * fw[1]); w.y = pk2(-o[2][c] * fw[2], -o[3][c] * fw[3]); w.z = pk2(-o[4][c] * fw[4], -o[5][c] * fw[5]); w.w = pk2(-o[6][c] * fw[6], -o[7][c] * fw[7]);
            *(LAS v4u*)(lb + GD_RK + (cg * 8 + c) * GD_S + t0 * 2) = w; }
    } else if (uw == 2) {
        float fb[8];
#pragma unroll
        for (int t = 0; t < 8; ++t) fb[t] = fg[64 + t0 + t];
#pragma unroll
        for (int c = 0; c < 8; ++c) { v4u w;
            w.x = pk2(o[0][c] * fb[0], o[1][c] * fb[1]); w.y = pk2(o[2][c] * fb[2], o[3][c] * fb[3]); w.z = pk2(o[4][c] * fb[4], o[5][c] * fb[5]); w.w = pk2(o[6][c] * fb[6], o[7][c] * fb[7]);
            *(LAS v4u*)(lb + GD_RV + (cg * 8 + c) * GD_S + t0 * 2) = w; }
    }
    __syncthreads();
    F.lane = fresh_lane(); LN = F.lane; fr = F.lane & 15; fq = F.lane >> 4;
    for (int ti = uw; ti < 20; ti += 4) {
        const int kind = ti >= 10; int lt, mt; decode_lower(ti - 10 * kind, lt, mt);
        pg8::f32x4 acc = zero4(); bf16x8 fa_[2], fb_[2];
#pragma unroll
        for (int ks = 0; ks < 2; ++ks) { fa_[ks] = ldsfrag(lb + GD_KN, 16 * mt + fr, GD_S, 64 * ks + 16 * fq); fb_[ks] = ldsfrag(lb + (kind ? GD_QN : GD_KN), 16 * lt + fr, GD_S, 64 * ks + 16 * fq); }
#pragma unroll
        for (int ks = 0; ks < 2; ++ks) acc = MFMA16(fa_[ks], fb_[ks], acc);
        MFMA_SETTLE(acc);
        const int col = 16 * lt + fr, r0 = 16 * mt + 4 * fq; const float gcc = fg[col];
        if (kind == 0) { const float bc = fg[64 + col];
            const float l0 = (r0 + 0 < col) ? bc * acc[0] * __expf(gcc - fg[r0 + 0]) : 0.f, l1 = (r0 + 1 < col) ? bc * acc[1] * __expf(gcc - fg[r0 + 1]) : 0.f,
                        l2 = (r0 + 2 < col) ? bc * acc[2] * __expf(gcc - fg[r0 + 2]) : 0.f, l3 = (r0 + 3 < col) ? bc * acc[3] * __expf(gcc - fg[r0 + 3]) : 0.f;
            if (lt != mt) { v2u w; w.x = pk2(-l0, -l1); w.y = pk2(-l2, -l3); *(LAS v2u*)(lb + GD_NL + col * GD_S + r0 * 2) = w; }
            else { *(LAS v4f*)(lb + GD_LD + lt * 1280 + fr * 80 + fq * 16) = (v4f){l0, l1, l2, l3}; *(LAS v2u*)(lb + GD_NL + col * GD_S + r0 * 2) = zero2u(); } }
        else { float a0 = (r0 + 0 <= col) ? acc[0] * __expf(gcc - fg[r0 + 0]) : 0.f, a1 = (r0 + 1 <= col) ? acc[1] * __expf(gcc - fg[r0 + 1]) : 0.f,
                     a2 = (r0 + 2 <= col) ? acc[2] * __expf(gcc - fg[r0 + 2]) : 0.f, a3 = (r0 + 3 <= col) ? acc[3] * __expf(gcc - fg[r0 + 3]) : 0.f;
            v2u w; w.x = pk2(a0, a1); w.y = pk2(a2, a3);
            *(LAS v2u*)(lb + GD_AT + col * GD_S + r0 * 2) = w;
            if (lt == mt && (lt & 1) == 0) *(LAS v2u*)(lb + GD_AT + col * GD_S + (r0 + 16) * 2) = zero2u(); }
    }
    __syncthreads();
    F.lane = fresh_lane(); LN = F.lane; fr = F.lane & 15; fq = F.lane >> 4;
    if (uw == 3) {
        const int blk = F.lane >> 4, j = F.lane & 15; float x[16];
        unsigned ldv = (unsigned)(unsigned long long)(lb + GD_LD + blk * 1280); asm volatile("" : "+v"(ldv)); LAS unsigned char* Ld = (LAS unsigned char*)(unsigned long long)ldv;
#pragma unroll
        for (int c = 0; c < 16; ++c) x[c] = (c == j) ? 1.f : 0.f;
#pragma unroll
        for (int c = 1; c < 16; ++c) { float s0 = 0.f;
#pragma unroll
            for (int mc = 0; mc <= (c - 1) / 4; ++mc) { const v4f lv = *(const LAS v4f*)(Ld + c * 80 + mc * 16); s0 += lv.x * x[4 * mc] + lv.y * x[4 * mc + 1] + lv.z * x[4 * mc + 2] + lv.w * x[4 * mc + 3]; }
            x[c] -= s0; asm volatile("" : "+v"(x[c]) :: "memory"); }
#pragma unroll
        for (int c = 0; c < 16; ++c) { *(LAS unsigned short*)(lb + GD_DB + blk * 1024 + c * 64 + j * 2) = (unsigned short)f2bf(x[c]); *(LAS unsigned short*)(lb + GD_DB + blk * 1024 + c * 64 + (16 + j) * 2) = 0; }
    }
    __syncthreads();
    F.lane = fresh_lane(); LN = F.lane; fr = F.lane & 15; fq = F.lane >> 4;
    {
        LAS unsigned char* img = lb + (uw < 2 ? GD_RV : GD_RK);
#pragma unroll
        for (int i = 0; i < 4; ++i) {
            if (i > 0) {
#pragma unroll
                for (int nt = 0; nt < 2; ++nt) { const int crow = 32 * (uw & 1) + 16 * nt + fr;
                    const v2u rr = *(const LAS v2u*)(img + crow * GD_S + (16 * i + 4 * fq) * 2);
                    pg8::f32x4 acc = (pg8::f32x4){bf2f(rr.x & 0xffffu), bf2f(rr.x >> 16), bf2f(rr.y & 0xffffu), bf2f(rr.y >> 16)};
#pragma unroll
                    for (int ks = 0; ks < (i == 3 ? 2 : 1); ++ks) acc = MFMA16(ldsfrag(lb + GD_NL, 16 * i + fr, GD_S, 64 * ks + 16 * fq), ldsfrag(img, crow, GD_S, 64 * ks + 16 * fq), acc);
                    MFMA_SETTLE(acc);
                    v2u w; w.x = pk2(acc[0], acc[1]); w.y = pk2(acc[2], acc[3]);
                    *(LAS v2u*)(img + crow * GD_S + (16 * i + 4 * fq) * 2) = w; }
                LDS_WAIT();
            }
#pragma unroll
            for (int nt = 0; nt < 2; ++nt) { const int crow = 32 * (uw & 1) + 16 * nt + fr;
                pg8::f32x4 acc = MFMA16(ldsfrag(lb + GD_DB + i * 1024, fr, 64, 16 * fq), ldsfrag(img, crow, GD_S, (16 * i + 8 * (fq & 1)) * 2), zero4());
                MFMA_SETTLE(acc);
                v2u w; w.x = pk2(acc[0], acc[1]); w.y = pk2(acc[2], acc[3]);
                *(LAS v2u*)(img + crow * GD_S + (16 * i + 4 * fq) * 2) = w; }
            LDS_WAIT();
        }
    }
    __syncthreads();
    {
        F.lane = fresh_lane(); LN = F.lane; fr = F.lane & 15; fq = F.lane >> 4;
        const int aoff = (uw == 0 || uw == 2) ? GD_RK : (uw == 1 ? GD_KDT : GD_RV), boff = uw == 0 ? GD_KDT : (uw == 1 ? GD_RV : GD_AT);
        bf16* dst = (bf16*)(F.ws + (uw == 0 ? WS_GAN : uw == 1 ? WS_GBN : uw == 2 ? WS_GQE : WS_GO1)) + (size_t)unit * 4096;
        const float gtot = __expf(fg[63]);
        for (int ct = 0; ct < 4; ++ct) { const int col = 16 * ct + fr; const float eg = __expf(fg[col]);
#pragma unroll
            for (int rt = 0; rt < 4; ++rt) { const int r0 = 16 * rt + 4 * fq;
                pg8::f32x4 acc = zero4(); bf16x8 pa_[2], pb_[2];
                if (uw == 0) { acc[0] = (r0 + 0 == col) ? gtot : 0.f; acc[1] = (r0 + 1 == col) ? gtot : 0.f; acc[2] = (r0 + 2 == col) ? gtot : 0.f; acc[3] = (r0 + 3 == col) ? gtot : 0.f; }
                if (uw == 2) { const v2u q = *(const LAS v2u*)(lb + GD_QN + col * GD_S + r0 * 2);
                    acc[0] = bf2f(q.x & 0xffffu) * eg; acc[1] = bf2f(q.x >> 16) * eg; acc[2] = bf2f(q.y & 0xffffu) * eg; acc[3] = bf2f(q.y >> 16) * eg; }
#pragma unroll
                for (int ks = 0; ks < 2; ++ks) { pa_[ks] = ldsfrag(lb + aoff, 16 * rt + fr, GD_S, 64 * ks + 16 * fq); pb_[ks] = ldsfrag(lb + boff, col, GD_S, 64 * ks + 16 * fq); }
#pragma unroll
                for (int ks = 0; ks < 2; ++ks) if (uw < 2 || 2 * ks <= ct) acc = MFMA16(pa_[ks], pb_[ks], acc);
                MFMA_SETTLE(acc);
                v2u w; w.x = pk2(acc[0], acc[1]); w.y = pk2(acc[2], acc[3]);
                *(v2u*)(dst + col * 64 + r0) = w; }
        }
    }
    __syncthreads();
}
__device__ __forceinline__ void ph_g1(const Ctx& F0, int l) { Ctx F = launder(F0); for (int p = F.bid; p < 1536; p += F.G) gdn_g1_pair(F, l, p); }

__device__ __forceinline__ void gdn_g2_task(Ctx& F, int task) {
    const int cq = task & 3, bh = task >> 2, b = bh / 6, hh = bh % 6; const int fr = F.lane & 15, fq = F.lane >> 4;
    const bf16* AN = (const bf16*)(F.ws + WS_GAN); const bf16* BN = (const bf16*)(F.ws + WS_GBN); bf16* SP = (bf16*)(F.ws + WS_GSP);
    pg8::f32x4 acc[4];
#pragma unroll
    for (int i = 0; i < 4; ++i) acc[i] = zero4();
    constexpr int RD = 4;
    v2u af[RD][4][2][2], bi[RD][4];
    const size_t u0 = (size_t)(b * 64) * 6 + hh;
    const bf16* anp = AN + u0 * 4096 + fr * 64 + 4 * fq; const bf16* bnp = BN + u0 * 4096 + (16 * cq + fr) * 64 + 4 * fq; bf16* spp = SP + u0 * 4096 + (16 * cq + fr) * 64 + 4 * fq;
#define G2_LOAD(slot, n) do { _Pragma("unroll") for (int it = 0; it < 4; ++it) { bi[slot][it] = *(const v2u*)(bnp + (size_t)(n) * 6 * 4096 + 16 * it); \
        _Pragma("unroll") for (int s_ = 0; s_ < 2; ++s_) { const bf16* ap = anp + (size_t)(n) * 6 * 4096 + 16 * it * 64 + 32 * s_; af[slot][it][s_][0] = *(const v2u*)ap; af[slot][it][s_][1] = *(const v2u*)(ap + 16); } } } while (0)
#pragma unroll
    for (int k = 0; k < RD; ++k) G2_LOAD(k, k);
    for (int n0 = 0; n0 < 64; n0 += RD) {
#pragma unroll
        for (int k = 0; k < RD; ++k) {
            const int n = n0 + k;
            unsigned pk[4][2];
#pragma unroll
            for (int it = 0; it < 4; ++it) { pk[it][0] = pk2(acc[it][0], acc[it][1]); pk[it][1] = pk2(acc[it][2], acc[it][3]);
                *(v2u*)(spp + (size_t)n * 6 * 4096 + 16 * it) = (v2u){pk[it][0], pk[it][1]}; }
            bf16x8 bfr[2];
#pragma unroll
            for (int s_ = 0; s_ < 2; ++s_) { const v4u t = (v4u){pk[2 * s_][0], pk[2 * s_][1], pk[2 * s_ + 1][0], pk[2 * s_ + 1][1]}; bfr[s_] = __builtin_bit_cast(bf16x8, t); }
#pragma unroll
            for (int it = 0; it < 4; ++it) {
                pg8::f32x4 a = (pg8::f32x4){bf2f(bi[k][it].x & 0xffffu), bf2f(bi[k][it].x >> 16), bf2f(bi[k][it].y & 0xffffu), bf2f(bi[k][it].y >> 16)};
#pragma unroll
                for (int s_ = 0; s_ < 2; ++s_) { const v4u t = (v4u){af[k][it][s_][0].x, af[k][it][s_][0].y, af[k][it][s_][1].x, af[k][it][s_][1].y}; a = MFMA16(__builtin_bit_cast(bf16x8, t), bfr[s_], a); }
                acc[it] = a; }
            asm volatile("s_nop 15\n\ts_nop 7" : "+v"(acc[0]), "+v"(acc[1]), "+v"(acc[2]), "+v"(acc[3]));
            if (n + RD < 64) G2_LOAD(k, n + RD);
        }
    }
#undef G2_LOAD
}
__device__ __forceinline__ void ph_g2(const Ctx& F0) { Ctx F = launder(F0); const int t = F.wave * F.G + F.bid; if (t < 192) gdn_g2_task(F, t); }

__device__ __forceinline__ void ph_g3(const Ctx& F0, int l) {
    Ctx F = launder(F0); const int LN = F.lane;
    const bf16* P = (const bf16*)(F.ws + WS_P); bf16* Y = (bf16*)(F.ws + WS_Y);
    const bf16* QE = (const bf16*)(F.ws + WS_GQE); const bf16* O1 = (const bf16*)(F.ws + WS_GO1); const bf16* SP = (const bf16*)(F.ws + WS_GSP);
    const int fr = F.lane & 15, fq = F.lane >> 4; const float* gnp = inptr(F, I_GNORM) + l * 64;
    const int NT = 3072 * 4, stride = F.G * 8;
    bf16x8 bq[2], sp[4][2], bqn[2], spn[4][2]; v2u oi[4], zz[4], oin[4], zzn[4];
#define G3_LOAD(task_, BQ, SPF, OI, ZZ) do { const int u_ = (task_) >> 2, t_ = (task_) & 3, h_ = u_ % 6; const size_t r_ = (size_t)(u_ / 6) * 64 + 16 * t_ + fr; \
        _Pragma("unroll") for (int ks = 0; ks < 2; ++ks) BQ[ks] = *(const bf16x8*)(QE + (size_t)u_ * 4096 + (16 * t_ + fr) * 64 + 32 * ks + 8 * fq); \
        _Pragma("unroll") for (int et = 0; et < 4; ++et) { OI[et] = *(const v2u*)(O1 + (size_t)u_ * 4096 + (16 * t_ + fr) * 64 + 16 * et + 4 * fq); ZZ[et] = *(const v2u*)(P + r_ * NP + PC_GZ + h_ * 64 + 16 * et + 4 * fq); \
            _Pragma("unroll") for (int ks = 0; ks < 2; ++ks) SPF[et][ks] = *(const bf16x8*)(SP + (size_t)u_ * 4096 + (16 * et + fr) * 64 + 32 * ks + 8 * fq); } } while (0)
    int task = F.bid * 8 + F.wave;
    if (task < NT) G3_LOAD(task, bq, sp, oi, zz);
    for (; task < NT; task += stride) {
        const int unit = task >> 2, tt = task & 3, hh = unit % 6, bn = unit / 6; const size_t row = (size_t)bn * 64 + 16 * tt + fr;
        if (task + stride < NT) G3_LOAD(task + stride, bqn, spn, oin, zzn);
        float ov[4][4]; float ss = 0.f;
#pragma unroll
        for (int et = 0; et < 4; ++et) {
            pg8::f32x4 a = (pg8::f32x4){bf2f(oi[et].x & 0xffffu), bf2f(oi[et].x >> 16), bf2f(oi[et].y & 0xffffu), bf2f(oi[et].y >> 16)};
#pragma unroll
            for (int ks = 0; ks < 2; ++ks) a = MFMA16(sp[et][ks], bq[ks], a);
            MFMA_SETTLE(a);
            ov[et][0] = a[0]; ov[et][1] = a[1]; ov[et][2] = a[2]; ov[et][3] = a[3]; ss += (a[0] * a[0] + a[1] * a[1]) + (a[2] * a[2] + a[3] * a[3]); }
        ss += SHX(ss, 16); ss += SHX(ss, 32);
        const float rs = rsqrtf(ss * (1.f / 64.f) + EPS);
#pragma unroll
        for (int et = 0; et < 4; ++et) { const int e0 = 16 * et + 4 * fq; const v4f gw = *(const v4f*)(gnp + e0);
            v2u w; w.x = pk2(ov[et][0] * rs * gw.x * silu_f(bf2f(zz[et].x & 0xffffu)), ov[et][1] * rs * gw.y * silu_f(bf2f(zz[et].x >> 16)));
            w.y = pk2(ov[et][2] * rs * gw.z * silu_f(bf2f(zz[et].y & 0xffffu)), ov[et][3] * rs * gw.w * silu_f(bf2f(zz[et].y >> 16)));
            *(v2u*)(Y + row * DM + 256 + hh * 64 + e0) = w; }
#pragma unroll
        for (int ks = 0; ks < 2; ++ks) bq[ks] = bqn[ks];
#pragma unroll
        for (int et = 0; et < 4; ++et) { oi[et] = oin[et]; zz[et] = zzn[et];
#pragma unroll
            for (int ks = 0; ks < 2; ++ks) sp[et][ks] = spn[et][ks]; }
    }
#undef G3_LOAD
}


constexpr size_t WS_S5KT = 592 * MiB;
constexpr size_t WS_S5LP = 594 * MiB;
constexpr size_t WS_S5CM = 597 * MiB;
constexpr size_t WS_S5BB = 598 * MiB;
constexpr size_t WS_YS5 = 392 * MiB;
typedef float v2f __attribute__((ext_vector_type(2)));
__device__ __forceinline__ void s5_tables(const Ctx& F0) {
    Ctx F = launder(F0);
    LAS v2f* lp = (LAS v2f*)F.lds; LAS v2f* bb = (LAS v2f*)(F.lds + 33280); LAS v2f* cc = (LAS v2f*)(F.lds + 33280 + 8192);
    const int tb0 = (F.G >= 2 * NL * 24) ? NL * 24 : 0;
    if (F.bid < tb0) return;
    for (int task = F.bid - tb0; task < NL * 16 * 16; task += F.G - tb0) {
        const int lg = task >> 4, c = task & 15, l = lg >> 4, g = lg & 15;
        const float step = expf(inptr(F, I_S5LDT)[lg]);
        for (int i = F.tid; i < 65 * 64; i += 512) { const int k = i >> 6, p = i & 63; const float are = inptr(F, I_S5ARE)[lg * 64 + p], aim = inptr(F, I_S5AIM)[lg * 64 + p];
            const float mag = expf((float)k * are * step); float sn, cs; sincosf((float)k * aim * step, &sn, &cs); lp[i] = (v2f){mag * cs, mag * sn}; }
        __syncthreads();
        for (int i = F.tid; i < 64 * 16; i += 512) { const int p = i >> 4; const float are = inptr(F, I_S5ARE)[lg * 64 + p], aim = inptr(F, I_S5AIM)[lg * 64 + p];
            const v2f lb = lp[64 + p]; const float nr = lb.x - 1.f, ni = lb.y, den = are * are + aim * aim, fr_ = (nr * are + ni * aim) / den, fi_ = (ni * are - nr * aim) / den;
            const float br = inptr(F, I_S5BRE)[(size_t)lg * 1024 + i], bi = inptr(F, I_S5BIM)[(size_t)lg * 1024 + i];
            bb[i] = (v2f){fr_ * br - fi_ * bi, fr_ * bi + fi_ * br}; }
        if (F.tid < 64) cc[F.tid] = (v2f){inptr(F, I_S5CRE)[((size_t)lg * 16 + c) * 64 + F.tid], inptr(F, I_S5CIM)[((size_t)lg * 16 + c) * 64 + F.tid]};
        __syncthreads();
        bf16* KT = (bf16*)(F.ws + WS_S5KT) + (size_t)lg * 16384 + c * 1024;
        for (int o = F.tid; o < 1024; o += 512) { const int d = o >> 4, c2 = o & 15; float acc = 0.f;
            for (int p = 0; p < 64; ++p) { const v2f C = cc[p], L = lp[d * 64 + p], B = bb[p * 16 + c2]; const float mr = C.x * L.x - C.y * L.y, mi = C.x * L.y + C.y * L.x; acc += mr * B.x - mi * B.y; }
            KT[o] = (bf16)f2bf(acc); }
        if (c == 0) {
            float* LPg = (float*)(F.ws + WS_S5LP) + (size_t)lg * 65 * 128; bf16* CMg = (bf16*)(F.ws + WS_S5CM) + (size_t)lg * 2048; bf16* BBg = (bf16*)(F.ws + WS_S5BB) + (size_t)lg * 4096;
            for (int i = F.tid; i < 65 * 64; i += 512) { LPg[2 * i] = lp[i].x; LPg[2 * i + 1] = lp[i].y; }
            for (int i = F.tid; i < 64 * 16; i += 512) { const int p = i >> 4, c2 = i & 15; BBg[p * 32 + c2] = (bf16)f2bf(bb[i].x); BBg[(64 + p) * 32 + c2] = (bf16)f2bf(bb[i].y); BBg[p * 32 + 16 + c2] = 0; BBg[(64 + p) * 32 + 16 + c2] = 0; }
            for (int i = F.tid; i < 16 * 64; i += 512) { const int c2 = i >> 6, p = i & 63; CMg[c2 * 128 + p] = (bf16)f2bf(inptr(F, I_S5CRE)[((size_t)lg * 16 + c2) * 64 + p]); CMg[c2 * 128 + 64 + p] = (bf16)f2bf(-inptr(F, I_S5CIM)[((size_t)lg * 16 + c2) * 64 + p]); }
        }
        __syncthreads();
    }
}
constexpr int S5_KT = 0, S5_KT_S = 2064, S5_LP = 33024, S5_CM = 66304, S5_CM_S = 272, S5_BB = 70656, S5_SL = 74752, S5_U = 107520;
__device__ __forceinline__ void s5_unit(const Ctx& F0, int l, int unit) {
    Ctx F = F0; F.lane = fresh_lane(); F.tid = F.wave * 64 + F.lane; int LN = F.lane;
    const int hs = unit & 1, b = unit >> 5, g = (unit >> 1) & 15, lg = l * 16 + g; int fr = F.lane & 15, fq = F.lane >> 4;
    const bf16* P = (const bf16*)(F.ws + WS_P); bf16* YS = (bf16*)(F.ws + WS_YS5);
    { const bf16* KTg = (const bf16*)(F.ws + WS_S5KT) + (size_t)lg * 16384;
      for (int i = F.tid; i < 16 * 128; i += 512) { const int c = i >> 7, k8 = i & 127; *(LAS v4u*)(F.lds + S5_KT + c * S5_KT_S + k8 * 16) = *(const v4u*)(KTg + c * 1024 + k8 * 8); }
      const v4f* LPg = (const v4f*)((const float*)(F.ws + WS_S5LP) + (size_t)lg * 65 * 128);
      for (int i = F.tid; i < 65 * 32; i += 512) ((LAS v4f*)(F.lds + S5_LP))[i] = LPg[i];
      const bf16* CMg = (const bf16*)(F.ws + WS_S5CM) + (size_t)lg * 2048;
      for (int i = F.tid; i < 16 * 16; i += 512) { const int c = i >> 4, k8 = i & 15; *(LAS v4u*)(F.lds + S5_CM + c * S5_CM_S + k8 * 16) = *(const v4u*)(CMg + c * 128 + k8 * 8); }
      LAS v4u* uz = (LAS v4u*)(F.lds + S5_U + F.wave * 4096);
      for (int i = F.lane; i < 128; i += 64) uz[i] = zero4u(); }
    __syncthreads();
    LAS v2f* lp = (LAS v2f*)(F.lds + S5_LP); LAS v2f* sl = (LAS v2f*)(F.lds + S5_SL);
    {
        const bf16* BBq = (const bf16*)(F.ws + WS_S5BB) + (size_t)lg * 4096;
        bf16x8 bbr[4], bbi[4];
#pragma unroll
        for (int j = 0; j < 4; ++j) { bbr[j] = *(const bf16x8*)(BBq + (16 * j + fr) * 32 + 8 * fq); bbi[j] = *(const bf16x8*)(BBq + (64 + 16 * j + fr) * 32 + 8 * fq); }
        const bf16* up = P + ((size_t)b * SEQ + fr) * NP + PC_S5 + g * 16 + 8 * (fq & 1);
        bf16x8 ua[4], un[4];
#pragma unroll
        for (int st = 0; st < 4; ++st) ua[st] = *(const bf16x8*)(up + ((size_t)(32 * hs + F.wave) * 64 + 16 * st) * NP);
        for (int n = 32 * hs + F.wave; n < 32 * (hs + 1); n += 8) {
            unsigned l0v = (unsigned)(unsigned long long)F.lds; asm volatile("" : "+v"(l0v)); LAS unsigned char* L0 = (LAS unsigned char*)(unsigned long long)l0v;
            LAS v2f* lp = (LAS v2f*)(L0 + S5_LP); LAS v2f* sl = (LAS v2f*)(L0 + S5_SL);
            if (n + 8 < 32 * (hs + 1)) {
#pragma unroll
                for (int st = 0; st < 4; ++st) un[st] = *(const bf16x8*)(up + ((size_t)(n + 8) * 64 + 16 * st) * NP); }
#pragma unroll
            for (int j = 0; j < 4; ++j) {
                float sr = 0.f, si = 0.f;
#pragma unroll
                for (int st = 0; st < 4; ++st) { const pg8::f32x4 z4 = zero4();
                    pg8::f32x4 ar = MFMA16(ua[st], bbr[j], z4), ai = MFMA16(ua[st], bbi[j], z4);
                    asm volatile("s_nop 15\n\ts_nop 15" : "+v"(ar), "+v"(ai));
#pragma unroll
                    for (int r = 0; r < 4; ++r) { const v2f w = lp[(63 - (16 * st + 4 * fq + r)) * 64 + 16 * j + fr]; sr += w.x * ar[r] - w.y * ai[r]; si += w.x * ai[r] + w.y * ar[r]; } }
                sr += SHX(sr, 16); sr += SHX(sr, 32); si += SHX(si, 16); si += SHX(si, 32);
                if (fq == 0) sl[n * 64 + 16 * j + fr] = (v2f){sr, si};
            }
#pragma unroll
            for (int st = 0; st < 4; ++st) ua[st] = un[st];
        }
    }
    __syncthreads();
    if (F.wave == 0) { const v2f l64 = lp[64 * 64 + F.lane]; float sr = 0.f, si = 0.f;
        unsigned* flag = (unsigned*)(F.ws + WS_CTL) + CW_S5F + ((l * 128 + b * 16 + g) * 16);
        unsigned long long* sx = (unsigned long long*)(F.ws + WS_S5X) + (size_t)(l * 128 + b * 16 + g) * 64 + F.lane;
        if (hs == 1) {
            unsigned spins = 0; while (__hip_atomic_load(flag, __ATOMIC_RELAXED, __HIP_MEMORY_SCOPE_AGENT) == 0u && ++spins < (1u << 22)) __builtin_amdgcn_s_sleep(2);
            __builtin_amdgcn_fence(__ATOMIC_ACQUIRE, "agent");
            const unsigned long long v = __hip_atomic_load(sx, __ATOMIC_RELAXED, __HIP_MEMORY_SCOPE_AGENT); sr = __uint_as_float((unsigned)v); si = __uint_as_float((unsigned)(v >> 32)); }
        for (int n = 32 * hs; n < 32 * (hs + 1); ++n) { const v2f loc = sl[n * 64 + F.lane]; sl[n * 64 + F.lane] = (v2f){sr, si};
            const float nr = l64.x * sr - l64.y * si + loc.x, ni = l64.x * si + l64.y * sr + loc.y; sr = nr; si = ni; }
        if (hs == 0) {
            __hip_atomic_store(sx, ((unsigned long long)__float_as_uint(si) << 32) | __float_as_uint(sr), __ATOMIC_RELAXED, __HIP_MEMORY_SCOPE_AGENT);
            asm volatile("s_waitcnt vmcnt(0)" ::: "memory");
            if (F.lane == 0) __hip_atomic_store(flag, 1u, __ATOMIC_RELAXED, __HIP_MEMORY_SCOPE_AGENT); } }
    __syncthreads();
    F.lane = fresh_lane(); LN = F.lane; fr = F.lane & 15; fq = F.lane >> 4;
    const float Dc = inptr(F, I_S5D)[l * 256 + g * 16 + fr];
    v4u upc[2];
    { const bf16* q = P + ((size_t)b * SEQ + (size_t)(32 * hs + F.wave) * 64 + (F.lane >> 1)) * NP + PC_S5 + g * 16 + 8 * (F.lane & 1); upc[0] = *(const v4u*)q; upc[1] = *(const v4u*)(q + (size_t)32 * NP); }
    for (int n = 32 * hs + F.wave; n < 32 * (hs + 1); n += 8) {
        unsigned l0v = (unsigned)(unsigned long long)F.lds; asm volatile("" : "+v"(l0v)); LAS unsigned char* L0 = (LAS unsigned char*)(unsigned long long)l0v;
        LAS unsigned char* ub = L0 + S5_U + F.wave * 4096;
        const size_t rowbase = (size_t)b * SEQ + n * 64;
        { const int r0_ = F.lane >> 1, hf = F.lane & 1; *(LAS v4u*)(ub + (64 + r0_) * 32 + hf * 16) = upc[0]; *(LAS v4u*)(ub + (96 + r0_) * 32 + hf * 16) = upc[1];
          if (n + 8 < 32 * (hs + 1)) { const bf16* q = P + ((size_t)b * SEQ + (size_t)(n + 8) * 64 + r0_) * NP + PC_S5 + g * 16 + 8 * hf; upc[0] = *(const v4u*)q; upc[1] = *(const v4u*)(q + (size_t)32 * NP); } }
        LDS_WAIT();
#pragma unroll 1
        for (int tt = 0; tt < 4; ++tt) {
            pg8::f32x4 a = zero4();
            const int t = 16 * tt + fr;
#pragma unroll
            for (int hp = 0; hp < 2; ++hp) { float zr[8], zi[8];
#pragma unroll
                for (int q4 = 0; q4 < 4; ++q4) { const v4f lw = *(const LAS v4f*)(L0 + S5_LP + ((t + 1) * 64 + 32 * hp + 8 * fq + 2 * q4) * 8), sv = *(const LAS v4f*)(L0 + S5_SL + (n * 64 + 32 * hp + 8 * fq + 2 * q4) * 8);
                    zr[2 * q4] = lw.x * sv.x - lw.y * sv.y; zi[2 * q4] = lw.x * sv.y + lw.y * sv.x; zr[2 * q4 + 1] = lw.z * sv.z - lw.w * sv.w; zi[2 * q4 + 1] = lw.z * sv.w + lw.w * sv.z; }
                const v4u fre = (v4u){pk2(zr[0], zr[1]), pk2(zr[2], zr[3]), pk2(zr[4], zr[5]), pk2(zr[6], zr[7])}, fim = (v4u){pk2(zi[0], zi[1]), pk2(zi[2], zi[3]), pk2(zi[4], zi[5]), pk2(zi[6], zi[7])};
                a = MFMA16(__builtin_bit_cast(bf16x8, fre), *(const LAS bf16x8*)(L0 + S5_CM + fr * S5_CM_S + (32 * hp + 8 * fq) * 2), a);
                a = MFMA16(__builtin_bit_cast(bf16x8, fim), *(const LAS bf16x8*)(L0 + S5_CM + fr * S5_CM_S + (64 + 32 * hp + 8 * fq) * 2), a); }
            for (int k4 = 0; k4 < 8 * (tt + 1); k4 += 4) { bf16x8 ua_[4], kb_[4];
#pragma unroll
                for (int i = 0; i < 4; ++i) { const int ks = k4 + i; ua_[i] = *(const LAS bf16x8*)(ub + (64 + t - 2 * ks - (fq >> 1)) * 32 + (fq & 1) * 16); kb_[i] = *(const LAS bf16x8*)(L0 + S5_KT + fr * S5_KT_S + (32 * ks + 8 * fq) * 2); }
#pragma unroll
                for (int i = 0; i < 4; ++i) a = MFMA16(ua_[i], kb_[i], a); }
            MFMA_SETTLE(a);
#pragma unroll
            for (int r = 0; r < 4; ++r) { const int t2 = 16 * tt + 4 * fq + r; const float u = bf2f(*(const LAS unsigned short*)(ub + (64 + t2) * 32 + fr * 2));
                YS[(rowbase + t2) * 256 + g * 16 + fr] = (bf16)f2bf(gelu_tanh(a[r] + Dc * u)); }
        }
        LDS_WAIT();
    }
    __syncthreads();
}
__device__ __forceinline__ void ph_s5(const Ctx& F0, int l) { Ctx F = launder(F0); for (int u = F.bid; u < 256; u += F.G) s5_unit(F, l, u); }

__device__ __forceinline__ void ph_scan(const Ctx& F0, int l) {
    Ctx F = launder(F0);
    if (F.wave == 0) { if (F.bid < 192) gdn_g2_task(F, F.bid); }
    else {
        bf16* CS = (bf16*)(F.ws + WS_CS2); const float* CD = (const float*)(F.ws + WS_CD);
        for (int task = (F.bid * 7 + (F.wave - 1)) * 64 + F.lane; task < 48 * 1024; task += F.G * 7 * 64) {
            const int bh = task >> 10, e = (task & 1023) * 8; float s[8];
#pragma unroll
            for (int i = 0; i < 8; ++i) s[i] = 0.f;
            for (int n0 = 0; n0 < 64; n0 += 8) { v4u v[8]; float cd[8];
#pragma unroll
                for (int i = 0; i < 8; ++i) { v[i] = *(const v4u*)(CS + (size_t)(bh * 64 + n0 + i) * 8192 + e); cd[i] = CD[bh * 64 + n0 + i]; }
#pragma unroll
                for (int i = 0; i < 8; ++i) { v4u o; o.x = pk2(s[0], s[1]); o.y = pk2(s[2], s[3]); o.z = pk2(s[4], s[5]); o.w = pk2(s[6], s[7]);
                    *(v4u*)(CS + (size_t)(bh * 64 + n0 + i) * 8192 + e) = o;
                    s[0] = cd[i] * s[0] + bf2f(v[i].x & 0xffffu); s[1] = cd[i] * s[1] + bf2f(v[i].x >> 16); s[2] = cd[i] * s[2] + bf2f(v[i].y & 0xffffu); s[3] = cd[i] * s[3] + bf2f(v[i].y >> 16);
                    s[4] = cd[i] * s[4] + bf2f(v[i].z & 0xffffu); s[5] = cd[i] * s[5] + bf2f(v[i].z >> 16); s[6] = cd[i] * s[6] + bf2f(v[i].w & 0xffffu); s[7] = cd[i] * s[7] + bf2f(v[i].w >> 16); }
            }
        }
    }
    { const int NFW = F.G * 7 + (F.G > 192 ? F.G - 192 : 0);
      const int idx = F.wave > 0 ? F.bid * 7 + (F.wave - 1) : (F.bid >= 192 ? F.G * 7 + (F.bid - 192) : -1);
      if (idx >= 0) { LAS float* scr = (LAS float*)(F.lds + F.wave * 8448);
          for (int it = CV_IN + idx; it < CV_ITEMS; it += NFW) convert_item(F, l, it, scr, F.lane); } }
}

__device__ __forceinline__ void ph_m3(const Ctx& F0, int l) {
    Ctx F = launder(F0); const int LN = F.lane;
    const bf16* YS = (const bf16*)(F.ws + WS_YS5); const bf16* WT = (const bf16*)(F.ws + WS_WGLU); bf16* Y = (bf16*)(F.ws + WS_Y);
    const int fr = F.lane & 15, fq = F.lane >> 4; const float* nrm = inptr(F, I_S5NORM) + l * 256;
    LAS v4f* vl = (LAS v4f*)(F.lds + F.wave * 16384) + F.lane;
    for (int tile = F.bid * 8 + F.wave; tile < NTOK / 16; tile += F.G * 8) {
        const size_t row = (size_t)tile * 16 + fr;
        bf16x8 bq[8];
#pragma unroll
        for (int ks = 0; ks < 8; ++ks) bq[ks] = *(const bf16x8*)(YS + row * 256 + 32 * ks + 8 * fq);
        float ss = 0.f;
        const bf16* wp = WT + fr * 256 + 8 * fq; const bf16* yp = YS + row * 256 + 4 * fq;
        bf16x8 wc[8], wn[8];
#pragma unroll
        for (int ks = 0; ks < 8; ++ks) wc[ks] = *(const bf16x8*)(wp + 32 * ks);
#pragma unroll 1
        for (int jt = 0; jt < 16; ++jt) {
            wp += 16 * 256;
            if (jt < 15) {
#pragma unroll
                for (int ks = 0; ks < 8; ++ks) wn[ks] = *(const bf16x8*)(wp + 32 * ks); }
            pg8::f32x4 a = zero4();
#pragma unroll
            for (int ks = 0; ks < 8; ++ks) a = MFMA16(wc[ks], bq[ks], a);
            MFMA_SETTLE(a);
            const v2u yy = *(const v2u*)(yp + 16 * jt);
            v4f v; v.x = bf2f(yy.x & 0xffffu) * sigm(a[0]); v.y = bf2f(yy.x >> 16) * sigm(a[1]); v.z = bf2f(yy.y & 0xffffu) * sigm(a[2]); v.w = bf2f(yy.y >> 16) * sigm(a[3]);
            ss += dot4(v, v);
            vl[jt * 64] = v;
#pragma unroll
            for (int ks = 0; ks < 8; ++ks) wc[ks] = wn[ks];
        }
        ss += SHX(ss, 16); ss += SHX(ss, 32);
        const float rs = rsqrtf(ss * (1.f / 256.f) + EPS);
        LDS_WAIT();
#pragma unroll 1
        for (int j4 = 0; j4 < 16; j4 += 4) { v4f nw[4];
#pragma unroll
            for (int i = 0; i < 4; ++i) nw[i] = *(const v4f*)(nrm + 16 * (j4 + i) + 4 * fq);
#pragma unroll
            for (int i = 0; i < 4; ++i) { const v4f v = vl[(j4 + i) * 64];
                v2u w; w.x = pk2(v.x * rs * nw[i].x, v.y * rs * nw[i].y); w.y = pk2(v.z * rs * nw[i].z, v.w * rs * nw[i].w);
                *(v2u*)(Y + row * DM + 16 * (j4 + i) + 4 * fq) = w; } }
        LDS_WAIT();
    }
}

__device__ __forceinline__ void ph_n2(const Ctx& F0, int l) {
    Ctx F = launder(F0);
    const int LN = F.lane;
    const float* MOD = (const float*)(F.ws + WS_MOD);
    LAS float* rw = (LAS float*)F.lds;
    { const float* RW = (const float*)(F.ws + WS_RW) + (size_t)l * 36 * DM;
      for (int i = F.tid; i < 36 * DM / 4; i += 512) ((LAS v4f*)rw)[i] = ((const v4f*)RW)[i]; }
    __syncthreads();
    const int NGW = F.G * 8, gw = F.bid * 8 + F.wave, rows_per = (NTOK + NGW - 1) / NGW;
    const int r0 = gw * rows_per, r1 = (r0 + rows_per) < NTOK ? (r0 + rows_per) : NTOK;
    if (F.tid == 0) { const unsigned* xp = (const unsigned*)(F.ws + WS_CTL) + CW_XP + l * (128 * 64);
        const int b0 = F.bid * 8 * rows_per, b1 = (b0 + 8 * rows_per) < NTOK ? (b0 + 8 * rows_per) : NTOK;
        for (int pm = b0 >> 8; pm <= ((b1 - 1) >> 8) && b0 < NTOK; ++pm) { unsigned spins = 0;
            while (__hip_atomic_load(xp + 64 * pm, __ATOMIC_RELAXED, __HIP_MEMORY_SCOPE_AGENT) < 32u && ++spins < (1u << 22)) __builtin_amdgcn_s_sleep(2); }
        __builtin_amdgcn_fence(__ATOMIC_ACQUIRE, "agent"); asm volatile("s_waitcnt vmcnt(0)" ::: "memory"); }
    __syncthreads();
    bf16* H = (bf16*)(F.ws + WS_H); const bf16* X = (const bf16*)(F.ws + WS_X); int* TI = (int*)(F.ws + WS_TI); int* LIST = (int*)(F.ws + WS_LIST);
    unsigned* cnt = (unsigned*)(F.ws + WS_CTL) + CW_CNT + l * NE;
    int curb = -1; v4f An[4], Bn[4];
    const float* p_nffn = inptr(F, I_NFFN); const float* p_mbg = inptr(F, I_MBG) + l * 4; const float* p_mbr = inptr(F, I_MBR) + l * 32;
#pragma unroll
    for (int j = 0; j < 4; ++j) { An[j] = zero4(); Bn[j] = An[j]; }
    for (int c0 = r0; c0 < r1; c0 += 64) {
        const int c1 = (c0 + 64) < r1 ? (c0 + 64) : r1;
        int me0 = 0, me1 = 0; float mw0 = 0.f, mw1 = 0.f;
        v2u nv[4];
#pragma unroll
        for (int j = 0; j < 4; ++j) nv[j] = *(const v2u*)(X + (size_t)c0 * DM + 4 * F.lane + 256 * j);
        for (int row = c0; row < c1; ++row) {
            const int b = row >> 12;
            if (b != curb) { curb = b;
#pragma unroll
                for (int j = 0; j < 4; ++j) { const int c = 4 * F.lane + 256 * j;
                    const v4f nm = *(const v4f*)(p_nffn + l * DM + c), sc = *(const v4f*)(MOD + ((size_t)l * NB + b) * 6 * DM + 4 * DM + c), sh = *(const v4f*)(MOD + ((size_t)l * NB + b) * 6 * DM + 3 * DM + c);
                    An[j] = nm * (1.f + sc); Bn[j] = sh; }
            }
            v4f v[4]; float ss = 0.f;
#pragma unroll
            for (int j = 0; j < 4; ++j) { const v2u q = nv[j]; v[j] = (v4f){bf2f(q.x & 0xffffu), bf2f(q.x >> 16), bf2f(q.y & 0xffffu), bf2f(q.y >> 16)}; ss += dot4(v[j], v[j]); }
            { const int nr = (row + 1 < c1) ? row + 1 : row;
#pragma unroll
              for (int j = 0; j < 4; ++j) nv[j] = *(const v2u*)(X + (size_t)nr * DM + 4 * F.lane + 256 * j); }
            const float rs = rsqrtf(wave_sum(ss) * (1.f / DM) + EPS);
            v4f h[4];
#pragma unroll
            for (int j = 0; j < 4; ++j) { h[j] = v[j] * rs * An[j] + Bn[j]; v2u o; o.x = pk2(h[j].x, h[j].y); o.y = pk2(h[j].z, h[j].w); *(v2u*)(H + (size_t)row * DM + 4 * F.lane + 256 * j) = o; }
            float lg[4];
#pragma unroll
            for (int c = 0; c < 4; ++c) { float s = 0.f;
#pragma unroll
                for (int j = 0; j < 4; ++j) s += dot4(h[j], ((const LAS v4f*)rw)[c * 256 + 64 * j + F.lane]);
                lg[c] = wave_sum(s) + p_mbg[c]; }
            int gi = 0; float gm = lg[0];
#pragma unroll
            for (int c = 1; c < 4; ++c) if (lg[c] > gm) { gm = lg[c]; gi = c; }
            float den = 0.f;
#pragma unroll
            for (int c = 0; c < 4; ++c) den += __expf(lg[c] - gm);
            const float gwt = 1.f / den;
            float le[8];
#pragma unroll
            for (int c = 0; c < 8; ++c) { float s = 0.f; const LAS v4f* wr_ = (const LAS v4f*)rw + (4 + gi * 8 + c) * 256;
#pragma unroll
                for (int j = 0; j < 4; ++j) s += dot4(h[j], wr_[64 * j + F.lane]);
                le[c] = wave_sum(s) + p_mbr[gi * 8 + c]; }
            int i1 = 0; float v1 = le[0];
#pragma unroll
            for (int c = 1; c < 8; ++c) if (le[c] > v1) { v1 = le[c]; i1 = c; }
            int i2 = (i1 == 0) ? 1 : 0; float v2 = -3.0e38f;
#pragma unroll
            for (int c = 0; c < 8; ++c) if (c != i1 && le[c] > v2) { v2 = le[c]; i2 = c; }
            const float ex = __expf(v2 - v1), we1 = 1.f / (1.f + ex), we2 = ex / (1.f + ex);
            if (F.lane == row - c0) { me0 = gi * 8 + i1; me1 = gi * 8 + i2; mw0 = gwt * we1; mw1 = gwt * we2; }
        }
        LAS int* lcnt = (LAS int*)(F.lds + LDS_MISC) + 700; LAS int* lbase = (LAS int*)(F.lds + LDS_MISC) + 740;
        if (F.tid < 32) lcnt[F.tid] = 0;
        __syncthreads();
        int ls0 = 0, ls1 = 0; const bool act = c0 + F.lane < c1;
        if (act) { ls0 = __hip_atomic_fetch_add(lcnt + me0, 1, __ATOMIC_RELAXED, __HIP_MEMORY_SCOPE_WORKGROUP); ls1 = __hip_atomic_fetch_add(lcnt + me1, 1, __ATOMIC_RELAXED, __HIP_MEMORY_SCOPE_WORKGROUP); }
        __syncthreads();
        if (F.tid < 32) { const int nn = lcnt[F.tid]; lbase[F.tid] = nn ? (int)__hip_atomic_fetch_add(cnt + F.tid, (unsigned)nn, __ATOMIC_RELAXED, __HIP_MEMORY_SCOPE_AGENT) : 0; }
        __syncthreads();
        if (act) {
            const int row = c0 + F.lane; const int s0 = lbase[me0] + ls0, s1 = lbase[me1] + ls1;
            int* ti = TI + (size_t)row * 8; ti[0] = me0; ti[1] = s0; ti[2] = __float_as_int(mw0); ti[3] = me1; ti[4] = s1; ti[5] = __float_as_int(mw1);
            LIST[(size_t)me0 * NTOK + s0] = row; LIST[(size_t)me1 * NTOK + s1] = row;
        }
        __syncthreads();
    }
}

__device__ __forceinline__ void ph_e0(const Ctx& F0, int l) {
    Ctx F = launder(F0);
    build_tiles(F, l); __syncthreads();
    const int ntiles = F.misc[16 + NE];
    const bf16* H = (const bf16*)(F.ws + WS_H); bf16* XG = (bf16*)(F.ws + WS_P); const int* LIST = (const int*)(F.ws + WS_LIST);
    for (int tile = F.bid; tile < ntiles; tile += F.G) {
        const int e = F.misc[128 + tile], ts = F.misc[16 + e], ce = F.misc[64 + e];
        for (int r = F.wave; r < 256; r += 8) { const int slot = (tile - ts) * 256 + r;
            if (slot < ce) { const int tok = LIST[(size_t)e * NTOK + slot]; const v4u* s = (const v4u*)(H + (size_t)tok * DM); v4u* d = (v4u*)(XG + ((size_t)tile * 256 + r) * DM);
                d[F.lane] = s[F.lane]; d[64 + F.lane] = s[64 + F.lane]; } }
    }
}

struct EpiResid {
    static constexpr bool PERM = true, AFTER_DRAIN = false;
    const bf16* xin; bf16* xout; const float* gate;
    __device__ __forceinline__ void operator()(const pg8::f32x4 (&acc)[2][2][4][2], const pg8::Unit& u, int wr, int wc, int fr, int fq) const {
        const int row0 = u.pm * 256 + wr * 64 + fr, col0 = u.pn * 256 + wc * 32 + 8 * fq, b = u.pm >> 4;
        pg8::f32x4 gv[2][2];
#pragma unroll
        for (int bj = 0; bj < 2; ++bj)
#pragma unroll
            for (int n = 0; n < 2; ++n) gv[bj][n] = *(const pg8::f32x4*)(gate + (size_t)b * 6 * DM + col0 + bj * 128 + n * 4);
#pragma unroll
        for (int ai = 0; ai < 2; ++ai)
#pragma unroll
            for (int m = 0; m < 4; m += 2) {
                v4u xv[2][2];
#pragma unroll
                for (int mm = 0; mm < 2; ++mm)
#pragma unroll
                    for (int bj = 0; bj < 2; ++bj) xv[mm][bj] = *(const v4u*)(xin + (size_t)(row0 + ai * 128 + (m + mm) * 16) * DM + col0 + bj * 128);
#pragma unroll
                for (int mm = 0; mm < 2; ++mm)
#pragma unroll
                    for (int bj = 0; bj < 2; ++bj) { const v4u q = xv[mm][bj]; const pg8::f32x4 a0 = acc[ai][bj][m + mm][0], a1 = acc[ai][bj][m + mm][1]; v4u o;
                        o.x = pk2(bf2f(q.x & 0xffffu) + gv[bj][0][0] * a0[0], bf2f(q.x >> 16) + gv[bj][0][1] * a0[1]); o.y = pk2(bf2f(q.y & 0xffffu) + gv[bj][0][2] * a0[2], bf2f(q.y >> 16) + gv[bj][0][3] * a0[3]);
                        o.z = pk2(bf2f(q.z & 0xffffu) + gv[bj][1][0] * a1[0], bf2f(q.z >> 16) + gv[bj][1][1] * a1[1]); o.w = pk2(bf2f(q.w & 0xffffu) + gv[bj][1][2] * a1[2], bf2f(q.w >> 16) + gv[bj][1][3] * a1[3]);
                        asm volatile("global_store_dwordx4 %0, %1, off sc1\n\ts_nop 2" :: "v"(xout + (size_t)(row0 + ai * 128 + (m + mm) * 16) * DM + col0 + bj * 128), "v"(o) : "memory"); }
                asm volatile("" ::: "memory"); }
    }
};
struct EpiGLU {
    static constexpr bool PERM = true, AFTER_DRAIN = false;
    bf16* O;
    __device__ __forceinline__ void operator()(const pg8::f32x4 (&acc)[2][2][4][2], const pg8::Unit& u, int wr, int wc, int fr, int fq) const {
        const int row0 = u.pm * 256 + wr * 64 + fr, col0 = u.pn * 128 + wc * 32 + 8 * fq;
#pragma unroll
        for (int ai = 0; ai < 2; ++ai)
#pragma unroll
            for (int m = 0; m < 4; ++m) { bf16* rowp = O + (size_t)(row0 + ai * 128 + m * 16) * DE + col0; float hv[8];
#pragma unroll
                for (int n = 0; n < 2; ++n)
#pragma unroll
                    for (int i = 0; i < 4; ++i) { const float g = acc[ai][0][m][n][i], uu = acc[ai][1][m][n][i]; hv[4 * n + i] = g * __builtin_amdgcn_rcpf(1.f + __expf(-g)) * uu; }
                v4u w; w.x = pk2(hv[0], hv[1]); w.y = pk2(hv[2], hv[3]); w.z = pk2(hv[4], hv[5]); w.w = pk2(hv[6], hv[7]);
                asm volatile("global_store_dwordx4 %0, %1, off sc1\n\ts_nop 2" :: "v"(rowp), "v"(w) : "memory"); }
    }
};
struct MoeOrder {
    int nunits, NT, G, c; volatile LAS int* misc; const int* list;
    __device__ __forceinline__ bool next(int i, pg8::Unit& u) const {
        int tile, pn;
        if (G == 256 && NT == 2) { const int x = c & 7, q = c >> 3; tile = i * 128 + x * 16 + (q >> 1); pn = q & 1; if (tile * 2 >= nunits) return false; }
        else { const int L = i * G + c; if (L >= nunits) return false; tile = L / NT; pn = L % NT; }
        u.pm = tile; u.pn = pn; u.e = misc[128 + tile]; return true; }
    __device__ __forceinline__ void a_ready(const pg8::Unit&) const {}
    __device__ __forceinline__ void done(const pg8::Unit&) const {}
    __device__ __forceinline__ unsigned rowbyte(const pg8::Unit& u, int r, int K) const { const int slot = (u.pm - misc[16 + u.e]) * 256 + r; const int tok = slot < misc[64 + u.e] ? list[(size_t)u.e * NTOK + slot] : 0; return (unsigned)tok * (unsigned)(K * 2); }
};

struct StaticOrderCnt : pg8::StaticOrder {
    const unsigned* ready;
    __device__ __forceinline__ void a_ready(const pg8::Unit& u) const {
        if (threadIdx.x < 64) {
            unsigned polls = 0;
            while ((unsigned)__builtin_amdgcn_readfirstlane(__hip_atomic_load(ready + 64 * u.pm, __ATOMIC_RELAXED, __HIP_MEMORY_SCOPE_AGENT)) < 16u && ++polls < (1u << 20)) __builtin_amdgcn_s_sleep(2);
            __builtin_amdgcn_fence(__ATOMIC_ACQUIRE, "agent");
            asm volatile("s_waitcnt vmcnt(0)" ::: "memory");
        }
        asm volatile("" ::: "memory"); __builtin_amdgcn_s_barrier(); asm volatile("" ::: "memory");
    }
};
struct StaticOrderPub : pg8::StaticOrder {
    unsigned* ready;
    __device__ __forceinline__ void done(const pg8::Unit& u) const {
        asm volatile("s_waitcnt vmcnt(0)" ::: "memory");
        if (fresh_lane() == 0) (void)__hip_atomic_fetch_add(ready + 64 * u.pm, 1u, __ATOMIC_RELAXED, __HIP_MEMORY_SCOPE_AGENT);
    }
};
struct MoeOrderPub : MoeOrder {
    unsigned* ready;
    __device__ __forceinline__ void done(const pg8::Unit& u) const {
        asm volatile("s_waitcnt vmcnt(0)" ::: "memory");
        if (fresh_lane() == 0) (void)__hip_atomic_fetch_add(ready + 64 * u.pm, 1u, __ATOMIC_RELAXED, __HIP_MEMORY_SCOPE_AGENT);
    }
};
struct MoeOrderCnt {
    int nunits, NT, G, c, xe; volatile LAS int* misc; const unsigned* ready;
    __device__ __forceinline__ bool next(int i, pg8::Unit& u) const {
        int tile, pn;
        if (G == 256 && NT == 4) { const int x = c & 7, q = c >> 3, Te = (8 - xe) * 8;
            if (x >= xe) tile = (i < 2) ? i * Te + (x - xe) * 8 + (q >> 2) : 2 * Te + (i - 2) * 64 + x * 8 + (q >> 2); else tile = 2 * Te + i * 64 + x * 8 + (q >> 2);
            pn = q & 3; if (tile * 4 >= nunits) return false; }
        else { const int L = i * G + c; if (L >= nunits) return false; tile = L / NT; pn = L % NT; }
        u.pm = tile; u.pn = pn; u.e = misc[128 + tile]; return true; }
    __device__ __forceinline__ void a_ready(const pg8::Unit& u) const {
        if (threadIdx.x < 64) {
            unsigned polls = 0;
            while ((unsigned)__builtin_amdgcn_readfirstlane(__hip_atomic_load(ready + 64 * u.pm, __ATOMIC_RELAXED, __HIP_MEMORY_SCOPE_AGENT)) < 16u && ++polls < (1u << 20)) __builtin_amdgcn_s_sleep(2);
            __builtin_amdgcn_fence(__ATOMIC_ACQUIRE, "agent");
            asm volatile("s_waitcnt vmcnt(0)" ::: "memory");
        }
        asm volatile("" ::: "memory"); __builtin_amdgcn_s_barrier(); asm volatile("" ::: "memory");
    }
    __device__ __forceinline__ void done(const pg8::Unit&) const {}
    __device__ __forceinline__ unsigned rowbyte(const pg8::Unit&, int, int) const { return 0u; }
};

constexpr int PH_PER_LAYER = 9, N_PHASES = 2 + NL * PH_PER_LAYER;

__global__ void __launch_bounds__(512, 2) fwd(Args A) {
    extern __shared__ __attribute__((aligned(16))) unsigned char lds_raw[];
    Ctx F; F.lds = (LAS unsigned char*)lds_raw; F.misc = (volatile LAS int*)(F.lds + LDS_MISC);
    F.tid = threadIdx.x; F.lane = F.tid & 63; F.wave = __builtin_amdgcn_readfirstlane(F.tid >> 6); F.G = gridDim.x; F.bid = blockIdx.x; F.ws = A.ws; F.out = A.out;
    for (int i = F.tid; i < (LDS_BYTES - LDS_MISC) / 4; i += 512) F.misc[i] = 0;
    __syncthreads();
    if (F.tid < 36) { const unsigned long long p = (unsigned long long)A.in[F.tid]; F.misc[MISC_PTR + 2 * F.tid] = (int)(unsigned)p; F.misc[MISC_PTR + 2 * F.tid + 1] = (int)(unsigned)(p >> 32); }
    __syncthreads();
#if ONE_LAUNCH
    (void)xcd_barrier_post((unsigned*)(F.ws + WS_CTL) + CW_BAR, (volatile LAS unsigned*)F.misc);
#define GRID_BAR() do { const Ctx Q_ = launder(F); XcdBarrier b_; b_.bar = (unsigned*)(Q_.ws + WS_CTL) + CW_BAR; b_.x = xb_xcc_id(); b_.st = (volatile LAS unsigned*)Q_.misc; xcd_barrier(b_); } while (0)
#else
#define GRID_BAR() do {} while (0)
#endif
#if ONE_LAUNCH
    constexpr int lo = 0, hi = N_PHASES;
#else
    const int lo = A.ph_lo, hi = A.ph_hi;
#endif
#ifndef DISMASK
#define DISMASK 0
#endif
#define IN(k) (lo <= (k) && (k) < hi)
#define EN(j) (!((DISMASK >> (j)) & 1))
#ifndef PROBE_MASK
#define PROBE_MASK 0
#endif
#ifndef DUP_MASK
#define DUP_MASK 0
#endif
#define DUP(j) ((DUP_MASK >> (j)) & 1)
#if PROBE_MASK
#define PR_BEGIN(j) do { if (((PROBE_MASK >> (j)) & 1) && F.wave == 0) { const unsigned long long t_ = __builtin_amdgcn_s_memrealtime(); F.misc[602] = (int)(unsigned)t_; F.misc[603] = (int)(unsigned)(t_ >> 32); } } while (0)
#define PR_END(j) do { if (((PROBE_MASK >> (j)) & 1) && F.wave == 0) { const unsigned long long t_ = __builtin_amdgcn_s_memrealtime(); const unsigned long long t0_ = ((unsigned long long)(unsigned)F.misc[603] << 32) | (unsigned)F.misc[602]; F.misc[600] = F.misc[600] + (int)(unsigned)(t_ - t0_); } } while (0)
#else
#define PR_BEGIN(j) do {} while (0)
#define PR_END(j) do {} while (0)
#endif
#define SEAM(k) do { if (IN((k) + 1)) GRID_BAR(); } while (0)
    if (IN(0)) { ph_prologue(F); s5_tables(F); __syncthreads(); convert_win(F, 0); SEAM(0); }
    for (int l = 0; l < NL; ++l) {
        const int p0 = 1 + l * PH_PER_LAYER;
        if (IN(p0 + 0)) { ph_n1(F, l, 0); __syncthreads(); }
        if (IN(p0 + 1)) { const Ctx P = launder(F);
            pg8::Gemm g{(const bf16*)(P.ws + WS_H), (const bf16*)((P.ws + WS_WB) + WB_IN), NTOK, NP, DM, 0}; StaticOrderCnt S; S.init(NTOK, NP, P.G, P.bid); S.ready = (const unsigned*)(P.ws + WS_CTL) + CW_HP + l * (128 * 64);
            pg8::EpiBf16<0> E{(bf16*)(P.ws + WS_P), NP, nullptr, 0, 0, 1.f};
            pg8::gemm_phase<pg8::EpiBf16<0>, StaticOrderCnt, true, true>(P.lds, g, S, E, P.wave);
            SEAM(p0 + 1); }
        if (IN(p0 + 2)) { ph_s5(F, l); __syncthreads(); ph_s1(F, l); __syncthreads(); ph_g1(F, l); SEAM(p0 + 2); }
        if (IN(p0 + 3)) { ph_scan(F, l); SEAM(p0 + 3); }
        if (IN(p0 + 4)) { ph_s3(F, l); __syncthreads(); ph_g3(F, l); __syncthreads(); ph_m3(F, l); SEAM(p0 + 4); }
        if (IN(p0 + 5)) { const Ctx P = launder(F);
            pg8::Gemm g{(const bf16*)(P.ws + WS_Y), (const bf16*)((P.ws + WS_WB) + WB_OUT), NTOK, DM, DM, 0}; StaticOrderPub S; S.init(NTOK, DM, P.G, P.bid); S.ready = (unsigned*)(P.ws + WS_CTL) + CW_XP + l * (128 * 64);
            EpiResid E{(const bf16*)(P.ws + WS_X), (bf16*)(P.ws + WS_X), (const float*)(P.ws + WS_MOD) + (size_t)l * NB * 6 * DM + 2 * DM};
            pg8::gemm_phase<EpiResid, StaticOrderPub, true, true>(P.lds, g, S, E, P.wave);
            __syncthreads(); }
        if (IN(p0 + 6)) { ph_n2(F, l); SEAM(p0 + 6); }
        if (IN(p0 + 7)) { const Ctx P = launder(F);
            __syncthreads(); build_tiles(P, l); __syncthreads();
            const int ntiles = P.misc[16 + NE];
            unsigned* rt = (unsigned*)(P.ws + WS_CTL) + CW_RT + l * (320 * 64);
            { pg8::Gemm g{(const bf16*)(P.ws + WS_H), (const bf16*)((P.ws + WS_WB) + WB_GU), MAXROWS, 512, DM, (size_t)512 * DM * 2};
              MoeOrderPub S{{ntiles * 2, 2, P.G, P.bid, P.misc, (const int*)(P.ws + WS_LIST)}, rt};
              EpiGLU E{(bf16*)(P.ws + WS_HID)};
              pg8::gemm_phase<EpiGLU, MoeOrderPub, true, true, true>(P.lds, g, S, E, P.wave); }
            __syncthreads();
            { const Ctx Q = launder(F);
              const int R1 = (ntiles + 127) / 128, n3 = ntiles - (R1 - 1) * 128; const int xe = (n3 >= 128) ? 0 : (n3 + 15) / 16;
              pg8::Gemm g{(const bf16*)(Q.ws + WS_HID), (const bf16*)((Q.ws + WS_WB) + WB_DN), MAXROWS, DM, DE, (size_t)DM * DE * 2};
              MoeOrderCnt S{ntiles * 4, 4, Q.G, Q.bid, xe, Q.misc, (const unsigned*)(Q.ws + WS_CTL) + CW_RT + l * (320 * 64)};
              pg8::EpiBf16<0> E{(bf16*)(Q.ws + WS_MO), DM, nullptr, 0, 0, 1.f};
              pg8::gemm_phase<pg8::EpiBf16<0>, MoeOrderCnt, true, true>(Q.lds, g, S, E, Q.wave); }
            if (l + 1 < NL) { __syncthreads(); convert_win(F, l + 1); }
            SEAM(p0 + 8); }
    }
    if (IN(N_PHASES - 1)) ph_n1(F, 0, 1);
}

extern "C" void kernel_launch(void* const* d_in, const int* in_sizes, int n_in, void* d_out, int out_size, void* d_ws, size_t ws_size, hipStream_t stream) {
    static int grid = 0;
    if (grid == 0) {
        if (n_in != 36 || out_size != NTOK * DM || ws_size < WS_END) { fprintf(stderr, "kernel_launch: unexpected shapes: n_in %d out %d ws %zu (need %zu)\n", n_in, out_size, ws_size, (size_t)WS_END); grid = -1; return; }
        int dev = 0, cus = 0, per_cu = 0;
        if (hipGetDevice(&dev) != hipSuccess || hipDeviceGetAttribute(&cus, hipDeviceAttributeMultiprocessorCount, dev) != hipSuccess) { grid = -1; return; }
        if (hipFuncSetAttribute((const void*)fwd, hipFuncAttributeMaxDynamicSharedMemorySize, LDS_BYTES) != hipSuccess) { fprintf(stderr, "kernel_launch: hipFuncSetAttribute failed\n"); grid = -1; return; }
        if (hipOccupancyMaxActiveBlocksPerMultiprocessor(&per_cu, (const void*)fwd, 512, LDS_BYTES) != hipSuccess || per_cu < 1) fprintf(stderr, "kernel_launch: occupancy query says %d\n", per_cu);
        (void)hipGetLastError();
        grid = cus;
    }
    if (grid < 0) return;
    (void)hipMemsetAsync((char*)d_ws + WS_CTL, 0, CTL_BYTES, stream);
    Args a{};
    for (int i = 0; i < 36; ++i) a.in[i] = (const float*)d_in[i];
    a.out = (float*)d_out; a.ws = (unsigned char*)d_ws;
#if ONE_LAUNCH
    a.ph_lo = 0; a.ph_hi = N_PHASES;
    hipLaunchKernelGGL(fwd, dim3(grid), dim3(512), LDS_BYTES, stream, a);
#else
    for (int ph = 0; ph < N_PHASES; ++ph) { a.ph_lo = ph; a.ph_hi = ph + 1; hipLaunchKernelGGL(fwd, dim3(grid), dim3(512), LDS_BYTES, stream, a); }
#endif
}
```
